# Optimizing an MI355X kernel written in HIP

```python
import jax, jax.numpy as jnp
from jax import lax
import numpy as np

D_MODEL = 1024
BATCH = 2
SEQ = 8192
DEPTH = 4

EPS = 1e-6
D_LRU = 384
LRU_HEADS = 6
LRU_HEAD_DIM = D_LRU // LRU_HEADS
CONV_WIDTH = 4
LRU_C = 8.0
MLA_HEADS = 6
QK_NOPE_DIM = 64
QK_ROPE_DIM = 32
V_HEAD_DIM = 64
D_MLA = MLA_HEADS * V_HEAD_DIM
Q_LORA_RANK = 384
KV_LORA_RANK = 256
ROPE_BASE = 10000.0
Q_BLOCK = 128
POOL_WINDOWS = (2, 4, 8, 16)
POOL_GROUP_DIM = 64
D_POOL = POOL_GROUP_DIM * len(POOL_WINDOWS)
D_MIX = D_LRU + D_MLA + D_POOL
IN_SIZES = (D_LRU, D_LRU, Q_LORA_RANK, KV_LORA_RANK, QK_ROPE_DIM, D_MLA, D_POOL, D_POOL)
D_IN = sum(IN_SIZES)

kernel_name = "hybrid_lru_mla_pool_trunk"


def rms_norm(x, g):
    xf = x.astype(jnp.float32)
    y = xf * lax.rsqrt(jnp.mean(xf * xf, axis=-1, keepdims=True) + EPS)
    return (y * g.astype(jnp.float32)).astype(x.dtype)


def rope_tables(seq_len):
    pos = jnp.arange(seq_len, dtype=jnp.float32)
    inv_freq = ROPE_BASE ** (-jnp.arange(0, QK_ROPE_DIM, 2, dtype=jnp.float32) / QK_ROPE_DIM)
    ang = pos[:, None] * inv_freq[None, :]
    return jnp.cos(ang), jnp.sin(ang)


def apply_rope(x, cos, sin):
    shape = (1, x.shape[1]) + (1,) * (x.ndim - 3) + (QK_ROPE_DIM // 2,)
    c = cos.reshape(shape)
    s = sin.reshape(shape)
    xf = x.astype(jnp.float32)
    x1, x2 = jnp.split(xf, 2, axis=-1)
    return jnp.concatenate([x1 * c - x2 * s, x1 * s + x2 * c], axis=-1).astype(x.dtype)


def causal_depthwise_conv(x, w, b):
    S = x.shape[1]
    xp = jnp.pad(x, ((0, 0), (CONV_WIDTH - 1, 0), (0, 0)))
    y = b
    for k in range(CONV_WIDTH):
        y = y + xp[:, k:k + S, :] * w[k]
    return y


def rg_lru(x, w_r, b_r, w_i, b_i, lam):
    B, S, _ = x.shape
    xf = x.astype(jnp.float32)
    xh = xf.reshape(B, S, LRU_HEADS, LRU_HEAD_DIM)
    r = jax.nn.sigmoid(jnp.einsum('bshi,hij->bshj', xh, w_r.astype(jnp.float32)).reshape(B, S, D_LRU) + b_r.astype(jnp.float32))
    i = jax.nn.sigmoid(jnp.einsum('bshi,hij->bshj', xh, w_i.astype(jnp.float32)).reshape(B, S, D_LRU) + b_i.astype(jnp.float32))
    log_a = -LRU_C * r * jax.nn.softplus(-lam.astype(jnp.float32))
    a = jnp.exp(log_a)
    u = jnp.sqrt(-jnp.expm1(2.0 * log_a)) * (i * xf)

    def combine(left, right):
        a_l, h_l = left
        a_r, h_r = right
        return a_l * a_r, a_r * h_l + h_r

    _, h = lax.associative_scan(combine, (a, u), axis=1)
    return h.astype(x.dtype)


def mla(c_q, c_kv, k_r, q_norm_g, w_uq, kv_norm_g, w_ukv, cos, sin):
    B, S, _ = c_q.shape
    q = (rms_norm(c_q, q_norm_g) @ w_uq).reshape(B, S, MLA_HEADS, QK_NOPE_DIM + QK_ROPE_DIM)
    q_nope = q[..., :QK_NOPE_DIM]
    q_rope = apply_rope(q[..., QK_NOPE_DIM:], cos, sin)
    kv = (rms_norm(c_kv, kv_norm_g) @ w_ukv).reshape(B, S, MLA_HEADS, QK_NOPE_DIM + V_HEAD_DIM)
    k_nope = kv[..., :QK_NOPE_DIM]
    v = kv[..., QK_NOPE_DIM:]
    k_rope = apply_rope(k_r, cos, sin)
    scale = (QK_NOPE_DIM + QK_ROPE_DIM) ** -0.5
    outs = []
    for blk in range(S // Q_BLOCK):
        q0 = blk * Q_BLOCK
        q1 = q0 + Q_BLOCK
        s = (jnp.einsum('bqhd,bkhd->bhqk', q_nope[:, q0:q1], k_nope[:, :q1])
             + jnp.einsum('bqhr,bkr->bhqk', q_rope[:, q0:q1], k_rope[:, :q1]))
        s = s.astype(jnp.float32) * scale
        mask = jnp.arange(q1)[None, :] <= (q0 + jnp.arange(Q_BLOCK))[:, None]
        s = jnp.where(mask, s, -1e30)
        p = jax.nn.softmax(s, axis=-1).astype(v.dtype)
        outs.append(jnp.einsum('bhqk,bkhd->bqhd', p, v[:, :q1]))
    return jnp.concatenate(outs, axis=1).reshape(B, S, D_MLA)


def multi_scale_pool(x, w_pool, pool_scale):
    B, S, _ = x.shape
    xf = x.astype(jnp.float32)
    n_seen = jnp.arange(1, S + 1, dtype=jnp.float32)
    outs = []
    for g, w in enumerate(POOL_WINDOWS):
        xg = xf[..., g * POOL_GROUP_DIM:(g + 1) * POOL_GROUP_DIM]
        cs = jnp.cumsum(xg, axis=1)
        lower = jnp.pad(cs, ((0, 0), (w, 0), (0, 0)))[:, :S]
        cnt = jnp.minimum(n_seen, float(w))[None, :, None]
        outs.append((cs - lower) / cnt - xg)
    pooled = jnp.stack(outs, axis=2)
    y = jnp.einsum('bsgi,gij->bsgj', pooled, w_pool.astype(jnp.float32)).reshape(B, S, D_POOL)
    return (y * pool_scale.astype(jnp.float32)).astype(x.dtype)


def setup_inputs(seed: int = 0) -> dict:
    key = jax.random.key(seed)
    ks = jax.random.split(key, 20)

    def nrm(k, shape, scale):
        return scale * jax.random.normal(k, shape, jnp.float32)

    u = jax.random.uniform(ks[9], (DEPTH, D_LRU), jnp.float32, minval=0.9, maxval=0.999)
    s = u ** (1.0 / LRU_C)
    lru_lambda = jnp.log(s) - jnp.log1p(-s)
    return {
        "x": nrm(ks[0], (BATCH, SEQ, D_MODEL), 1.0),
        "norm_g": 1.0 + nrm(ks[1], (DEPTH, D_MODEL), 0.02),
        "w_in": nrm(ks[2], (DEPTH, D_MODEL, D_IN), D_MODEL ** -0.5),
        "conv_w": nrm(ks[3], (DEPTH, CONV_WIDTH, D_LRU), CONV_WIDTH ** -0.5),
        "conv_b": nrm(ks[4], (DEPTH, D_LRU), 0.01),
        "w_rg": nrm(ks[5], (DEPTH, LRU_HEADS, LRU_HEAD_DIM, LRU_HEAD_DIM), LRU_HEAD_DIM ** -0.5),
        "b_rg": nrm(ks[6], (DEPTH, D_LRU), 0.01),
        "w_ig": nrm(ks[7], (DEPTH, LRU_HEADS, LRU_HEAD_DIM, LRU_HEAD_DIM), LRU_HEAD_DIM ** -0.5),
        "b_ig": nrm(ks[8], (DEPTH, D_LRU), 0.01),
        "lru_lambda": lru_lambda,
        "q_norm_g": 1.0 + nrm(ks[10], (DEPTH, Q_LORA_RANK), 0.02),
        "w_uq": nrm(ks[11], (DEPTH, Q_LORA_RANK, MLA_HEADS * (QK_NOPE_DIM + QK_ROPE_DIM)), Q_LORA_RANK ** -0.5),
        "kv_norm_g": 1.0 + nrm(ks[12], (DEPTH, KV_LORA_RANK), 0.02),
        "w_ukv": nrm(ks[13], (DEPTH, KV_LORA_RANK, MLA_HEADS * (QK_NOPE_DIM + V_HEAD_DIM)), KV_LORA_RANK ** -0.5),
        "w_pool": nrm(ks[14], (DEPTH, len(POOL_WINDOWS), POOL_GROUP_DIM, POOL_GROUP_DIM), POOL_GROUP_DIM ** -0.5),
        "pool_scale": 1.0 + nrm(ks[15], (DEPTH, D_POOL), 0.1),
        "w_out": nrm(ks[16], (DEPTH, D_MIX, D_MODEL), D_MIX ** -0.5),
        "final_norm_g": 1.0 + nrm(ks[17], (D_MODEL,), 0.02),
    }


def reference(x, norm_g, w_in, conv_w, conv_b, w_rg, b_rg, w_ig, b_ig, lru_lambda,
              q_norm_g, w_uq, kv_norm_g, w_ukv, w_pool, pool_scale, w_out, final_norm_g):
    S = x.shape[1]
    cos, sin = rope_tables(S)
    offsets = np.cumsum(IN_SIZES)[:-1].tolist()
    for l in range(DEPTH):
        h = rms_norm(x, norm_g[l])
        z = h @ w_in[l]
        za, ga, cq, ckv, kr, gb, zc, gc = jnp.split(z, offsets, axis=-1)
        xa = causal_depthwise_conv(za, conv_w[l], conv_b[l])
        ya = rg_lru(xa, w_rg[l], b_rg[l], w_ig[l], b_ig[l], lru_lambda[l]) * jax.nn.silu(ga)
        yb = mla(cq, ckv, kr, q_norm_g[l], w_uq[l], kv_norm_g[l], w_ukv[l], cos, sin) * jax.nn.silu(gb)
        yc = multi_scale_pool(zc, w_pool[l], pool_scale[l]) * jax.nn.silu(gc)
        y = jnp.concatenate([ya, yb, yc], axis=-1)
        x = x + y @ w_out[l]
    return rms_norm(x, final_norm_g)
```

```cpp
#include <hip/hip_runtime.h>
#include <hip/hip_cooperative_groups.h>
#include <cstdio>
#include <cstdint>
#include <cmath>
namespace cg = cooperative_groups;
namespace pg8 {
#define PG8_LAS __attribute__((address_space(3)))
typedef unsigned short bf16_t;
typedef short bf16x8 __attribute__((ext_vector_type(8)));
typedef float f32x4 __attribute__((ext_vector_type(4)));
typedef unsigned u32x4 __attribute__((ext_vector_type(4)));
constexpr int BM = 256, BK = 64, HALF = 128, HTB = HALF * BK * 2  , STAGE_BYTES = 8 * HTB, NXCD = 8, WGM = 8;

__host__ __device__ __forceinline__ int lds_byte(int r, int c) { const int st = (r >> 4) * 2 + (c >> 5), rr = r & 15, cc = c & 31, ob = rr * 64 + cc * 2; return st * 1024 + (ob ^ (((ob >> 9) & 1) << 5)); }
__host__ __device__ __forceinline__ void stage_rc(int b, int& R, int& C) { const int st = b / 1024, sb = b % 1024, swz = sb ^ (((sb >> 9) & 1) << 5); R = (st >> 1) * 16 + swz / 64; C = (st & 1) * 32 + (swz % 64) / 2; }
__host__ __device__ __forceinline__ int perm32(int rho) { const int n = rho >> 4, i = rho & 15; return 8 * (i >> 2) + 4 * n + (i & 3); }

struct Unit { int pm, pn; };
struct Gemm { const bf16_t* A; const bf16_t* Bt; int M, N, K, lda, ldb; };

struct StaticOrder {
    int nM, nN, nwg, G, c;
    __host__ __device__ void init(int M, int N, int G_, int c_) { nM = M / BM; nN = N / BM; nwg = nM * nN; G = G_; c = c_; }
    __host__ __device__ bool next(int i, Unit& u) const {
        const long L = (long)i * G + c; if (L >= nwg) return false;
        int wgid = (int)L; { const int q = nwg / NXCD, r = nwg % NXCD, xcd = wgid % NXCD, off = wgid / NXCD; wgid = (xcd < r ? xcd * (q + 1) : r * (q + 1) + (xcd - r) * q) + off; }
        const int nig = WGM * nN, gid = wgid / nig, fm = gid * WGM, gsz = (nM - fm) < WGM ? (nM - fm) : WGM;
        u.pm = fm + ((wgid % nig) % gsz); u.pn = (wgid % nig) / gsz; return true;
    }
    __device__ __forceinline__ void a_ready(const Unit&) const {}
    __device__ __forceinline__ void done(const Unit&) const {}
};

__device__ __forceinline__ unsigned cvt_pk_bf16(float lo, float hi) { unsigned r; asm volatile("v_cvt_pk_bf16_f32 %0, %1, %2" : "=v"(r) : "v"(lo), "v"(hi)); return r; }
typedef float f32x2 __attribute__((ext_vector_type(2)));
template <class Epi, class Sched, bool ALIGN_EPI, bool SP2>
__device__ __forceinline__ void gemm_phase(PG8_LAS unsigned char* lds, const Gemm g, const Sched& S, const Epi& E) {
    int tid_ = threadIdx.x; asm volatile("" : "+v"(tid_));
    const int tid = tid_, wid = __builtin_amdgcn_readfirstlane(tid >> 6), lane = tid & 63, wr = wid >> 2, wc = wid & 3, fr = lane & 15, fq = lane >> 4;
    const int K = g.K; int nt = K / BK; asm volatile("" : "+s"(nt));
    unsigned voffA[2], voffB[2];
#pragma unroll
    for (int i = 0; i < 2; ++i) { int R, C; stage_rc(tid * 16 + i * 8192, R, C); const int Rb = Epi::PERM ? ((R & ~31) + perm32(R & 31)) : R;
        voffA[i] = (unsigned)(R * g.lda + C) * 2u; voffB[i] = (unsigned)(Rb * g.ldb + C) * 2u; }
    const size_t kstep = (size_t)(BK * 2);
    const size_t hstepA = (size_t)HALF * g.lda * 2, hstepB = (size_t)HALF * g.ldb * 2;
    const size_t tstepA = 2 * hstepA, tstepB = 2 * hstepB;
    const unsigned ldsw = (unsigned)wid * 1024u;
    const int aoff = lds_byte(wr * 64 + fr, fq * 8), boff = lds_byte(wc * 32 + fr, fq * 8);
#define PG8_SA(b, h) (((b) * 2 + (h)) * HTB)
#define PG8_SB(b, h) ((4 + (b) * 2 + (h)) * HTB)
#define PG8_STAGE(bufoff, gbase, voff) do { _Pragma("unroll") for (int _i = 0; _i < 2; ++_i) \
        __builtin_amdgcn_global_load_lds((const unsigned*)((const char*)(gbase) + (voff)[_i]), (PG8_LAS unsigned*)(lds + (bufoff) + ldsw + _i * 8192), 16, 0, 0); } while (0)
#define PG8_LDA(dst, b, h) do { _Pragma("unroll") for (int m = 0; m < 4; ++m) _Pragma("unroll") for (int k = 0; k < 2; ++k) dst[m][k] = *(const PG8_LAS bf16x8*)(lds + PG8_SA(b, h) + aoff + m * 2048 + k * 1024); } while (0)
#define PG8_LDB(dst, b, h) do { _Pragma("unroll") for (int n = 0; n < 2; ++n) _Pragma("unroll") for (int k = 0; k < 2; ++k) dst[n][k] = *(const PG8_LAS bf16x8*)(lds + PG8_SB(b, h) + boff + n * 2048 + k * 1024); } while (0)
#define PG8_MMA(ai, bj, At, Bt) do { __builtin_amdgcn_s_setprio(1); _Pragma("unroll") for (int m = 0; m < 4; ++m) _Pragma("unroll") for (int n = 0; n < 2; ++n) _Pragma("unroll") for (int k = 0; k < 2; ++k) \
        acc[ai][bj][m][n] = __builtin_amdgcn_mfma_f32_16x16x32_bf16(Bt[n][k], At[m][k], acc[ai][bj][m][n], 0, 0, 0); __builtin_amdgcn_s_setprio(0); } while (0)
#define PG8_WAIT_V(n) asm volatile("s_waitcnt vmcnt(" #n ")" ::: "memory")
#define PG8_WAIT_L(n) asm volatile("s_waitcnt lgkmcnt(" #n ")" ::: "memory")
#define PG8_BAR __builtin_amdgcn_s_barrier()
#define PG8_SCHED __builtin_amdgcn_sched_barrier(0)
    Unit cur, nxt; int ui = 0;
    if (!S.next(0, cur)) return;
    f32x4 acc[2][2][4][2];
#pragma unroll
    for (int a = 0; a < 2; ++a)
#pragma unroll
        for (int b = 0; b < 2; ++b)
#pragma unroll
            for (int m = 0; m < 4; ++m)
#pragma unroll
                for (int n = 0; n < 2; ++n) acc[a][b][m][n] = (f32x4){0.f, 0.f, 0.f, 0.f};
    bf16x8 At[4][2], B0[2][2], B1[2][2];
    const char* cA = (const char*)g.A + (size_t)cur.pm * tstepA; const char* cB = (const char*)g.Bt + (size_t)cur.pn * tstepB;
    S.a_ready(cur);
    if constexpr (SP2) {
        PG8_STAGE(PG8_SB(0, 0), cB, voffB); PG8_STAGE(PG8_SB(0, 1), cB + hstepB, voffB); PG8_STAGE(PG8_SA(0, 0), cA, voffA); PG8_STAGE(PG8_SA(0, 1), cA + hstepA, voffA);
        if (wr == 1) PG8_BAR;
        PG8_WAIT_V(2); PG8_BAR;
        PG8_STAGE(PG8_SB(1, 0), cB + kstep, voffB); PG8_STAGE(PG8_SA(1, 0), cA + kstep, voffA); PG8_STAGE(PG8_SB(1, 1), cB + hstepB + kstep, voffB);
        PG8_WAIT_V(6); PG8_BAR;
    } else {
        PG8_STAGE(PG8_SB(0, 0), cB, voffB); PG8_STAGE(PG8_SA(0, 0), cA, voffA); PG8_STAGE(PG8_SB(0, 1), cB + hstepB, voffB); PG8_STAGE(PG8_SA(0, 1), cA + hstepA, voffA);
        if (wr == 1) PG8_BAR;
        PG8_WAIT_V(4); PG8_BAR;
        PG8_STAGE(PG8_SB(1, 0), cB + kstep, voffB); PG8_STAGE(PG8_SA(1, 0), cA + kstep, voffA); PG8_STAGE(PG8_SB(1, 1), cB + hstepB + kstep, voffB);
        PG8_WAIT_V(6); PG8_BAR;
    }
    for (;;) {
        const bool has_next = S.next(ui + 1, nxt);
        const char* nA = has_next ? (const char*)g.A + (size_t)nxt.pm * tstepA : cA; const char* nB = has_next ? (const char*)g.Bt + (size_t)nxt.pn * tstepB : cB;
        for (int t = 0; t < nt; t += 2) {
            const bool last = (t == nt - 2);
            const char* a1 = cA + (size_t)(t + 1) * kstep;
            const char* a2 = last ? nA : cA + (size_t)(t + 2) * kstep; const char* b2 = last ? nB : cB + (size_t)(t + 2) * kstep;
            const char* a3 = a2 + kstep; const char* b3 = b2 + kstep;
            if (last && has_next) S.a_ready(nxt);
            if constexpr (SP2) {
            PG8_LDB(B0, 0, 0); PG8_LDB(B1, 0, 1); PG8_SCHED; PG8_LDA(At, 0, 0); PG8_STAGE(PG8_SA(1, 1), a1 + hstepA, voffA);
            PG8_WAIT_V(8); PG8_WAIT_L(0); PG8_BAR; PG8_MMA(0, 0, At, B0); PG8_MMA(0, 1, At, B1); PG8_BAR; PG8_SCHED;
            PG8_LDA(At, 0, 1); PG8_STAGE(PG8_SB(0, 0), b2, voffB); PG8_STAGE(PG8_SB(0, 1), b2 + hstepB, voffB); PG8_STAGE(PG8_SA(0, 0), a2, voffA);
            PG8_WAIT_V(8); PG8_WAIT_L(0); PG8_BAR; PG8_MMA(1, 0, At, B0); PG8_MMA(1, 1, At, B1); PG8_BAR; PG8_SCHED;
            PG8_LDB(B0, 1, 0); PG8_LDB(B1, 1, 1); PG8_SCHED; PG8_LDA(At, 1, 0); PG8_STAGE(PG8_SA(0, 1), a2 + hstepA, voffA);
            PG8_WAIT_V(8); PG8_WAIT_L(0); PG8_BAR; PG8_MMA(0, 0, At, B0); PG8_MMA(0, 1, At, B1); PG8_BAR; PG8_SCHED;
            PG8_LDA(At, 1, 1); PG8_STAGE(PG8_SB(1, 0), b3, voffB); PG8_STAGE(PG8_SB(1, 1), b3 + hstepB, voffB); PG8_STAGE(PG8_SA(1, 0), a3, voffA);
            PG8_WAIT_V(8); PG8_WAIT_L(0); PG8_BAR; PG8_MMA(1, 0, At, B0); PG8_MMA(1, 1, At, B1); PG8_BAR; PG8_SCHED;
            } else {
            PG8_LDB(B0, 0, 0); PG8_SCHED; PG8_LDA(At, 0, 0); PG8_STAGE(PG8_SA(1, 1), a1 + hstepA, voffA);
            PG8_WAIT_L(8); PG8_BAR; PG8_WAIT_L(0); PG8_MMA(0, 0, At, B0); PG8_BAR; PG8_SCHED;
            PG8_LDB(B1, 0, 1); PG8_STAGE(PG8_SB(0, 0), b2, voffB);
            PG8_BAR; PG8_WAIT_L(0); PG8_MMA(0, 1, At, B1); PG8_BAR;
            PG8_LDA(At, 0, 1); PG8_STAGE(PG8_SA(0, 0), a2, voffA);
            PG8_BAR; PG8_WAIT_L(0); PG8_MMA(1, 0, At, B0); PG8_BAR; PG8_SCHED;
            PG8_STAGE(PG8_SB(0, 1), b2 + hstepB, voffB);
            PG8_WAIT_V(6); PG8_BAR; PG8_MMA(1, 1, At, B1); PG8_BAR;
            PG8_LDB(B0, 1, 0); PG8_SCHED; PG8_LDA(At, 1, 0); PG8_STAGE(PG8_SA(0, 1), a2 + hstepA, voffA);
            PG8_WAIT_L(8); PG8_BAR; PG8_WAIT_L(0); PG8_MMA(0, 0, At, B0); PG8_BAR; PG8_SCHED;
            PG8_LDB(B1, 1, 1); PG8_STAGE(PG8_SB(1, 0), b3, voffB);
            PG8_BAR; PG8_WAIT_L(0); PG8_MMA(0, 1, At, B1); PG8_BAR;
            PG8_LDA(At, 1, 1); PG8_STAGE(PG8_SA(1, 0), a3, voffA);
            PG8_BAR; PG8_WAIT_L(0); PG8_MMA(1, 0, At, B0); PG8_BAR; PG8_SCHED;
            PG8_STAGE(PG8_SB(1, 1), b3 + hstepB, voffB);
            PG8_WAIT_V(6); PG8_BAR; PG8_MMA(1, 1, At, B1); PG8_BAR;
            }
        }
        if constexpr (ALIGN_EPI) { if (wr == 0) PG8_BAR; }
        if constexpr (!Epi::AFTER_DRAIN) { E(acc, cur, wr, wc, fr, fq); S.done(cur); }
        if (!has_next) break;
#pragma unroll
        for (int a = 0; a < 2; ++a)
#pragma unroll
            for (int b = 0; b < 2; ++b)
#pragma unroll
                for (int m = 0; m < 4; ++m)
#pragma unroll
                    for (int n = 0; n < 2; ++n) acc[a][b][m][n] = (f32x4){0.f, 0.f, 0.f, 0.f};
        cur = nxt; cA = nA; cB = nB; ++ui;
        if constexpr (ALIGN_EPI) { if (wr == 1) PG8_BAR; }
    }
    PG8_WAIT_V(0);
    if constexpr (!ALIGN_EPI) { if (wr == 0) PG8_BAR; }
    PG8_BAR;
    if constexpr (Epi::AFTER_DRAIN) { E.fused(acc, cur, wr, wc, fr, fq, lds, wid, lane); S.done(cur); }
#undef PG8_SA
#undef PG8_SB
#undef PG8_STAGE
#undef PG8_LDA
#undef PG8_LDB
#undef PG8_MMA
#undef PG8_WAIT_V
#undef PG8_WAIT_L
#undef PG8_BAR
#undef PG8_SCHED
}
}

#ifndef PG8_SP2
#define PG8_SP2 true
#endif
#ifndef PG8_ALIGN
#define PG8_ALIGN true
#endif
#ifndef P2_REPEAT
#define P2_REPEAT 1
#endif
#ifndef MK_ONE_LAUNCH
#define MK_ONE_LAUNCH 1
#endif

#define LAS __attribute__((address_space(3)))
typedef unsigned short bf16_t;
typedef short bf16x8 __attribute__((ext_vector_type(8)));
typedef short s16x4 __attribute__((ext_vector_type(4)));
typedef float f32x4 __attribute__((ext_vector_type(4)));
typedef float f32x2 __attribute__((ext_vector_type(2)));
typedef float f32x16 __attribute__((ext_vector_type(16)));
typedef unsigned u32x4 __attribute__((ext_vector_type(4)));
typedef unsigned u32x2 __attribute__((ext_vector_type(2)));

constexpr int NB = 2, SEQ = 8192, M = NB * SEQ, DM = 1024, NL = 4;
constexpr int ZW = 2560, DQ = 576, DKV = 768, DLRU = 384, DPOOL = 256;
constexpr int Z_ZA = 0, Z_GA = 384, Z_CQ = 768, Z_CKV = 1152, Z_KR = 1408, Z_GB = 1440, Z_ZC = 1824, Z_GC = 2080, D_IN = 2336;
constexpr float EPS = 1e-6f;
constexpr float QSCALE = 0.10206207261596577f * 1.4426950408889634f;
constexpr int NWAVES = 8, NTHREADS = 512;
constexpr int LDS_BYTES = 155648;

constexpr size_t MiB = 1u << 20;
constexpr size_t WS_CTL = 0, CTL_ZERO_BYTES = 1 * MiB;
typedef unsigned long long ssum_t;
constexpr size_t WS_ACC = 254 * MiB;
constexpr size_t OFF_SSX = 0, OFF_SSQ = (size_t)5 * 16384 * 8, OFF_SSKV = (size_t)9 * 16384 * 8, ACC_BYTES = (size_t)13 * 16384 * 8;
constexpr size_t WS_ROPE = 1 * MiB;
constexpr size_t WS_CHS = 2 * MiB;
constexpr size_t WS_SMALL = 3 * MiB;
constexpr size_t WS_WIN = 4 * MiB, WS_WOUT = 24 * MiB, WS_WUQ = 32 * MiB, WS_WUKV = 35 * MiB;
constexpr size_t WS_XB = 38 * MiB;
constexpr size_t OUT_Q = 0, OUT_KR = 20 * MiB;
constexpr size_t WS_Z = 70 * MiB, WS_KV = 150 * MiB, WS_A32 = 174 * MiB, WS_U32 = 198 * MiB, WS_Y = 222 * MiB, WS_END = 256 * MiB;

struct Args { const float* in[18]; float* out; unsigned char* ws; int ph_lo, ph_hi; };

struct Frame {
    LAS unsigned char* lds;
    int tid, lane, wave, bid, G;
    float* out; unsigned char* ws;
};
typedef __attribute__((address_space(1))) const float* gfp_t;
__device__ __forceinline__ const float* kin(int i) {
    __attribute__((address_space(4))) const char* k = (__attribute__((address_space(4))) const char*)__builtin_amdgcn_kernarg_segment_ptr();
    asm volatile("" : "+s"(k));
    gfp_t p_ = *(__attribute__((address_space(4))) const gfp_t*)(k + 8 * i);
    return (const float*)p_; }

__device__ __forceinline__ unsigned f2bf(float f) { unsigned u = __builtin_bit_cast(unsigned, f); return (u + 0x7fffu + ((u >> 16) & 1u)) >> 16; }
__device__ __forceinline__ unsigned pk2(float lo, float hi) { return f2bf(lo) | (f2bf(hi) << 16); }
__device__ __forceinline__ float bf2f(unsigned short b) { return __builtin_bit_cast(float, (unsigned)b << 16); }
__device__ __forceinline__ float bflo(unsigned w) { return __builtin_bit_cast(float, w << 16); }
__device__ __forceinline__ float bfhi(unsigned w) { return __builtin_bit_cast(float, w & 0xffff0000u); }
__device__ __forceinline__ float sigmoidf_(float x) { return 1.0f / (1.0f + __expf(-x)); }
__device__ __forceinline__ float siluf_(float x) { return x / (1.0f + __expf(-x)); }
__device__ __forceinline__ float wave_sum(float v) {
#pragma unroll
    for (int o = 1; o < 64; o <<= 1) v += __shfl_xor(v, o);
    return v;
}
__device__ __forceinline__ void atomic_addf(ssum_t* p, float v) { (void)__hip_atomic_fetch_add(p, (ssum_t)(v * 16777216.0f), __ATOMIC_RELAXED, __HIP_MEMORY_SCOPE_AGENT); }
__device__ __forceinline__ float ldfx(const ssum_t* p) { return (float)(*p) * (1.0f / 16777216.0f); }
#define LDS_WAIT() asm volatile("s_waitcnt lgkmcnt(0)" ::: "memory")
__device__ __forceinline__ float fast_sigmoid(float x) { return __builtin_amdgcn_rcpf(1.0f + __expf(-x)); }
__device__ __forceinline__ float neg_expm1(float x) {
    const float ser = -x * (1.0f + x * (0.5f + x * (0.16666667f + x * (0.041666668f + x * 0.0083333338f))));
    const float dir = 1.0f - __expf(x);
    return (x > -0.25f) ? ser : dir;
}

struct EpiZ {
    static constexpr bool PERM = true, AFTER_DRAIN = false;
    bf16_t* Zb; const ssum_t* ssx; ssum_t* ssq; ssum_t* sskv;
    __device__ __forceinline__ void operator()(const pg8::f32x4 (&acc)[2][2][4][2], const pg8::Unit& u, int wr, int wc, int fr, int fq) const {
        const int row0 = u.pm * 256 + wr * 64 + fr, col0 = u.pn * 256 + wc * 32 + 8 * fq;
#pragma unroll
        for (int ai = 0; ai < 2; ++ai)
#pragma unroll
            for (int m = 0; m < 4; ++m) {
                const int row = row0 + ai * 128 + m * 16;
                const float rs = rsqrtf(ldfx(ssx + row) * (1.0f / 1024.0f) + EPS);
#pragma unroll
                for (int bj = 0; bj < 2; ++bj) {
                    const f32x4 v0 = acc[ai][bj][m][0] * rs, v1 = acc[ai][bj][m][1] * rs;
                    u32x4 w; w.x = pg8::cvt_pk_bf16(v0[0], v0[1]); w.y = pg8::cvt_pk_bf16(v0[2], v0[3]); w.z = pg8::cvt_pk_bf16(v1[0], v1[1]); w.w = pg8::cvt_pk_bf16(v1[2], v1[3]);
                    if (u.pn * 256 + bj * 128 + wc * 32 < D_IN) *(u32x4*)(Zb + (size_t)row * ZW + col0 + bj * 128) = w;
                    const int ht = u.pn * 2 + bj;
                    if (ht >= 6 && ht <= 10) {
                        float s = (v0[0] * v0[0] + v0[1] * v0[1]) + (v0[2] * v0[2] + v0[3] * v0[3]) + (v1[0] * v1[0] + v1[1] * v1[1]) + (v1[2] * v1[2] + v1[3] * v1[3]);
                        s += __shfl_xor(s, 16); s += __shfl_xor(s, 32);
                        if (fq == 0) atomic_addf((ht <= 8 ? ssq : sskv) + row, s);
                    }
                }
                asm volatile("" ::: "memory");
            }
    }
};
struct EpiQ {
    static constexpr bool PERM = true, AFTER_DRAIN = false;
    bf16_t* Qb; const ssum_t* ssq; const float* cosT; const float* sinT;
    __device__ __forceinline__ void operator()(const pg8::f32x4 (&acc)[2][2][4][2], const pg8::Unit& u, int wr, int wc, int fr, int fq) const {
        const int row0 = u.pm * 256 + wr * 64 + fr;
#pragma unroll
        for (int bj = 0; bj < 2; ++bj) {
            const int cg0 = u.pn * 256 + bj * 128 + wc * 32;
            if (cg0 >= DQ) continue;
            const bool rope = ((cg0 >> 5) % 3) == 2;
#pragma unroll
            for (int ai = 0; ai < 2; ++ai)
#pragma unroll
                for (int m = 0; m < 4; ++m) {
                    const int row = row0 + ai * 128 + m * 16;
                    const float rs = rsqrtf(ldfx(ssq + row) * (1.0f / 384.0f) + EPS) * QSCALE;
                    f32x4 v0 = acc[ai][bj][m][0] * rs, v1 = acc[ai][bj][m][1] * rs;
                    if (rope) {
                        const int pos = row & (SEQ - 1);
                        const f32x4 c0 = *(const f32x4*)(cosT + pos * 16 + 8 * (fq & 1)), c1 = *(const f32x4*)(cosT + pos * 16 + 8 * (fq & 1) + 4);
                        const f32x4 s0 = *(const f32x4*)(sinT + pos * 16 + 8 * (fq & 1)), s1 = *(const f32x4*)(sinT + pos * 16 + 8 * (fq & 1) + 4);
                        const float sg = (fq < 2) ? -1.0f : 1.0f;
                        f32x4 p0, p1;
#pragma unroll
                        for (int j = 0; j < 4; ++j) { p0[j] = __shfl_xor(v0[j], 32); p1[j] = __shfl_xor(v1[j], 32); }
                        v0 = v0 * c0 + (p0 * s0) * sg; v1 = v1 * c1 + (p1 * s1) * sg;
                    }
                    u32x4 w; w.x = pg8::cvt_pk_bf16(v0[0], v0[1]); w.y = pg8::cvt_pk_bf16(v0[2], v0[3]); w.z = pg8::cvt_pk_bf16(v1[0], v1[1]); w.w = pg8::cvt_pk_bf16(v1[2], v1[3]);
                    *(u32x4*)(Qb + (size_t)row * DQ + cg0 + 8 * fq) = w;
                    asm volatile("" ::: "memory");
                }
        }
    }
};
struct EpiKV {
    static constexpr bool PERM = true, AFTER_DRAIN = false;
    bf16_t* KVb; const ssum_t* sskv;
    __device__ __forceinline__ void operator()(const pg8::f32x4 (&acc)[2][2][4][2], const pg8::Unit& u, int wr, int wc, int fr, int fq) const {
        const int row0 = u.pm * 256 + wr * 64 + fr, col0 = u.pn * 256 + wc * 32 + 8 * fq;
#pragma unroll
        for (int ai = 0; ai < 2; ++ai)
#pragma unroll
            for (int m = 0; m < 4; ++m) {
                const int row = row0 + ai * 128 + m * 16;
                const float rs = rsqrtf(ldfx(sskv + row) * (1.0f / 256.0f) + EPS);
#pragma unroll
                for (int bj = 0; bj < 2; ++bj) {
                    const f32x4 v0 = acc[ai][bj][m][0] * rs, v1 = acc[ai][bj][m][1] * rs;
                    u32x4 w; w.x = pg8::cvt_pk_bf16(v0[0], v0[1]); w.y = pg8::cvt_pk_bf16(v0[2], v0[3]); w.z = pg8::cvt_pk_bf16(v1[0], v1[1]); w.w = pg8::cvt_pk_bf16(v1[2], v1[3]);
                    *(u32x4*)(KVb + (size_t)row * DKV + col0 + bj * 128) = w;
                }
                asm volatile("" ::: "memory");
            }
    }
};
struct EpiOut {
    static constexpr bool PERM = true, AFTER_DRAIN = false;
    bf16_t* XB; ssum_t* ssn;
    __device__ __forceinline__ void operator()(const pg8::f32x4 (&acc)[2][2][4][2], const pg8::Unit& u, int wr, int wc, int fr, int fq) const {
        const int row0 = u.pm * 256 + wr * 64 + fr, col0 = u.pn * 256 + wc * 32 + 8 * fq;
#pragma unroll
        for (int ai = 0; ai < 2; ++ai)
#pragma unroll
            for (int m = 0; m < 4; ++m) {
                const int row = row0 + ai * 128 + m * 16;
                float s = 0.f;
#pragma unroll
                for (int bj = 0; bj < 2; ++bj) {
                    const size_t off = (size_t)row * DM + col0 + bj * 128;
                    const u32x4 xw = *(const u32x4*)(XB + off);
                    const f32x4 v0 = (f32x4){bflo(xw.x), bfhi(xw.x), bflo(xw.y), bfhi(xw.y)} + acc[ai][bj][m][0], v1 = (f32x4){bflo(xw.z), bfhi(xw.z), bflo(xw.w), bfhi(xw.w)} + acc[ai][bj][m][1];
                    u32x4 w; w.x = pg8::cvt_pk_bf16(v0[0], v0[1]); w.y = pg8::cvt_pk_bf16(v0[2], v0[3]); w.z = pg8::cvt_pk_bf16(v1[0], v1[1]); w.w = pg8::cvt_pk_bf16(v1[2], v1[3]);
                    *(u32x4*)(XB + off) = w;
                    s += (v0[0] * v0[0] + v0[1] * v0[1]) + (v0[2] * v0[2] + v0[3] * v0[3]) + (v1[0] * v1[0] + v1[1] * v1[1]) + (v1[2] * v1[2] + v1[3] * v1[3]);
                }
                s += __shfl_xor(s, 16); s += __shfl_xor(s, 32);
                if (fq == 0) atomic_addf(ssn + row, s);
                asm volatile("" ::: "memory");
            }
    }
};

struct EpiAll {
    static constexpr bool PERM = true, AFTER_DRAIN = false;
    int mode; void* a; void* b; void* c; void* d;
    __device__ __forceinline__ void operator()(const pg8::f32x4 (&acc)[2][2][4][2], const pg8::Unit& u, int wr, int wc, int fr, int fq) const {
#ifdef ONLY_MODE
        if (mode != ONLY_MODE) return;
#endif
        if (mode == 0) { EpiZ E{(bf16_t*)a, (const ssum_t*)b, (ssum_t*)c, (ssum_t*)d}; E(acc, u, wr, wc, fr, fq); }
        else if (mode == 1) { EpiQ E{(bf16_t*)a, (const ssum_t*)b, (const float*)c, (const float*)d}; E(acc, u, wr, wc, fr, fq); }
        else if (mode == 2) { EpiKV E{(bf16_t*)a, (const ssum_t*)b}; E(acc, u, wr, wc, fr, fq); }
        else { EpiOut E{(bf16_t*)c, (ssum_t*)d}; E(acc, u, wr, wc, fr, fq); }
    }
};

__device__ __forceinline__ void p0_transpose_item(const float* W, int N, const float* g, bf16_t* WT, int ldt, LAS float* scr, int item, int lane) {
    const int nblk = N / 32, kb = item / nblk, nb = item % nblk, k0 = 64 * kb, n0 = 32 * nb;
#pragma unroll 8
    for (int i = 0; i < 32; ++i) { const int kk = 2 * i + (lane >> 5); float v = W[(size_t)(k0 + kk) * N + n0 + (lane & 31)]; if (g) v *= g[k0 + kk]; scr[kk * 33 + (lane & 31)] = v; }
    LDS_WAIT(); asm volatile("" ::: "memory");
    const int c = lane & 7;
#pragma unroll
    for (int j = 0; j < 4; ++j) { const int n = (lane >> 3) + 8 * j; const LAS float* s = scr + (8 * c) * 33 + n;
        u32x4 o; o.x = pk2(s[0 * 33], s[1 * 33]); o.y = pk2(s[2 * 33], s[3 * 33]); o.z = pk2(s[4 * 33], s[5 * 33]); o.w = pk2(s[6 * 33], s[7 * 33]);
        *(u32x4*)(WT + (size_t)(n0 + n) * ldt + k0 + 8 * c) = o; }
    LDS_WAIT(); asm volatile("" ::: "memory");
}
__device__ __forceinline__ void convert_layer_weights(Frame& F, int l, int gw, int NGW) {
    LAS float* scr = (LAS float*)(F.lds + F.wave * 16384);
    const int lane = F.lane;
    unsigned char* ws = F.ws;
    constexpr int I_IN = 16 * 73, I_OUT = 16 * 32, I_UQ = 6 * 18, I_UKV = 4 * 24, I_G = 12, I_P = 8;
    constexpr int I_L = I_IN + I_OUT + I_UQ + I_UKV + 2 * I_G + I_P;
    for (int it = gw; it < I_L; it += NGW) {
        int r = it;
        if (r < I_IN) { p0_transpose_item(kin(2) + (size_t)l * 1024 * D_IN, D_IN, kin(1) + l * 1024, (bf16_t*)(ws + WS_WIN) + (size_t)l * ZW * 1024, 1024, scr, r, lane); continue; } r -= I_IN;
        if (r < I_OUT) { p0_transpose_item(kin(16) + (size_t)l * 1024 * 1024, 1024, nullptr, (bf16_t*)(ws + WS_WOUT) + (size_t)l * 1024 * 1024, 1024, scr, r, lane); continue; } r -= I_OUT;
        if (r < I_UQ) { p0_transpose_item(kin(11) + (size_t)l * 384 * DQ, DQ, kin(10) + l * 384, (bf16_t*)(ws + WS_WUQ) + (size_t)l * 768 * 384, 384, scr, r, lane); continue; } r -= I_UQ;
        if (r < I_UKV) { p0_transpose_item(kin(13) + (size_t)l * 256 * DKV, DKV, kin(12) + l * 256, (bf16_t*)(ws + WS_WUKV) + (size_t)l * 768 * 256, 256, scr, r, lane); continue; } r -= I_UKV;
        if (r < I_G) { const int h = r >> 1; p0_transpose_item(kin(5) + (size_t)(l * 6 + h) * 4096, 64, nullptr, (bf16_t*)(ws + WS_SMALL) + (size_t)(l * 6 + h) * 4096, 64, scr, r & 1, lane); continue; } r -= I_G;
        if (r < I_G) { const int h = r >> 1; p0_transpose_item(kin(7) + (size_t)(l * 6 + h) * 4096, 64, nullptr, (bf16_t*)(ws + WS_SMALL + 196608) + (size_t)(l * 6 + h) * 4096, 64, scr, r & 1, lane); continue; } r -= I_G;
        { const int gq = r >> 1; p0_transpose_item(kin(14) + (size_t)(l * 4 + gq) * 4096, 64, nullptr, (bf16_t*)(ws + WS_SMALL + 393216) + (size_t)(l * 4 + gq) * 4096, 64, scr, r & 1, lane); }
    }
}
__device__ __forceinline__ void phase_prologue(Frame& F) {
    const int gw = F.bid * NWAVES + F.wave, NGW = F.G * NWAVES, lane = F.lane;
    unsigned char* ws = F.ws;
    convert_layer_weights(F, 0, gw, NGW);
    if (F.G != 256) { for (int l = 1; l < NL; ++l) convert_layer_weights(F, l, gw, NGW); }
    {
        const int gt = F.bid * NTHREADS + F.tid, NGT = F.G * NTHREADS;
        constexpr int ZIN = 224 * 1024 * 2 / 16, ZUQ = 192 * 384 * 2 / 16;
        for (int i = gt; i < NL * (ZIN + ZUQ); i += NGT) {
            const int l = i / (ZIN + ZUQ), r = i % (ZIN + ZUQ);
            u32x4* p = (r < ZIN) ? (u32x4*)(ws + WS_WIN + ((size_t)l * ZW + D_IN) * 1024 * 2) + r : (u32x4*)(ws + WS_WUQ + ((size_t)l * 768 + DQ) * 384 * 2) + (r - ZIN);
            *p = (u32x4){0u, 0u, 0u, 0u};
        }
        float* SP = (float*)(ws + WS_SMALL + 524288);
        for (int i = gt; i < NL * DLRU; i += NGT) SP[i] = log1pf(expf(-kin(9)[i]));
        float* cosT = (float*)(ws + WS_ROPE); float* sinT = cosT + SEQ * 16;
        for (int i = gt; i < SEQ * 16; i += NGT) {
            const int pos = i >> 4, fi = i & 15, j = fi & 3, k = fi >> 2;
            double inv = (j == 0) ? 1.0 : (j == 1) ? 0.56234132519034908 : (j == 2) ? 0.31622776601683794 : 0.17782794100389228;
            inv *= (k == 0) ? 1.0 : (k == 1) ? 0.1 : (k == 2) ? 0.01 : 0.001;
            const double ang = (double)pos * inv;
            const double n = __builtin_rint(ang * 0.15915494309189535);
            double rr = __builtin_fma(-n, 6.283185307179586, ang); rr = __builtin_fma(-n, 2.4492935982947064e-16, rr);
            const double r2 = rr * rr; double tc = 1.0, sc = 1.0, tsn = rr, ss = rr;
#pragma unroll 1
            for (int q = 1; q <= 15; ++q) { tc *= -r2 / (double)((2 * q - 1) * (2 * q)); sc += tc; tsn *= -r2 / (double)((2 * q) * (2 * q + 1)); ss += tsn; }
            cosT[i] = (float)sc; sinT[i] = (float)ss;
        }
    }
    {
        const float* x = kin(0); bf16_t* XB = (bf16_t*)(ws + WS_XB); ssum_t* ssx = (ssum_t*)(ws + WS_ACC + OFF_SSX);
#pragma unroll 4
        for (int m = gw; m < M; m += NGW) {
            const f32x4* xr = (const f32x4*)(x + (size_t)m * DM) + lane; u32x2* o = (u32x2*)(XB + (size_t)m * DM) + lane;
            float s = 0.f;
#pragma unroll
            for (int j = 0; j < 4; ++j) { const f32x4 v = xr[64 * j]; s += (v.x * v.x + v.y * v.y) + (v.z * v.z + v.w * v.w); o[64 * j] = (u32x2){pk2(v.x, v.y), pk2(v.z, v.w)}; }
            s = wave_sum(s);
            if (lane == 0) ssx[m] = (ssum_t)(s * 16777216.0f);
        }
    }
}

__device__ __forceinline__ bf16x8 ld_x_frag(const LAS float* p) {
    const f32x4 a = *(const LAS f32x4*)p, b = *(const LAS f32x4*)(p + 4);
    u32x4 w; w.x = pg8::cvt_pk_bf16(a[0], a[1]); w.y = pg8::cvt_pk_bf16(a[2], a[3]); w.z = pg8::cvt_pk_bf16(b[0], b[1]); w.w = pg8::cvt_pk_bf16(b[2], b[3]);
    return __builtin_bit_cast(bf16x8, w);
}
constexpr int XAP16 = 392, PLP16 = 264;
constexpr int L2_LA = 64 * XAP16 * 2, L2_UU = L2_LA + 64 * DLRU * 2, L2_END = L2_UU + 64 * DLRU * 2;
static_assert(L2_END <= 150016, "phase-2 LDS map (below the barrier's LDS words)");
template <int W> __device__ __forceinline__ void pool_rows(const float (&c0)[31], const float (&c1)[31], const float (&v0)[31], const float (&v1)[31], int tpos0, LAS bf16_t* dst) {
#pragma unroll
    for (int j = 0; j < 16; ++j) {
        const int idx = 15 + j; const int tp = tpos0 + j;
        float s0 = c0[idx], s1 = c1[idx];
        if (idx - W >= 0) { s0 -= c0[idx - W >= 0 ? idx - W : 0]; s1 -= c1[idx - W >= 0 ? idx - W : 0]; }
        const float cnt = (float)((tp + 1 < W) ? tp + 1 : W);
        *(LAS unsigned*)(dst + j * PLP16) = pg8::cvt_pk_bf16(s0 / cnt - v0[idx], s1 / cnt - v1[idx]);
    }
}
__device__ __forceinline__ void phase2_tile(Frame& F, int l, int u) {
    const int tid = F.tid, lane = F.lane, wave = F.wave;
    unsigned char* ws = F.ws;
    const bf16_t* Z = (const bf16_t*)(ws + WS_Z);
    const int row0 = u * 64, t0 = (u & 127) * 64;
    LAS bf16_t* XA = (LAS bf16_t*)F.lds;
    LAS bf16_t* LA = (LAS bf16_t*)(F.lds + L2_LA); LAS bf16_t* UU = (LAS bf16_t*)(F.lds + L2_UU);
    bf16_t* A16 = (bf16_t*)(ws + WS_A32); bf16_t* U16 = (bf16_t*)(ws + WS_U32);
    if (tid < 384) {
        const int p = tid % 192, half = tid / 192, c = 2 * p;
        const float* cw = kin(3) + (size_t)l * 4 * DLRU; const float* cb = kin(4) + (size_t)l * DLRU;
        const f32x2 w0 = *(const f32x2*)(cw + c), w1 = *(const f32x2*)(cw + DLRU + c), w2 = *(const f32x2*)(cw + 2 * DLRU + c), w3 = *(const f32x2*)(cw + 3 * DLRU + c), bb = *(const f32x2*)(cb + c);
        const int ts = t0 + 32 * half;
        const bf16_t* zp = Z + (size_t)(row0 + 32 * half) * ZW + Z_ZA + c;
        unsigned zr[35];
#pragma unroll
        for (int j = 0; j < 35; ++j) { zr[j] = 0u; if (j >= 3 || ts >= 3) zr[j] = *(const unsigned*)(zp + (ptrdiff_t)(j - 3) * ZW); }
#pragma unroll
        for (int j = 0; j < 32; ++j) {
            const f32x2 x0 = {bflo(zr[j]), bfhi(zr[j])}, x1 = {bflo(zr[j + 1]), bfhi(zr[j + 1])}, x2 = {bflo(zr[j + 2]), bfhi(zr[j + 2])}, x3 = {bflo(zr[j + 3]), bfhi(zr[j + 3])};
            const f32x2 y = bb + w0 * x0 + w1 * x1 + w2 * x2 + w3 * x3;
            *(LAS unsigned*)(XA + (32 * half + j) * XAP16 + c) = pg8::cvt_pk_bf16(y.x, y.y);
        }
    } else {
        const float* cosT = (const float*)(ws + WS_ROPE); const float* sinT = cosT + SEQ * 16;
        bf16_t* KR = (bf16_t*)((unsigned char*)F.out + OUT_KR);
        float ka[8], kb2[8], kc[8], ks[8];
#pragma unroll
        for (int q = 0; q < 8; ++q) { const int it = tid - 384 + 128 * q, tk = it >> 4, i = it & 15, row = row0 + tk, pos = t0 + tk;
            ka[q] = bf2f(Z[(size_t)row * ZW + Z_KR + i]); kb2[q] = bf2f(Z[(size_t)row * ZW + Z_KR + 16 + i]); kc[q] = cosT[pos * 16 + i]; ks[q] = sinT[pos * 16 + i]; }
#pragma unroll
        for (int q = 0; q < 8; ++q) { const int it = tid - 384 + 128 * q, tk = it >> 4, i = it & 15, row = row0 + tk;
            KR[(size_t)row * 32 + i] = (bf16_t)f2bf(ka[q] * kc[q] - kb2[q] * ks[q]); KR[(size_t)row * 32 + 16 + i] = (bf16_t)f2bf(ka[q] * ks[q] + kb2[q] * kc[q]); }
    }
    __syncthreads();
    {
        const int mt = wave & 3, hg = wave >> 2, fr = lane & 15, fq = lane >> 4;
        const bf16_t* Wr = (const bf16_t*)(ws + WS_SMALL) + (size_t)l * 6 * 4096; const bf16_t* Wi = (const bf16_t*)(ws + WS_SMALL + 196608) + (size_t)l * 6 * 4096;
        const float* br = kin(6) + l * DLRU; const float* bi = kin(8) + l * DLRU; const float* SP = (const float*)(ws + WS_SMALL + 524288) + l * DLRU;
        const LAS bf16_t* xrow = XA + (16 * mt + fr) * XAP16; const int lrow = (16 * mt + fr) * DLRU;
        const size_t grow = (size_t)(row0 + 16 * mt + fr) * DLRU;
#pragma unroll 1
        for (int hh = 0; hh < 3; ++hh) {
            const int h = 3 * hg + hh;
            const bf16x8 xb0 = *(const LAS bf16x8*)(xrow + 64 * h + 8 * fq), xb1 = *(const LAS bf16x8*)(xrow + 64 * h + 32 + 8 * fq);
            bf16x8 wfr[4][4]; f32x4 brq[4], biq[4], spq[4];
#pragma unroll
            for (int nt = 0; nt < 4; ++nt) {
                const bf16_t* wr_ = Wr + (size_t)h * 4096 + (16 * nt + fr) * 64 + 8 * fq; const bf16_t* wi_ = Wi + (size_t)h * 4096 + (16 * nt + fr) * 64 + 8 * fq;
                wfr[nt][0] = *(const bf16x8*)wr_; wfr[nt][1] = *(const bf16x8*)(wr_ + 32); wfr[nt][2] = *(const bf16x8*)wi_; wfr[nt][3] = *(const bf16x8*)(wi_ + 32);
                const int c = 64 * h + 16 * nt + 4 * fq;
                brq[nt] = *(const f32x4*)(br + c); biq[nt] = *(const f32x4*)(bi + c); spq[nt] = *(const f32x4*)(SP + c);
            }
#pragma unroll
            for (int nt = 0; nt < 4; ++nt) {
                const bf16x8 ar0 = wfr[nt][0], ar1 = wfr[nt][1], ai0 = wfr[nt][2], ai1 = wfr[nt][3];
                f32x4 accR = {0.f, 0.f, 0.f, 0.f}, accI = {0.f, 0.f, 0.f, 0.f};
                accR = __builtin_amdgcn_mfma_f32_16x16x32_bf16(ar0, xb0, accR, 0, 0, 0); accR = __builtin_amdgcn_mfma_f32_16x16x32_bf16(ar1, xb1, accR, 0, 0, 0);
                accI = __builtin_amdgcn_mfma_f32_16x16x32_bf16(ai0, xb0, accI, 0, 0, 0); accI = __builtin_amdgcn_mfma_f32_16x16x32_bf16(ai1, xb1, accI, 0, 0, 0);
                const int c = 64 * h + 16 * nt + 4 * fq;
                const u32x2 xw_ = *(const LAS u32x2*)(xrow + c);
                const f32x4 brv = brq[nt], biv = biq[nt], spv = spq[nt], xav = {bflo(xw_.x), bfhi(xw_.x), bflo(xw_.y), bfhi(xw_.y)};
                f32x4 lv, uv;
#pragma unroll
                for (int v = 0; v < 4; ++v) {
                    const float r = fast_sigmoid(accR[v] + brv[v]), ig = fast_sigmoid(accI[v] + biv[v]);
                    const float la = -8.0f * r * spv[v];
                    lv[v] = la; uv[v] = __builtin_amdgcn_sqrtf(neg_expm1(2.0f * la)) * (ig * xav[v]);
                }
                *(LAS u32x2*)(LA + lrow + c) = (u32x2){pg8::cvt_pk_bf16(lv[0], lv[1]), pg8::cvt_pk_bf16(lv[2], lv[3])};
                *(LAS u32x2*)(UU + lrow + c) = (u32x2){pg8::cvt_pk_bf16(uv[0], uv[1]), pg8::cvt_pk_bf16(uv[2], uv[3])};
            }
        }
    }
    __syncthreads();
    unsigned zpool[31];
    {
        const int p_ = tid & 127, tq_ = tid >> 7, c_ = 2 * p_, tp0_ = t0 + 16 * tq_;
#pragma unroll
        for (int i = 0; i < 31; ++i) { zpool[i] = 0u; if (tp0_ - 15 + i >= 0) zpool[i] = *(const unsigned*)(Z + (size_t)(row0 + 16 * tq_ - 15 + i) * ZW + Z_ZC + c_); }
    }
    if (tid < DLRU) {
        float ap = 1.0f, hh = 0.0f;
        bf16_t* ar = A16 + (size_t)row0 * DLRU + tid; bf16_t* ur = U16 + (size_t)row0 * DLRU + tid;
#pragma unroll 1
        for (int jb = 0; jb < 64; jb += 16) {
            unsigned short lq[16], uq16[16], pq[16], hq[16];
#pragma unroll
            for (int j = 0; j < 16; ++j) { lq[j] = LA[(jb + j) * DLRU + tid]; uq16[j] = UU[(jb + j) * DLRU + tid]; }
#pragma unroll
            for (int j = 0; j < 16; ++j) { const float a = __expf(bf2f(lq[j])); hh = a * hh + bf2f(uq16[j]); ap *= a; const unsigned w_ = pg8::cvt_pk_bf16(ap, hh); pq[j] = (unsigned short)(w_ & 0xffffu); hq[j] = (unsigned short)(w_ >> 16); }
#pragma unroll
            for (int j = 0; j < 16; ++j) { ar[(size_t)(jb + j) * DLRU] = pq[j]; ur[(size_t)(jb + j) * DLRU] = hq[j]; }
        }
        float* CA = (float*)(ws + WS_CHS); float* CH = CA + 256 * DLRU;
        CA[u * DLRU + tid] = ap; CH[u * DLRU + tid] = hh;
    }
    LAS bf16_t* PL = (LAS bf16_t*)F.lds;
    {
        const int p = tid & 127, tq = tid >> 7, c = 2 * p, g = c >> 6;
        const int tp0 = t0 + 16 * tq;
        float v0[31], v1[31], c0[31], c1[31];
#pragma unroll
        for (int i = 0; i < 31; ++i) {
            const unsigned a = zpool[i];
            v0[i] = bflo(a); v1[i] = bfhi(a);
            c0[i] = (i ? c0[i - 1] : 0.f) + v0[i]; c1[i] = (i ? c1[i - 1] : 0.f) + v1[i];
        }
        LAS bf16_t* dst = PL + (16 * tq) * PLP16 + c;
        if (g == 0) pool_rows<2>(c0, c1, v0, v1, tp0, dst); else if (g == 1) pool_rows<4>(c0, c1, v0, v1, tp0, dst); else if (g == 2) pool_rows<8>(c0, c1, v0, v1, tp0, dst); else pool_rows<16>(c0, c1, v0, v1, tp0, dst);
    }
    __syncthreads();
    {
        const int mt = wave & 3, gg = wave >> 2, fr = lane & 15, fq = lane >> 4;
        const bf16_t* Wp = (const bf16_t*)(ws + WS_SMALL + 393216) + (size_t)l * 4 * 4096; const float* psc = kin(15) + l * DPOOL;
        bf16_t* Y = (bf16_t*)(ws + WS_Y);
        const LAS bf16_t* prow = PL + (16 * mt + fr) * PLP16; const size_t row = (size_t)(row0 + 16 * mt + fr);
        u32x2 gcq[2][4]; f32x4 psq[2][4]; bf16x8 wpq[2][4][2];
#pragma unroll
        for (int q = 0; q < 2; ++q)
#pragma unroll
            for (int nt = 0; nt < 4; ++nt) { const int g = 2 * gg + q, c = 64 * g + 16 * nt + 4 * fq;
                gcq[q][nt] = *(const u32x2*)(Z + row * ZW + Z_GC + c); psq[q][nt] = *(const f32x4*)(psc + c);
                const bf16_t* wp_ = Wp + (size_t)g * 4096 + (16 * nt + fr) * 64 + 8 * fq; wpq[q][nt][0] = *(const bf16x8*)wp_; wpq[q][nt][1] = *(const bf16x8*)(wp_ + 32); }
#pragma unroll
        for (int q = 0; q < 2; ++q) {
            const int g = 2 * gg + q;
            const bf16x8 xb0 = *(const LAS bf16x8*)(prow + 64 * g + 8 * fq), xb1 = *(const LAS bf16x8*)(prow + 64 * g + 32 + 8 * fq);
#pragma unroll
            for (int nt = 0; nt < 4; ++nt) {
                const bf16x8 a0 = wpq[q][nt][0], a1 = wpq[q][nt][1];
                f32x4 acc = {0.f, 0.f, 0.f, 0.f};
                acc = __builtin_amdgcn_mfma_f32_16x16x32_bf16(a0, xb0, acc, 0, 0, 0); acc = __builtin_amdgcn_mfma_f32_16x16x32_bf16(a1, xb1, acc, 0, 0, 0);
                const int c = 64 * g + 16 * nt + 4 * fq;
                const f32x4 ps = psq[q][nt]; const u32x2 gw_ = gcq[q][nt];
                const float y0 = acc[0] * ps[0] * siluf_(bflo(gw_.x)), y1 = acc[1] * ps[1] * siluf_(bfhi(gw_.x)), y2 = acc[2] * ps[2] * siluf_(bflo(gw_.y)), y3 = acc[3] * ps[3] * siluf_(bfhi(gw_.y));
                *(u32x2*)(Y + row * DM + 768 + c) = (u32x2){pg8::cvt_pk_bf16(y0, y1), pg8::cvt_pk_bf16(y2, y3)};
            }
        }
    }
    __syncthreads();
}

__device__ __forceinline__ void lru_final_unit(Frame& F, int u) {
    const int tid = F.tid; unsigned char* ws = F.ws;
    LAS float* carry = (LAS float*)F.lds;
    if (tid < DLRU) {
        const float* CA = (const float*)(ws + WS_CHS); const float* CH = CA + 256 * DLRU;
        const int b0 = u & ~127;
        float hh = 0.f;
#pragma unroll 16
        for (int j = b0; j < u; ++j) hh = CA[j * DLRU + tid] * hh + CH[j * DLRU + tid];
        carry[tid] = hh;
    }
    __syncthreads();
    const bf16_t* PA = (const bf16_t*)(ws + WS_A32) + (size_t)u * 64 * DLRU; const bf16_t* HL = (const bf16_t*)(ws + WS_U32) + (size_t)u * 64 * DLRU;
    const bf16_t* zg = (const bf16_t*)(ws + WS_Z) + (size_t)u * 64 * ZW + Z_GA; bf16_t* Y = (bf16_t*)(ws + WS_Y) + (size_t)u * 64 * DM;
#pragma unroll
    for (int k0 = 0; k0 < 12; k0 += 6) {
        u32x2 pq[6], hq[6]; u32x2 gq[6];
#pragma unroll
        for (int k = 0; k < 6; ++k) { const int idx = tid + NTHREADS * (k0 + k), row = idx / 96, c = 4 * (idx % 96);
            pq[k] = *(const u32x2*)(PA + (size_t)row * DLRU + c); hq[k] = *(const u32x2*)(HL + (size_t)row * DLRU + c); gq[k] = *(const u32x2*)(zg + (size_t)row * ZW + c); }
#pragma unroll
        for (int k = 0; k < 6; ++k) { const int idx = tid + NTHREADS * (k0 + k), row = idx / 96, c = 4 * (idx % 96);
            const f32x4 cr = *(const LAS f32x4*)(carry + c);
            const f32x4 pv = {bflo(pq[k].x), bfhi(pq[k].x), bflo(pq[k].y), bfhi(pq[k].y)}, hv = {bflo(hq[k].x), bfhi(hq[k].x), bflo(hq[k].y), bfhi(hq[k].y)};
            const f32x4 h = hv + pv * cr; const u32x2 gw_ = gq[k];
            const float y0 = h[0] * siluf_(bflo(gw_.x)), y1 = h[1] * siluf_(bfhi(gw_.x)), y2 = h[2] * siluf_(bflo(gw_.y)), y3 = h[3] * siluf_(bfhi(gw_.y));
            *(u32x2*)(Y + (size_t)row * DM + c) = (u32x2){pg8::cvt_pk_bf16(y0, y1), pg8::cvt_pk_bf16(y2, y3)}; }
    }
    __syncthreads();
}

namespace att {
constexpr int KSLOT = 12288, VSLOT = 8192;
constexpr int L_K = 0, L_V = 3 * KSLOT, L_WS = L_V + 3 * VSLOT, L_OST = L_WS + NWAVES * 256, L_END = L_OST + NWAVES * 8192;
static_assert(L_END <= 131072, "attention LDS");
__device__ __forceinline__ int crow(int r, int hi) { return (r & 3) + 8 * (r >> 2) + 4 * hi; }
__device__ __forceinline__ void glds16(const void* gsrc, unsigned lds_dst) {
    unsigned keep;
    asm volatile("s_mov_b32 %0, m0\n\ts_mov_b32 m0, %2\n\ts_nop 0\n\tglobal_load_lds_dwordx4 %1, off\n\ts_mov_b32 m0, %0" : "=&s"(keep) : "v"(gsrc), "s"(lds_dst) : "memory");
}
__device__ __forceinline__ void glds16s(const void* sbase, unsigned voff, unsigned lds_dst) {
    unsigned keep;
    asm volatile("s_mov_b32 %0, m0\n\ts_mov_b32 m0, %3\n\ts_nop 0\n\tglobal_load_lds_dwordx4 %1, %2\n\ts_mov_b32 m0, %0" : "=&s"(keep) : "v"(voff), "s"(sbase), "s"(lds_dst) : "memory");
}
typedef short v4i16_t __attribute__((ext_vector_type(4)));
__device__ __forceinline__ s16x4 vtr(const LAS char* p) { return __builtin_bit_cast(s16x4, __builtin_amdgcn_ds_read_tr16_b64_v4i16((LAS v4i16_t*)p)); }
typedef float f32x2_t __attribute__((ext_vector_type(2))); typedef __bf16 bf16x2_t __attribute__((ext_vector_type(2)));
__device__ __forceinline__ unsigned cvtpk_s(float lo, float hi) { f32x2_t v = {lo, hi}; bf16x2_t b = __builtin_convertvector(v, bf16x2_t); return __builtin_bit_cast(unsigned, b); }
__device__ __forceinline__ float swapmax(float m) { auto rr = __builtin_amdgcn_permlane32_swap(__float_as_uint(m), __float_as_uint(m), false, false); return fmaxf(__uint_as_float(rr[0]), __uint_as_float(rr[1])); }
__device__ __forceinline__ float swapsum(float m) { auto rr = __builtin_amdgcn_permlane32_swap(__float_as_uint(m), __float_as_uint(m), false, false); return __uint_as_float(rr[0]) + __uint_as_float(rr[1]); }
#define ATT_WAIT_BAR() asm volatile("s_waitcnt vmcnt(0) lgkmcnt(0)\n\ts_barrier" ::: "memory")

__device__ __forceinline__ void attn_unit(Frame& F, int b, int h, int qb) {
    const int lane = F.lane, r32 = lane & 31, hi = lane >> 5, wid = F.wave;
    unsigned char* ws = F.ws;
    const bf16_t* Q = (const bf16_t*)((const unsigned char*)F.out + OUT_Q); const bf16_t* KV = (const bf16_t*)(ws + WS_KV); const bf16_t* KR = (const bf16_t*)((const unsigned char*)F.out + OUT_KR);
    const LAS char* shm = (const LAS char*)F.lds;
    const unsigned lds0 = (unsigned)(uintptr_t)F.lds;
    const long rowbase = (long)b * SEQ; const int q0 = qb * 256;
    const bf16_t* kbase = KV + rowbase * DKV + h * 128 + wid * 8;
    const bf16_t* krbase = KR + rowbase * 32 + (wid & 3) * 8;
    const bf16_t* vbase = KV + (rowbase + 16 * (wid & 3)) * DKV + h * 128 + 64 + (wid >> 2) * 32;
    const unsigned kroffv = (unsigned)lane * 64u, voffv = (unsigned)(lane >> 2) * (DKV * 2) + (unsigned)(lane & 3) * 16u;
    const unsigned kdst = (unsigned)__builtin_amdgcn_readfirstlane(lds0 + L_K + wid * 1024), krdst = kdst + 8 * 1024  , vdst = kdst + (L_V - L_K);
#define ATT_ISSUE_K(t, sl) do { unsigned ko_ = kroffv; asm volatile("" : "+v"(ko_));   glds16s(kbase + (long)(t) * 64 * DKV, ko_ * 24u, kdst + (sl) * KSLOT); if (wid < 4) glds16s(krbase + (long)(t) * 64 * 32, kroffv, krdst + (sl) * KSLOT); } while (0)
#define ATT_ISSUE_V(t, sl) do { glds16s(vbase + (long)(t) * 64 * DKV, voffv, vdst + (sl) * VSLOT); } while (0)
#define ATT_QK(P0, P1, sl) do { const LAS char* kb_ = kfb + (sl) * KSLOT; P0 = f32x16{}; P1 = f32x16{}; \
        _Pragma("unroll") for (int d0 = 0; d0 < 6; ++d0) { \
            const bf16x8 k0_ = *(const LAS bf16x8*)(kb_ + d0 * 2048), k1_ = *(const LAS bf16x8*)(kb_ + d0 * 2048 + 512); \
            P0 = __builtin_amdgcn_mfma_f32_32x32x16_bf16(k0_, qr[d0], P0, 0, 0, 0); \
            P1 = __builtin_amdgcn_mfma_f32_32x32x16_bf16(k1_, qr[d0], P1, 0, 0, 0); } } while (0)
#define MX3(a, b, c) __builtin_fmaxf(__builtin_fmaxf((a), (b)), (c))
#define ATT_THR 8.0f
#define ATT_QKN(P0, P1, sl) do { const LAS char* kb_ = kfb + (sl) * KSLOT; \
        _Pragma("unroll") for (int d0 = 0; d0 < 6; ++d0) { \
            const bf16x8 k0_ = *(const LAS bf16x8*)(kb_ + d0 * 2048), k1_ = *(const LAS bf16x8*)(kb_ + d0 * 2048 + 512); \
            if (d0 == 0) { P0 = __builtin_amdgcn_mfma_f32_32x32x16_bf16(k0_, qr[0], negm, 0, 0, 0); P1 = __builtin_amdgcn_mfma_f32_32x32x16_bf16(k1_, qr[0], negm, 0, 0, 0); } \
            else { P0 = __builtin_amdgcn_mfma_f32_32x32x16_bf16(k0_, qr[d0], P0, 0, 0, 0); P1 = __builtin_amdgcn_mfma_f32_32x32x16_bf16(k1_, qr[d0], P1, 0, 0, 0); } } } while (0)
#define ATT_VF(d0, ks) ({ const s16x4 lo_ = vtr(vb + (d0) * 4096 + (ks) * 1024), hi_ = vtr(vb + (d0) * 4096 + (ks) * 1024 + 512); (bf16x8){lo_[0], lo_[1], lo_[2], lo_[3], hi_[0], hi_[1], hi_[2], hi_[3]}; })
#define ATT_STEP(C0, C1, N0, N1, tt) do { \
        ATT_WAIT_BAR(); \
        const int sl = (tt) & 1; \
        if ((tt) + 2 < NT) ATT_ISSUE_K((tt) + 2, sl); \
        if ((tt) + 1 < NT) ATT_ISSUE_V((tt) + 1, sl ^ 1); \
        if ((tt) <= tmax) { \
            if ((tt) == tmax) { const int kbase = 64 * (tt); \
                _Pragma("unroll") for (int r = 0; r < 16; ++r) { const int kv = kbase + crow(r, hi); if (kv > qabs) C0[r] = -INFINITY; if (kv + 32 > qabs) C1[r] = -INFINITY; } } \
            float ra = MX3(C0[0], C0[1], C1[0]), rb = MX3(C0[2], C0[3], C1[1]); ra = MX3(ra, C1[2], C1[3]); \
            _Pragma("unroll") for (int r = 4; r < 16; r += 4) { ra = MX3(ra, C0[r], C0[r + 1]); rb = MX3(rb, C0[r + 2], C0[r + 3]); ra = MX3(ra, C1[r], C1[r + 1]); rb = MX3(rb, C1[r + 2], C1[r + 3]); } \
            const float rm = swapmax(fmaxf(ra, rb)); \
            if ((tt) == 0 || __any(rm > ATT_THR)) {                                     \
                const float dl = ((tt) == 0) ? rm : fmaxf(rm, 0.f); \
                mref += dl; \
                _Pragma("unroll") for (int r = 0; r < 16; ++r) { C0[r] -= dl; C1[r] -= dl; } \
                _Pragma("unroll") for (int r = 0; r < 16; ++r) negm[r] = -mref; \
                asm volatile("" : "+v"(negm)); \
                if ((tt) != 0) { const float f = __builtin_amdgcn_exp2f(-dl); lrun *= f; \
                    if (hi == 0) wsf[r32] = f; \
                    LDS_WAIT(); \
                    _Pragma("unroll") for (int g4 = 0; g4 < 4; ++g4) { const f32x4 fv = *(const LAS f32x4*)(wsf + 8 * g4 + 4 * hi); \
                        _Pragma("unroll") for (int j = 0; j < 4; ++j) { o0[4 * g4 + j] *= fv[j]; o1[4 * g4 + j] *= fv[j]; } } \
                    LDS_WAIT(); } \
            } \
            ATT_QKN(N0, N1, sl ^ 1);                                                    \
            _Pragma("unroll") for (int r = 0; r < 16; ++r) { C0[r] = __builtin_amdgcn_exp2f(C0[r]); C1[r] = __builtin_amdgcn_exp2f(C1[r]); } \
            float sa = C0[0];                                                           \
            _Pragma("unroll") for (int r = 1; r < 16; ++r) sa += C0[r]; \
            _Pragma("unroll") for (int r = 0; r < 16; ++r) sa += C1[r]; \
            lrun += sa; \
            const u32x4 pw0 = (u32x4){cvtpk_s(C0[0], C0[1]), cvtpk_s(C0[2], C0[3]), cvtpk_s(C0[4], C0[5]), cvtpk_s(C0[6], C0[7])}; \
            const u32x4 pw1 = (u32x4){cvtpk_s(C0[8], C0[9]), cvtpk_s(C0[10], C0[11]), cvtpk_s(C0[12], C0[13]), cvtpk_s(C0[14], C0[15])}; \
            const u32x4 pw2 = (u32x4){cvtpk_s(C1[0], C1[1]), cvtpk_s(C1[2], C1[3]), cvtpk_s(C1[4], C1[5]), cvtpk_s(C1[6], C1[7])}; \
            const u32x4 pw3 = (u32x4){cvtpk_s(C1[8], C1[9]), cvtpk_s(C1[10], C1[11]), cvtpk_s(C1[12], C1[13]), cvtpk_s(C1[14], C1[15])}; \
            const LAS char* vb = vfb + sl * VSLOT; \
            o0 = __builtin_amdgcn_mfma_f32_32x32x16_bf16(__builtin_bit_cast(bf16x8, pw0), ATT_VF(0, 0), o0, 0, 0, 0); \
            o1 = __builtin_amdgcn_mfma_f32_32x32x16_bf16(__builtin_bit_cast(bf16x8, pw0), ATT_VF(1, 0), o1, 0, 0, 0); \
            o0 = __builtin_amdgcn_mfma_f32_32x32x16_bf16(__builtin_bit_cast(bf16x8, pw1), ATT_VF(0, 1), o0, 0, 0, 0); \
            o1 = __builtin_amdgcn_mfma_f32_32x32x16_bf16(__builtin_bit_cast(bf16x8, pw1), ATT_VF(1, 1), o1, 0, 0, 0); \
            o0 = __builtin_amdgcn_mfma_f32_32x32x16_bf16(__builtin_bit_cast(bf16x8, pw2), ATT_VF(0, 2), o0, 0, 0, 0); \
            o1 = __builtin_amdgcn_mfma_f32_32x32x16_bf16(__builtin_bit_cast(bf16x8, pw2), ATT_VF(1, 2), o1, 0, 0, 0); \
            o0 = __builtin_amdgcn_mfma_f32_32x32x16_bf16(__builtin_bit_cast(bf16x8, pw3), ATT_VF(0, 3), o0, 0, 0, 0); \
            o1 = __builtin_amdgcn_mfma_f32_32x32x16_bf16(__builtin_bit_cast(bf16x8, pw3), ATT_VF(1, 3), o1, 0, 0, 0); \
        } } while (0)
    const int NT = 4 * qb + 4, tmax = 4 * qb + (wid >> 1);
    ATT_ISSUE_K(0, 0); ATT_ISSUE_V(0, 0); ATT_ISSUE_K(1, 1);
    bf16x8 qr[6];
    { const bf16_t* qp = Q + (rowbase + q0 + wid * 32 + r32) * DQ + h * 96 + hi * 8;
#pragma unroll
      for (int d0 = 0; d0 < 6; ++d0) qr[d0] = *(const bf16x8*)(qp + d0 * 16); }
    float mref = 0.f, lrun = 0.f;
    f32x16 o0 = {}, o1 = {};
    f32x16 negm = {}; asm volatile("" : "+v"(negm));
    LAS float* wsf = (LAS float*)(F.lds + L_WS) + wid * 64;
    const int qabs = q0 + wid * 32 + r32;
    const LAS char* kfb = shm + L_K + hi * 1024 + r32 * 16;
    const LAS char* vfb = shm + L_V + ((lane >> 4) & 1) * 32 + (lane & 3) * 8 + (4 * hi + ((lane & 15) >> 2)) * 64;
    f32x16 pa0, pa1, pb0, pb1;
    if (wid >= 4) __builtin_amdgcn_s_setprio(1);
    ATT_WAIT_BAR();
    ATT_QKN(pa0, pa1, 0);
#pragma unroll 1
    for (int t = 0; t < NT; t += 2) {
        ATT_STEP(pa0, pa1, pb0, pb1, t);
        ATT_STEP(pb0, pb1, pa0, pa1, t + 1);
    }
    __builtin_amdgcn_s_setprio(0);
#undef ATT_STEP
#undef ATT_VF
#undef ATT_QKN
#undef ATT_THR
#undef MX3
    {
        const bf16_t* Z = (const bf16_t*)((const unsigned char*)kin(19) + WS_Z); bf16_t* Y = (bf16_t*)((unsigned char*)kin(19) + WS_Y);
        int lane_e = lane; asm volatile("" : "+v"(lane_e));
        const float lt = swapsum(lrun);
        if (hi == 0) wsf[r32] = 1.0f / lt;
        LDS_WAIT();
        LAS float* stg = (LAS float*)(F.lds + L_OST) + wid * 2048;
#pragma unroll
        for (int g4 = 0; g4 < 4; ++g4) { const f32x4 f = *(const LAS f32x4*)(wsf + 8 * g4 + 4 * hi);
#pragma unroll
            for (int j = 0; j < 4; ++j) { const int r = 4 * g4 + j, orow = crow(r, hi); stg[orow * 64 + r32] = o0[r] * f[j]; stg[orow * 64 + 32 + r32] = o1[r] * f[j]; } }
        LDS_WAIT();
        const size_t grow0 = (size_t)(rowbase + q0 + wid * 32);
        u32x2 gbq[8];
#pragma unroll
        for (int i = 0; i < 8; ++i) { const int row = i * 4 + (lane_e >> 4), ch = lane_e & 15; gbq[i] = *(const u32x2*)(Z + (grow0 + row) * ZW + Z_GB + 64 * h + 4 * ch); }
#pragma unroll
        for (int i = 0; i < 8; ++i) {
            const int row = i * 4 + (lane_e >> 4), ch = lane_e & 15;
            const f32x4 ov = *(const LAS f32x4*)(stg + row * 64 + ch * 4);
            const u32x2 gw_ = gbq[i];
            const float y0 = ov[0] * siluf_(bflo(gw_.x)), y1 = ov[1] * siluf_(bfhi(gw_.x)), y2 = ov[2] * siluf_(bflo(gw_.y)), y3 = ov[3] * siluf_(bfhi(gw_.y));
            *(u32x2*)(Y + (grow0 + row) * DM + 384 + 64 * h + 4 * ch) = (u32x2){pg8::cvt_pk_bf16(y0, y1), pg8::cvt_pk_bf16(y2, y3)};
        }
        LDS_WAIT();
    }
#undef ATT_ISSUE_K
#undef ATT_ISSUE_V
}
}

__device__ __forceinline__ void phase_final(Frame& F) {
    const int gw = F.bid * NWAVES + F.wave, NGW = F.G * NWAVES, lane = F.lane;
    const ssum_t* ssx = (const ssum_t*)(F.ws + WS_ACC + OFF_SSX) + 4 * M; const float* g = kin(17);
    const bf16_t* XB = (const bf16_t*)(F.ws + WS_XB);
#pragma unroll 4
    for (int m = gw; m < M; m += NGW) {
        const u32x2* xr = (const u32x2*)(XB + (size_t)m * DM) + lane; f32x4* orow = (f32x4*)(F.out + (size_t)m * DM) + lane; const f32x4* gr = (const f32x4*)g + lane;
        const float rs = rsqrtf(ldfx(ssx + m) * (1.0f / 1024.0f) + EPS);
#pragma unroll
        for (int j = 0; j < 4; ++j) { const u32x2 w = xr[64 * j]; const f32x4 v = {bflo(w.x), bfhi(w.x), bflo(w.y), bfhi(w.y)}; orow[64 * j] = v * rs * gr[64 * j]; }
    }
}

#define XB_TMO      128
#define XB_XCNT(j)  (256  + 64 * (j))
#define XB_XSUB(j)  (1280 + 64 * (j))
#define XB_XGEN(j)  (2304 + 64 * (j))
#define XB_TOP      3328
#define XB_TOPGEN   3392
#define XCD_BAR_WORDS 3456
#define XB_SPIN_CAP (1u << 18)

__device__ __forceinline__ unsigned xb_ld(unsigned* p)              { return __hip_atomic_load(p, __ATOMIC_RELAXED, __HIP_MEMORY_SCOPE_AGENT); }
__device__ __forceinline__ unsigned xb_add(unsigned* p, unsigned v) { return __hip_atomic_fetch_add(p, v, __ATOMIC_RELAXED, __HIP_MEMORY_SCOPE_AGENT); }
__device__ __forceinline__ unsigned xb_xcc_id() { return (unsigned)__builtin_amdgcn_s_getreg((3 << 11) | 20) & 0xFu; }
#define XB_SPIN(cond, bar) do { unsigned _sp = 0; while (cond) { __builtin_amdgcn_s_sleep(1); \
    if ((++_sp & 255u) == 0u) { if (xb_ld(&(bar)[XB_TMO])) break; if (_sp > XB_SPIN_CAP) { atomicAdd(&(bar)[XB_TMO], 1u); break; } } } } while (0)

struct XcdBarrier {
    unsigned* bar; unsigned x;
    volatile LAS unsigned* st;
};

__device__ __forceinline__ XcdBarrier xcd_barrier_post(unsigned* bar, volatile LAS unsigned* st) {
    XcdBarrier b; b.bar = bar; b.x = xb_xcc_id(); b.st = st;
    if (threadIdx.x == 0) (void)xb_add(&bar[XB_XCNT(b.x)], 1u);
    return b;
}
__device__ __forceinline__ void xcd_barrier_complete(unsigned* bar, unsigned x, unsigned& nloc, unsigned& nx) {
    const unsigned G = gridDim.x * gridDim.y * gridDim.z;
    unsigned sum, cnt, mine, sp = 0u;
    for (;;) {
        sum = 0u; cnt = 0u; mine = 0u;
#pragma unroll
        for (unsigned j = 0; j < 16; ++j) { const unsigned c = xb_ld(&bar[XB_XCNT(j)]); sum += c; cnt += (c > 0u) ? 1u : 0u; mine = (j == x) ? c : mine; }
        if (sum == G) break;
        __builtin_amdgcn_s_sleep(1);
        if ((++sp & 255u) == 0u) { if (xb_ld(&bar[XB_TMO])) break; if (sp > XB_SPIN_CAP) { atomicAdd(&bar[XB_TMO], 1u); break; } }
    }
    nloc = mine > 0u ? mine : 1u; nx = cnt > 0u ? cnt : 1u;
}

__device__ __forceinline__ void xcd_barrier(const XcdBarrier& b) {
    asm volatile("s_waitcnt vmcnt(0)" ::: "memory");
    __syncthreads();
    if (threadIdx.x == 0) {
        unsigned* bar = b.bar;
        __builtin_amdgcn_s_waitcnt(0);
        unsigned nloc = b.st[0], nx = b.st[1];
        if (nloc == 0u) { xcd_barrier_complete(bar, b.x, nloc, nx); b.st[0] = nloc; b.st[1] = nx; }
        const unsigned old = xb_add(&bar[XB_XSUB(b.x)], 1u);
        const unsigned gen = old / nloc;
        if (old + 1u == (gen + 1u) * nloc) {
            __builtin_amdgcn_fence(__ATOMIC_RELEASE, "agent");
            asm volatile("s_waitcnt vmcnt(0)" ::: "memory");
            const unsigned og = xb_add(&bar[XB_TOP], 1u);
            const unsigned tg = og / nx;
            if (og + 1u == (tg + 1u) * nx) xb_add(&bar[XB_TOPGEN], 1u);
            else XB_SPIN(xb_ld(&bar[XB_TOPGEN]) == tg, bar);
            __builtin_amdgcn_fence(__ATOMIC_ACQUIRE, "agent");
            xb_add(&bar[XB_XGEN(b.x)], 1u);
            asm volatile("s_waitcnt vmcnt(0)" ::: "memory");
        } else {
            XB_SPIN(xb_ld(&bar[XB_XGEN(b.x)]) == gen, bar);
            __builtin_amdgcn_fence(__ATOMIC_ACQUIRE, "agent");
            asm volatile("s_waitcnt vmcnt(0)" ::: "memory");
        }
    }
    __syncthreads();
}

constexpr size_t OFF_BAR = WS_ACC + ACC_BYTES;
constexpr size_t BAR_ZERO_BYTES = 16384;
static_assert(OFF_BAR % 256 == 0 && OFF_BAR + BAR_ZERO_BYTES <= WS_END, "control words inside the workspace");
constexpr int LDS_BARST = 150016;
#define MK_FRAME() \
    Frame F; F.lds = (LAS unsigned char*)lds; \
    { int t_ = threadIdx.x; asm volatile("" : "+v"(t_)); F.tid = t_; } \
    F.lane = F.tid & 63; F.wave = __builtin_amdgcn_readfirstlane(F.tid >> 6); \
    F.bid = blockIdx.x; F.G = gridDim.x; F.out = (float*)kin(18); F.ws = (unsigned char*)kin(19); \
    unsigned char* ws = F.ws; (void)ws; \
    ssum_t* ssx = (ssum_t*)(ws + WS_ACC + OFF_SSX); ssum_t* ssq = (ssum_t*)(ws + WS_ACC + OFF_SSQ); ssum_t* sskv = (ssum_t*)(ws + WS_ACC + OFF_SSKV); (void)ssx; (void)ssq; (void)sskv; \
    const float* cosT = (const float*)(ws + WS_ROPE); const float* sinT = cosT + SEQ * 16; (void)cosT; (void)sinT;
#define MK_IN(k) (ph_lo <= (k) && (k) < ph_hi)
#define MK_SEAM(k) do { if ((k) + 1 < ph_hi) { if ((k) == 0 && ph_hi > 18) cg::this_grid().sync();   else { XcdBarrier xb_; xb_.bar = (unsigned*)(kin(19)) + OFF_BAR / 4; xb_.x = xb_xcc_id(); xb_.st = (volatile LAS unsigned*)((LAS unsigned char*)lds + LDS_BARST); xcd_barrier(xb_); } } } while (0)

template <int l> __device__ __forceinline__ void layer_phases(unsigned char* lds, int ph_lo, int ph_hi) {
    if (MK_IN(1 + 4 * l)) {
        MK_FRAME();
#if !defined(NO_GEMM) && !defined(NO_G1)
        pg8::Gemm g{(const pg8::bf16_t*)(ws + WS_XB), (const pg8::bf16_t*)(ws + WS_WIN) + (size_t)l * ZW * 1024, M, ZW, 1024, 1024, 1024};
        pg8::StaticOrder S; S.init(M, ZW, F.G, F.bid);
        EpiZ E{(bf16_t*)(ws + WS_Z), ssx + l * M, ssq + l * M, sskv + l * M};
        pg8::gemm_phase<EpiZ, pg8::StaticOrder, PG8_ALIGN, PG8_SP2>(F.lds, g, S, E);
#endif
        if (F.G == 256 && l + 1 < NL && F.bid >= 128) convert_layer_weights(F, l + 1, (F.bid - 128) * NWAVES + F.wave, 128 * NWAVES);
        MK_SEAM(1 + 4 * l);
    }
    if (MK_IN(2 + 4 * l)) for (int rep2_ = 0; rep2_ < P2_REPEAT; ++rep2_) {
        {
            MK_FRAME();
#if !defined(NO_GEMM) && !defined(NO_G2)
            pg8::Gemm g{(const pg8::bf16_t*)(ws + WS_Z) + Z_CQ, (const pg8::bf16_t*)(ws + WS_WUQ) + (size_t)l * 768 * 384, M, 768, 384, ZW, 384};
            pg8::StaticOrder S; S.init(M, 768, F.G, F.bid);
            EpiQ E{(bf16_t*)((unsigned char*)F.out + OUT_Q), ssq + l * M, cosT, sinT};
            pg8::gemm_phase<EpiQ, pg8::StaticOrder, PG8_ALIGN, PG8_SP2>(F.lds, g, S, E);
#endif
        }
        {
            MK_FRAME();
#if !defined(NO_GEMM) && !defined(NO_G3)
            pg8::Gemm g{(const pg8::bf16_t*)(ws + WS_Z) + Z_CKV, (const pg8::bf16_t*)(ws + WS_WUKV) + (size_t)l * 768 * 256, M, 768, 256, ZW, 256};
            pg8::StaticOrder S; S.init(M, 768, F.G, (F.bid + F.G / 2) % F.G);
            EpiKV E{(bf16_t*)(ws + WS_KV), sskv + l * M};
            pg8::gemm_phase<EpiKV, pg8::StaticOrder, PG8_ALIGN, PG8_SP2>(F.lds, g, S, E);
#endif
        }
        __syncthreads();
        {
            MK_FRAME();
#if !defined(NO_P2)
            for (int u = F.bid; u < 256; u += F.G) phase2_tile(F, l, u);
#endif
        }
        MK_SEAM(2 + 4 * l);
    }
    if (MK_IN(3 + 4 * l)) {
        MK_FRAME();
#ifndef ATT_REPEAT
#define ATT_REPEAT 1
#endif
        int i1 = F.bid;
        if (F.G == 256) { const int v = (F.bid & 7) * 32 + (F.bid >> 3); i1 = (v < 252) ? (v % 21) * 12 + v / 21 : v; }
        for (int rep = 0; rep < ATT_REPEAT; ++rep)
        for (int r = 0;; ++r) {
            int i;
            if (F.G == 256) { if (r >= 2 || (r == 1 && i1 < 128)) break; i = r ? 511 - i1 : i1; }
            else { if (r * F.G >= 384) break; i = (r & 1) ? r * F.G + (F.G - 1 - F.bid) : r * F.G + F.bid; }
#if !defined(NO_ATT)
            if (i < 384) att::attn_unit(F, (i % 12) / 6, (i % 12) % 6, 31 - i / 12);
#endif
        }
        __syncthreads();
        { const int hg = F.G / 2;
          if (i1 >= F.G - hg) for (int u = F.G - 1 - i1; u < 256; u += hg) lru_final_unit(F, u); }
        MK_SEAM(3 + 4 * l);
    }
    if (MK_IN(4 + 4 * l)) {
        MK_FRAME();
#if !defined(NO_GEMM) && !defined(NO_G4)
        pg8::Gemm g{(const pg8::bf16_t*)(ws + WS_Y), (const pg8::bf16_t*)(ws + WS_WOUT) + (size_t)l * 1024 * 1024, M, 1024, 1024, 1024, 1024};
        pg8::StaticOrder S; S.init(M, 1024, F.G, F.bid);
        EpiOut E{(bf16_t*)(ws + WS_XB), ssx + (l + 1) * M};
        pg8::gemm_phase<EpiOut, pg8::StaticOrder, PG8_ALIGN, PG8_SP2>(F.lds, g, S, E);
#endif
        MK_SEAM(4 + 4 * l);
    }
}

__global__ void __launch_bounds__(NTHREADS, 2) mk_fwd(Args args) {
    extern __shared__ __attribute__((aligned(16))) unsigned char lds[];
    const int ph_lo = *(__attribute__((address_space(4))) const int*)((__attribute__((address_space(4))) const char*)__builtin_amdgcn_kernarg_segment_ptr() + 160);
    const int ph_hi = *(__attribute__((address_space(4))) const int*)((__attribute__((address_space(4))) const char*)__builtin_amdgcn_kernarg_segment_ptr() + 164);
    if (threadIdx.x < 2) ((LAS unsigned*)((LAS unsigned char*)lds + LDS_BARST))[threadIdx.x] = 0u;
    __syncthreads();
    (void)xcd_barrier_post((unsigned*)(kin(19)) + OFF_BAR / 4, (volatile LAS unsigned*)((LAS unsigned char*)lds + LDS_BARST));
    if (MK_IN(0)) {
        MK_FRAME();
#if !defined(NO_PRO)
        phase_prologue(F);
#endif
        MK_SEAM(0);
    }
    layer_phases<0>(lds, ph_lo, ph_hi);
    layer_phases<1>(lds, ph_lo, ph_hi);
    layer_phases<2>(lds, ph_lo, ph_hi);
    layer_phases<3>(lds, ph_lo, ph_hi);
    if (MK_IN(17)) {
        MK_FRAME();
        phase_final(F);
    }
}

extern "C" void kernel_launch(void* const* d_in, const int* in_sizes, int n_in, void* d_out, int out_size, void* d_ws, size_t ws_size, hipStream_t stream) {
    static int grid = 0;
    if (grid == 0) {
        if (n_in != 18 || in_sizes[0] != M * DM || out_size != M * DM || ws_size < WS_END) { fprintf(stderr, "kernel_launch: unexpected shapes (n_in %d, in0 %d, out %d, ws %zu)\n", n_in, n_in > 0 ? in_sizes[0] : -1, out_size, ws_size); grid = -1; return; }
        int dev = 0, cus = 0, per_cu = 0;
        hipGetDevice(&dev); hipDeviceGetAttribute(&cus, hipDeviceAttributeMultiprocessorCount, dev);
        if (hipFuncSetAttribute((const void*)mk_fwd, hipFuncAttributeMaxDynamicSharedMemorySize, LDS_BYTES) != hipSuccess) { fprintf(stderr, "kernel_launch: hipFuncSetAttribute failed\n"); grid = -1; return; }
        if (hipOccupancyMaxActiveBlocksPerMultiprocessor(&per_cu, (const void*)mk_fwd, NTHREADS, LDS_BYTES) != hipSuccess || per_cu < 1) { fprintf(stderr, "kernel_launch: occupancy query says %d\n", per_cu); per_cu = 1; }
        (void)hipGetLastError();
        grid = cus;
        if (grid > 256) grid = 256;
    }
    if (grid < 0) return;
    hipMemsetAsync((char*)d_ws + WS_ACC, 0, ACC_BYTES + BAR_ZERO_BYTES, stream);
    Args a{};
    for (int i = 0; i < 18; ++i) a.in[i] = (const float*)d_in[i];
    a.out = (float*)d_out; a.ws = (unsigned char*)d_ws;
#if MK_ONE_LAUNCH
    a.ph_lo = 0; a.ph_hi = 18;
    void* kargs[] = {&a};
    hipError_t e = hipLaunchCooperativeKernel((const void*)mk_fwd, dim3(grid), dim3(NTHREADS), kargs, LDS_BYTES, stream);
    if (e != hipSuccess) fprintf(stderr, "cooperative launch failed: %s (grid %d)\n", hipGetErrorString(e), grid);
#else
    for (int ph = 0; ph < 18; ++ph) {
        a.ph_lo = ph; a.ph_hi = ph + 1;
        hipLaunchKernelGGL(mk_fwd, dim3(grid), dim3(NTHREADS), LDS_BYTES, stream, a);
    }
#endif
}
```

```cpp
#include <hip/hip_runtime.h>
#include <hip/hip_cooperative_groups.h>
#include <cstdio>
#include <cstdint>
#include <cmath>
namespace cg = cooperative_groups;
namespace pg8 {
#define PG8_LAS __attribute__((address_space(3)))
typedef unsigned short bf16_t;
typedef short bf16x8 __attribute__((ext_vector_type(8)));
typedef float f32x4 __attribute__((ext_vector_type(4)));
typedef unsigned u32x4 __attribute__((ext_vector_type(4)));
constexpr int BM = 256, BK = 64, HALF = 128, HTB = HALF * BK * 2  , STAGE_BYTES = 8 * HTB, NXCD = 8, WGM = 8;

__host__ __device__ __forceinline__ int lds_byte(int r, int c) { const int st = (r >> 4) * 2 + (c >> 5), rr = r & 15, cc = c & 31, ob = rr * 64 + cc * 2; return st * 1024 + (ob ^ (((ob >> 9) & 1) << 5)); }
__host__ __device__ __forceinline__ void stage_rc(int b, int& R, int& C) { const int st = b / 1024, sb = b % 1024, swz = sb ^ (((sb >> 9) & 1) << 5); R = (st >> 1) * 16 + swz / 64; C = (st & 1) * 32 + (swz % 64) / 2; }
__host__ __device__ __forceinline__ int perm32(int rho) { const int n = rho >> 4, i = rho & 15; return 8 * (i >> 2) + 4 * n + (i & 3); }

struct Unit { int pm, pn; };
struct Gemm { const bf16_t* A; const bf16_t* Bt; int M, N, K, lda, ldb; };

struct StaticOrder {
    int nM, nN, nwg, G, c;
    __host__ __device__ void init(int M, int N, int G_, int c_) { nM = M / BM; nN = N / BM; nwg = nM * nN; G = G_; c = c_; }
    __host__ __device__ bool next(int i, Unit& u) const {
        const long L = (long)i * G + c; if (L >= nwg) return false;
        int wgid = (int)L; { const int q = nwg / NXCD, r = nwg % NXCD, xcd = wgid % NXCD, off = wgid / NXCD; wgid = (xcd < r ? xcd * (q + 1) : r * (q + 1) + (xcd - r) * q) + off; }
        const int nig = WGM * nN, gid = wgid / nig, fm = gid * WGM, gsz = (nM - fm) < WGM ? (nM - fm) : WGM;
        u.pm = fm + ((wgid % nig) % gsz); u.pn = (wgid % nig) / gsz; return true;
    }
    __device__ __forceinline__ void a_ready(const Unit&) const {}
    __device__ __forceinline__ void done(const Unit&) const {}
};

__device__ __forceinline__ unsigned cvt_pk_bf16(float lo, float hi) { unsigned r; asm volatile("v_cvt_pk_bf16_f32 %0, %1, %2" : "=v"(r) : "v"(lo), "v"(hi)); return r; }
typedef float f32x2 __attribute__((ext_vector_type(2)));
template <class Epi, class Sched, bool ALIGN_EPI, bool SP2>
__device__ __forceinline__ void gemm_phase(PG8_LAS unsigned char* lds, const Gemm g, const Sched& S, const Epi& E) {
    int tid_ = threadIdx.x; asm volatile("" : "+v"(tid_));
    const int tid = tid_, wid = __builtin_amdgcn_readfirstlane(tid >> 6), lane = tid & 63, wr = wid >> 2, wc = wid & 3, fr = lane & 15, fq = lane >> 4;
    const int K = g.K; int nt = K / BK; asm volatile("" : "+s"(nt));
    unsigned voffA[2], voffB[2];
#pragma unroll
    for (int i = 0; i < 2; ++i) { int R, C; stage_rc(tid * 16 + i * 8192, R, C); const int Rb = Epi::PERM ? ((R & ~31) + perm32(R & 31)) : R;
        voffA[i] = (unsigned)(R * g.lda + C) * 2u; voffB[i] = (unsigned)(Rb * g.ldb + C) * 2u; }
    const size_t kstep = (size_t)(BK * 2);
    const size_t hstepA = (size_t)HALF * g.lda * 2, hstepB = (size_t)HALF * g.ldb * 2;
    const size_t tstepA = 2 * hstepA, tstepB = 2 * hstepB;
    const unsigned ldsw = (unsigned)wid * 1024u;
    const int aoff = lds_byte(wr * 64 + fr, fq * 8), boff = lds_byte(wc * 32 + fr, fq * 8);
#define PG8_SA(b, h) (((b) * 2 + (h)) * HTB)
#define PG8_SB(b, h) ((4 + (b) * 2 + (h)) * HTB)
#define PG8_STAGE(bufoff, gbase, voff) do { _Pragma("unroll") for (int _i = 0; _i < 2; ++_i) \
        __builtin_amdgcn_global_load_lds((const unsigned*)((const char*)(gbase) + (voff)[_i]), (PG8_LAS unsigned*)(lds + (bufoff) + ldsw + _i * 8192), 16, 0, 0); } while (0)
#define PG8_LDA(dst, b, h) do { _Pragma("unroll") for (int m = 0; m < 4; ++m) _Pragma("unroll") for (int k = 0; k < 2; ++k) dst[m][k] = *(const PG8_LAS bf16x8*)(lds + PG8_SA(b, h) + aoff + m * 2048 + k * 1024); } while (0)
#define PG8_LDB(dst, b, h) do { _Pragma("unroll") for (int n = 0; n < 2; ++n) _Pragma("unroll") for (int k = 0; k < 2; ++k) dst[n][k] = *(const PG8_LAS bf16x8*)(lds + PG8_SB(b, h) + boff + n * 2048 + k * 1024); } while (0)
#define PG8_MMA(ai, bj, At, Bt) do { __builtin_amdgcn_s_setprio(1); _Pragma("unroll") for (int m = 0; m < 4; ++m) _Pragma("unroll") for (int n = 0; n < 2; ++n) _Pragma("unroll") for (int k = 0; k < 2; ++k) \
        acc[ai][bj][m][n] = __builtin_amdgcn_mfma_f32_16x16x32_bf16(Bt[n][k], At[m][k], acc[ai][bj][m][n], 0, 0, 0); __builtin_amdgcn_s_setprio(0); } while (0)
#define PG8_WAIT_V(n) asm volatile("s_waitcnt vmcnt(" #n ")" ::: "memory")
#define PG8_WAIT_L(n) asm volatile("s_waitcnt lgkmcnt(" #n ")" ::: "memory")
#define PG8_BAR __builtin_amdgcn_s_barrier()
#define PG8_SCHED __builtin_amdgcn_sched_barrier(0)
    Unit cur, nxt; int ui = 0;
    if (!S.next(0, cur)) return;
    f32x4 acc[2][2][4][2];
#pragma unroll
    for (int a = 0; a < 2; ++a)
#pragma unroll
        for (int b = 0; b < 2; ++b)
#pragma unroll
            for (int m = 0; m < 4; ++m)
#pragma unroll
                for (int n = 0; n < 2; ++n) acc[a][b][m][n] = (f32x4){0.f, 0.f, 0.f, 0.f};
    bf16x8 At[4][2], B0[2][2], B1[2][2];
    const char* cA = (const char*)g.A + (size_t)cur.pm * tstepA; const char* cB = (const char*)g.Bt + (size_t)cur.pn * tstepB;
    S.a_ready(cur);
    if constexpr (SP2) {
        PG8_STAGE(PG8_SB(0, 0), cB, voffB); PG8_STAGE(PG8_SB(0, 1), cB + hstepB, voffB); PG8_STAGE(PG8_SA(0, 0), cA, voffA); PG8_STAGE(PG8_SA(0, 1), cA + hstepA, voffA);
        if (wr == 1) PG8_BAR;
        PG8_WAIT_V(2); PG8_BAR;
        PG8_STAGE(PG8_SB(1, 0), cB + kstep, voffB); PG8_STAGE(PG8_SA(1, 0), cA + kstep, voffA); PG8_STAGE(PG8_SB(1, 1), cB + hstepB + kstep, voffB);
        PG8_WAIT_V(6); PG8_BAR;
    } else {
        PG8_STAGE(PG8_SB(0, 0), cB, voffB); PG8_STAGE(PG8_SA(0, 0), cA, voffA); PG8_STAGE(PG8_SB(0, 1), cB + hstepB, voffB); PG8_STAGE(PG8_SA(0, 1), cA + hstepA, voffA);
        if (wr == 1) PG8_BAR;
        PG8_WAIT_V(4); PG8_BAR;
        PG8_STAGE(PG8_SB(1, 0), cB + kstep, voffB); PG8_STAGE(PG8_SA(1, 0), cA + kstep, voffA); PG8_STAGE(PG8_SB(1, 1), cB + hstepB + kstep, voffB);
        PG8_WAIT_V(6); PG8_BAR;
    }
    for (;;) {
        const bool has_next = S.next(ui + 1, nxt);
        const char* nA = has_next ? (const char*)g.A + (size_t)nxt.pm * tstepA : cA; const char* nB = has_next ? (const char*)g.Bt + (size_t)nxt.pn * tstepB : cB;
        for (int t = 0; t < nt; t += 2) {
            const bool last = (t == nt - 2);
            const char* a1 = cA + (size_t)(t + 1) * kstep;
            const char* a2 = last ? nA : cA + (size_t)(t + 2) * kstep; const char* b2 = last ? nB : cB + (size_t)(t + 2) * kstep;
            const char* a3 = a2 + kstep; const char* b3 = b2 + kstep;
            if (last && has_next) S.a_ready(nxt);
            if constexpr (SP2) {
            PG8_LDB(B0, 0, 0); PG8_LDB(B1, 0, 1); PG8_SCHED; PG8_LDA(At, 0, 0); PG8_STAGE(PG8_SA(1, 1), a1 + hstepA, voffA);
            PG8_WAIT_V(8); PG8_WAIT_L(0); PG8_BAR; PG8_MMA(0, 0, At, B0); PG8_MMA(0, 1, At, B1); PG8_BAR; PG8_SCHED;
            PG8_LDA(At, 0, 1); PG8_STAGE(PG8_SB(0, 0), b2, voffB); PG8_STAGE(PG8_SB(0, 1), b2 + hstepB, voffB); PG8_STAGE(PG8_SA(0, 0), a2, voffA);
            PG8_WAIT_V(8); PG8_WAIT_L(0); PG8_BAR; PG8_MMA(1, 0, At, B0); PG8_MMA(1, 1, At, B1); PG8_BAR; PG8_SCHED;
            PG8_LDB(B0, 1, 0); PG8_LDB(B1, 1, 1); PG8_SCHED; PG8_LDA(At, 1, 0); PG8_STAGE(PG8_SA(0, 1), a2 + hstepA, voffA);
            PG8_WAIT_V(8); PG8_WAIT_L(0); PG8_BAR; PG8_MMA(0, 0, At, B0); PG8_MMA(0, 1, At, B1); PG8_BAR; PG8_SCHED;
            PG8_LDA(At, 1, 1); PG8_STAGE(PG8_SB(1, 0), b3, voffB); PG8_STAGE(PG8_SB(1, 1), b3 + hstepB, voffB); PG8_STAGE(PG8_SA(1, 0), a3, voffA);
            PG8_WAIT_V(8); PG8_WAIT_L(0); PG8_BAR; PG8_MMA(1, 0, At, B0); PG8_MMA(1, 1, At, B1); PG8_BAR; PG8_SCHED;
            } else {
            PG8_LDB(B0, 0, 0); PG8_SCHED; PG8_LDA(At, 0, 0); PG8_STAGE(PG8_SA(1, 1), a1 + hstepA, voffA);
            PG8_WAIT_L(8); PG8_BAR; PG8_WAIT_L(0); PG8_MMA(0, 0, At, B0); PG8_BAR; PG8_SCHED;
            PG8_LDB(B1, 0, 1); PG8_STAGE(PG8_SB(0, 0), b2, voffB);
            PG8_BAR; PG8_WAIT_L(0); PG8_MMA(0, 1, At, B1); PG8_BAR;
            PG8_LDA(At, 0, 1); PG8_STAGE(PG8_SA(0, 0), a2, voffA);
            PG8_BAR; PG8_WAIT_L(0); PG8_MMA(1, 0, At, B0); PG8_BAR; PG8_SCHED;
            PG8_STAGE(PG8_SB(0, 1), b2 + hstepB, voffB);
            PG8_WAIT_V(6); PG8_BAR; PG8_MMA(1, 1, At, B1); PG8_BAR;
            PG8_LDB(B0, 1, 0); PG8_SCHED; PG8_LDA(At, 1, 0); PG8_STAGE(PG8_SA(0, 1), a2 + hstepA, voffA);
            PG8_WAIT_L(8); PG8_BAR; PG8_WAIT_L(0); PG8_MMA(0, 0, At, B0); PG8_BAR; PG8_SCHED;
            PG8_LDB(B1, 1, 1); PG8_STAGE(PG8_SB(1, 0), b3, voffB);
            PG8_BAR; PG8_WAIT_L(0); PG8_MMA(0, 1, At, B1); PG8_BAR;
            PG8_LDA(At, 1, 1); PG8_STAGE(PG8_SA(1, 0), a3, voffA);
            PG8_BAR; PG8_WAIT_L(0); PG8_MMA(1, 0, At, B0); PG8_BAR; PG8_SCHED;
            PG8_STAGE(PG8_SB(1, 1), b3 + hstepB, voffB);
            PG8_WAIT_V(6); PG8_BAR; PG8_MMA(1, 1, At, B1); PG8_BAR;
            }
        }
        if constexpr (ALIGN_EPI) { if (wr == 0) PG8_BAR; }
        if constexpr (!Epi::AFTER_DRAIN) { E(acc, cur, wr, wc, fr, fq); S.done(cur); }
        if (!has_next) break;
#pragma unroll
        for (int a = 0; a < 2; ++a)
#pragma unroll
            for (int b = 0; b < 2; ++b)
#pragma unroll
                for (int m = 0; m < 4; ++m)
#pragma unroll
                    for (int n = 0; n < 2; ++n) acc[a][b][m][n] = (f32x4){0.f, 0.f, 0.f, 0.f};
        cur = nxt; cA = nA; cB = nB; ++ui;
        if constexpr (ALIGN_EPI) { if (wr == 1) PG8_BAR; }
    }
    PG8_WAIT_V(0);
    if constexpr (!ALIGN_EPI) { if (wr == 0) PG8_BAR; }
    PG8_BAR;
    if constexpr (Epi::AFTER_DRAIN) { E.fused(acc, cur, wr, wc, fr, fq, lds, wid, lane); S.done(cur); }
#undef PG8_SA
#undef PG8_SB
#undef PG8_STAGE
#undef PG8_LDA
#undef PG8_LDB
#undef PG8_MMA
#undef PG8_WAIT_V
#undef PG8_WAIT_L
#undef PG8_BAR
#undef PG8_SCHED
}
}

#ifndef PG8_SP2
#define PG8_SP2 true
#endif
#ifndef PG8_ALIGN
#define PG8_ALIGN true
#endif
#ifndef P2_REPEAT
#define P2_REPEAT 1
#endif
#ifndef MK_ONE_LAUNCH
#define MK_ONE_LAUNCH 1
#endif

#define LAS __attribute__((address_space(3)))
typedef unsigned short bf16_t;
typedef short bf16x8 __attribute__((ext_vector_type(8)));
typedef short s16x4 __attribute__((ext_vector_type(4)));
typedef float f32x4 __attribute__((ext_vector_type(4)));
typedef float f32x2 __attribute__((ext_vector_type(2)));
typedef float f32x16 __attribute__((ext_vector_type(16)));
typedef unsigned u32x4 __attribute__((ext_vector_type(4)));
typedef unsigned u32x2 __attribute__((ext_vector_type(2)));

constexpr int NB = 2, SEQ = 8192, M = NB * SEQ, DM = 1024, NL = 4;
constexpr int ZW = 2560, DQ = 576, DKV = 768, DLRU = 384, DPOOL = 256;
constexpr int Z_ZA = 0, Z_GA = 384, Z_CQ = 768, Z_CKV = 1152, Z_KR = 1408, Z_GB = 1440, Z_ZC = 1824, Z_GC = 2080, D_IN = 2336;
constexpr float EPS = 1e-6f;
constexpr float QSCALE = 0.10206207261596577f * 1.4426950408889634f;
constexpr int NWAVES = 8, NTHREADS = 512;
constexpr int LDS_BYTES = 155648;

constexpr size_t MiB = 1u << 20;
constexpr size_t WS_CTL = 0, CTL_ZERO_BYTES = 1 * MiB;
typedef unsigned long long ssum_t;
constexpr size_t WS_ACC = 254 * MiB;
constexpr size_t OFF_SSX = 0, OFF_SSQ = (size_t)5 * 16384 * 8, OFF_SSKV = (size_t)9 * 16384 * 8, ACC_BYTES = (size_t)13 * 16384 * 8;
constexpr size_t WS_ROPE = 1 * MiB;
constexpr size_t WS_CHS = 2 * MiB;
constexpr size_t WS_SMALL = 3 * MiB;
constexpr size_t WS_WIN = 4 * MiB, WS_WOUT = 24 * MiB, WS_WUQ = 32 * MiB, WS_WUKV = 35 * MiB;
constexpr size_t WS_XB = 38 * MiB;
constexpr size_t OUT_Q = 0, OUT_KR = 20 * MiB;
constexpr size_t WS_Z = 70 * MiB, WS_KV = 150 * MiB, WS_A32 = 174 * MiB, WS_U32 = 198 * MiB, WS_Y = 222 * MiB, WS_END = 256 * MiB;

struct Args { const float* in[18]; float* out; unsigned char* ws; int ph_lo, ph_hi; };

struct Frame {
    LAS unsigned char* lds;
    int tid, lane, wave, bid, G;
    float* out; unsigned char* ws;
};
typedef __attribute__((address_space(1))) const float* gfp_t;
__device__ __forceinline__ const float* kin(int i) {
    __attribute__((address_space(4))) const char* k = (__attribute__((address_space(4))) const char*)__builtin_amdgcn_kernarg_segment_ptr();
    asm volatile("" : "+s"(k));
    gfp_t p_ = *(__attribute__((address_space(4))) const gfp_t*)(k + 8 * i);
    return (const float*)p_; }

__device__ __forceinline__ unsigned f2bf(float f) { unsigned u = __builtin_bit_cast(unsigned, f); return (u + 0x7fffu + ((u >> 16) & 1u)) >> 16; }
__device__ __forceinline__ unsigned pk2(float lo, float hi) { return f2bf(lo) | (f2bf(hi) << 16); }
__device__ __forceinline__ float bf2f(unsigned short b) { return __builtin_bit_cast(float, (unsigned)b << 16); }
__device__ __forceinline__ float bflo(unsigned w) { return __builtin_bit_cast(float, w << 16); }
__device__ __forceinline__ float bfhi(unsigned w) { return __builtin_bit_cast(float, w & 0xffff0000u); }
__device__ __forceinline__ float sigmoidf_(float x) { return 1.0f / (1.0f + __expf(-x)); }
__device__ __forceinline__ float siluf_(float x) { return x * __builtin_amdgcn_rcpf(1.0f + __expf(-x)); }
__device__ __forceinline__ float wave_sum(float v) {
#pragma unroll
    for (int o = 1; o < 64; o <<= 1) v += __shfl_xor(v, o);
    return v;
}
__device__ __forceinline__ void atomic_addf(ssum_t* p, float v) { (void)__hip_atomic_fetch_add(p, (ssum_t)(v * 16777216.0f), __ATOMIC_RELAXED, __HIP_MEMORY_SCOPE_AGENT); }
__device__ __forceinline__ float ldfx(const ssum_t* p) { return (float)(*p) * (1.0f / 16777216.0f); }
#define LDS_WAIT() asm volatile("s_waitcnt lgkmcnt(0)" ::: "memory")
__device__ __forceinline__ float fast_sigmoid(float x) { return __builtin_amdgcn_rcpf(1.0f + __expf(-x)); }
__device__ __forceinline__ float neg_expm1(float x) {
    const float ser = -x * (1.0f + x * (0.5f + x * (0.16666667f + x * (0.041666668f + x * 0.0083333338f))));
    const float dir = 1.0f - __expf(x);
    return (x > -0.25f) ? ser : dir;
}

struct EpiZ {
    static constexpr bool PERM = true, AFTER_DRAIN = false;
    bf16_t* Zb; const ssum_t* ssx; ssum_t* ssq; ssum_t* sskv;
    __device__ __forceinline__ void operator()(const pg8::f32x4 (&acc)[2][2][4][2], const pg8::Unit& u, int wr, int wc, int fr, int fq) const {
        const int row0 = u.pm * 256 + wr * 64 + fr, col0 = u.pn * 256 + wc * 32 + 8 * fq;
#pragma unroll
        for (int ai = 0; ai < 2; ++ai)
#pragma unroll
            for (int m = 0; m < 4; ++m) {
                const int row = row0 + ai * 128 + m * 16;
                const float rs = rsqrtf(ldfx(ssx + row) * (1.0f / 1024.0f) + EPS);
#pragma unroll
                for (int bj = 0; bj < 2; ++bj) {
                    const f32x4 v0 = acc[ai][bj][m][0] * rs, v1 = acc[ai][bj][m][1] * rs;
                    u32x4 w; w.x = pg8::cvt_pk_bf16(v0[0], v0[1]); w.y = pg8::cvt_pk_bf16(v0[2], v0[3]); w.z = pg8::cvt_pk_bf16(v1[0], v1[1]); w.w = pg8::cvt_pk_bf16(v1[2], v1[3]);
                    if (u.pn * 256 + bj * 128 + wc * 32 < D_IN) *(u32x4*)(Zb + (size_t)row * ZW + col0 + bj * 128) = w;
                    const int ht = u.pn * 2 + bj;
                    if (ht >= 6 && ht <= 10) {
                        float s = (v0[0] * v0[0] + v0[1] * v0[1]) + (v0[2] * v0[2] + v0[3] * v0[3]) + (v1[0] * v1[0] + v1[1] * v1[1]) + (v1[2] * v1[2] + v1[3] * v1[3]);
                        s += __shfl_xor(s, 16); s += __shfl_xor(s, 32);
                        if (fq == 0) atomic_addf((ht <= 8 ? ssq : sskv) + row, s);
                    }
                }
                asm volatile("" ::: "memory");
            }
    }
};
struct EpiQ {
    static constexpr bool PERM = true, AFTER_DRAIN = false;
    bf16_t* Qb; const ssum_t* ssq; const float* cosT; const float* sinT;
    __device__ __forceinline__ void operator()(const pg8::f32x4 (&acc)[2][2][4][2], const pg8::Unit& u, int wr, int wc, int fr, int fq) const {
        const int row0 = u.pm * 256 + wr * 64 + fr;
#pragma unroll
        for (int bj = 0; bj < 2; ++bj) {
            const int cg0 = u.pn * 256 + bj * 128 + wc * 32;
            if (cg0 >= DQ) continue;
            const bool rope = ((cg0 >> 5) % 3) == 2;
#pragma unroll
            for (int ai = 0; ai < 2; ++ai)
#pragma unroll
                for (int m = 0; m < 4; ++m) {
                    const int row = row0 + ai * 128 + m * 16;
                    const float rs = rsqrtf(ldfx(ssq + row) * (1.0f / 384.0f) + EPS) * QSCALE;
                    f32x4 v0 = acc[ai][bj][m][0] * rs, v1 = acc[ai][bj][m][1] * rs;
                    if (rope) {
                        const int pos = row & (SEQ - 1);
                        const f32x4 c0 = *(const f32x4*)(cosT + pos * 16 + 8 * (fq & 1)), c1 = *(const f32x4*)(cosT + pos * 16 + 8 * (fq & 1) + 4);
                        const f32x4 s0 = *(const f32x4*)(sinT + pos * 16 + 8 * (fq & 1)), s1 = *(const f32x4*)(sinT + pos * 16 + 8 * (fq & 1) + 4);
                        const float sg = (fq < 2) ? -1.0f : 1.0f;
                        f32x4 p0, p1;
#pragma unroll
                        for (int j = 0; j < 4; ++j) { p0[j] = __shfl_xor(v0[j], 32); p1[j] = __shfl_xor(v1[j], 32); }
                        v0 = v0 * c0 + (p0 * s0) * sg; v1 = v1 * c1 + (p1 * s1) * sg;
                    }
                    u32x4 w; w.x = pg8::cvt_pk_bf16(v0[0], v0[1]); w.y = pg8::cvt_pk_bf16(v0[2], v0[3]); w.z = pg8::cvt_pk_bf16(v1[0], v1[1]); w.w = pg8::cvt_pk_bf16(v1[2], v1[3]);
                    *(u32x4*)(Qb + (size_t)row * DQ + cg0 + 8 * fq) = w;
                    asm volatile("" ::: "memory");
                }
        }
    }
};
struct EpiKV {
    static constexpr bool PERM = true, AFTER_DRAIN = false;
    bf16_t* KVb; const ssum_t* sskv;
    __device__ __forceinline__ void operator()(const pg8::f32x4 (&acc)[2][2][4][2], const pg8::Unit& u, int wr, int wc, int fr, int fq) const {
        const int row0 = u.pm * 256 + wr * 64 + fr, col0 = u.pn * 256 + wc * 32 + 8 * fq;
#pragma unroll
        for (int ai = 0; ai < 2; ++ai)
#pragma unroll
            for (int m = 0; m < 4; ++m) {
                const int row = row0 + ai * 128 + m * 16;
                const float rs = rsqrtf(ldfx(sskv + row) * (1.0f / 256.0f) + EPS);
#pragma unroll
                for (int bj = 0; bj < 2; ++bj) {
                    const f32x4 v0 = acc[ai][bj][m][0] * rs, v1 = acc[ai][bj][m][1] * rs;
                    u32x4 w; w.x = pg8::cvt_pk_bf16(v0[0], v0[1]); w.y = pg8::cvt_pk_bf16(v0[2], v0[3]); w.z = pg8::cvt_pk_bf16(v1[0], v1[1]); w.w = pg8::cvt_pk_bf16(v1[2], v1[3]);
                    *(u32x4*)(KVb + (size_t)row * DKV + col0 + bj * 128) = w;
                }
                asm volatile("" ::: "memory");
            }
    }
};
struct EpiOut {
    static constexpr bool PERM = true, AFTER_DRAIN = false;
    bf16_t* XB; ssum_t* ssn;
    __device__ __forceinline__ void operator()(const pg8::f32x4 (&acc)[2][2][4][2], const pg8::Unit& u, int wr, int wc, int fr, int fq) const {
        const int row0 = u.pm * 256 + wr * 64 + fr, col0 = u.pn * 256 + wc * 32 + 8 * fq;
#pragma unroll
        for (int ai = 0; ai < 2; ++ai)
#pragma unroll
            for (int m = 0; m < 4; ++m) {
                const int row = row0 + ai * 128 + m * 16;
                float s = 0.f;
#pragma unroll
                for (int bj = 0; bj < 2; ++bj) {
                    const size_t off = (size_t)row * DM + col0 + bj * 128;
                    const u32x4 xw = *(const u32x4*)(XB + off);
                    const f32x4 v0 = (f32x4){bflo(xw.x), bfhi(xw.x), bflo(xw.y), bfhi(xw.y)} + acc[ai][bj][m][0], v1 = (f32x4){bflo(xw.z), bfhi(xw.z), bflo(xw.w), bfhi(xw.w)} + acc[ai][bj][m][1];
                    u32x4 w; w.x = pg8::cvt_pk_bf16(v0[0], v0[1]); w.y = pg8::cvt_pk_bf16(v0[2], v0[3]); w.z = pg8::cvt_pk_bf16(v1[0], v1[1]); w.w = pg8::cvt_pk_bf16(v1[2], v1[3]);
                    *(u32x4*)(XB + off) = w;
                    s += (v0[0] * v0[0] + v0[1] * v0[1]) + (v0[2] * v0[2] + v0[3] * v0[3]) + (v1[0] * v1[0] + v1[1] * v1[1]) + (v1[2] * v1[2] + v1[3] * v1[3]);
                }
                s += __shfl_xor(s, 16); s += __shfl_xor(s, 32);
                if (fq == 0) atomic_addf(ssn + row, s);
                asm volatile("" ::: "memory");
            }
    }
};

struct EpiAll {
    static constexpr bool PERM = true, AFTER_DRAIN = false;
    int mode; void* a; void* b; void* c; void* d;
    __device__ __forceinline__ void operator()(const pg8::f32x4 (&acc)[2][2][4][2], const pg8::Unit& u, int wr, int wc, int fr, int fq) const {
#ifdef ONLY_MODE
        if (mode != ONLY_MODE) return;
#endif
        if (mode == 0) { EpiZ E{(bf16_t*)a, (const ssum_t*)b, (ssum_t*)c, (ssum_t*)d}; E(acc, u, wr, wc, fr, fq); }
        else if (mode == 1) { EpiQ E{(bf16_t*)a, (const ssum_t*)b, (const float*)c, (const float*)d}; E(acc, u, wr, wc, fr, fq); }
        else if (mode == 2) { EpiKV E{(bf16_t*)a, (const ssum_t*)b}; E(acc, u, wr, wc, fr, fq); }
        else { EpiOut E{(bf16_t*)c, (ssum_t*)d}; E(acc, u, wr, wc, fr, fq); }
    }
};

__device__ __forceinline__ void p0_transpose_item(const float* W, int N, const float* g, bf16_t* WT, int ldt, LAS float* scr, int item, int lane) {
    const int nblk = N / 32, kb = item / nblk, nb = item % nblk, k0 = 64 * kb, n0 = 32 * nb;
#pragma unroll 8
    for (int i = 0; i < 32; ++i) { const int kk = 2 * i + (lane >> 5); float v = W[(size_t)(k0 + kk) * N + n0 + (lane & 31)]; if (g) v *= g[k0 + kk]; scr[kk * 33 + (lane & 31)] = v; }
    LDS_WAIT(); asm volatile("" ::: "memory");
    const int c = lane & 7;
#pragma unroll
    for (int j = 0; j < 4; ++j) { const int n = (lane >> 3) + 8 * j; const LAS float* s = scr + (8 * c) * 33 + n;
        u32x4 o; o.x = pk2(s[0 * 33], s[1 * 33]); o.y = pk2(s[2 * 33], s[3 * 33]); o.z = pk2(s[4 * 33], s[5 * 33]); o.w = pk2(s[6 * 33], s[7 * 33]);
        *(u32x4*)(WT + (size_t)(n0 + n) * ldt + k0 + 8 * c) = o; }
    LDS_WAIT(); asm volatile("" ::: "memory");
}
__device__ __forceinline__ void convert_layer_weights(Frame& F, int l, int gw, int NGW) {
    LAS float* scr = (LAS float*)(F.lds + F.wave * 16384);
    const int lane = F.lane;
    unsigned char* ws = F.ws;
    constexpr int I_IN = 16 * 73, I_OUT = 16 * 32, I_UQ = 6 * 18, I_UKV = 4 * 24, I_G = 12, I_P = 8;
    constexpr int I_L = I_IN + I_OUT + I_UQ + I_UKV + 2 * I_G + I_P;
    for (int it = gw; it < I_L; it += NGW) {
        int r = it;
        if (r < I_IN) { p0_transpose_item(kin(2) + (size_t)l * 1024 * D_IN, D_IN, kin(1) + l * 1024, (bf16_t*)(ws + WS_WIN) + (size_t)l * ZW * 1024, 1024, scr, r, lane); continue; } r -= I_IN;
        if (r < I_OUT) { p0_transpose_item(kin(16) + (size_t)l * 1024 * 1024, 1024, nullptr, (bf16_t*)(ws + WS_WOUT) + (size_t)l * 1024 * 1024, 1024, scr, r, lane); continue; } r -= I_OUT;
        if (r < I_UQ) { p0_transpose_item(kin(11) + (size_t)l * 384 * DQ, DQ, kin(10) + l * 384, (bf16_t*)(ws + WS_WUQ) + (size_t)l * 768 * 384, 384, scr, r, lane); continue; } r -= I_UQ;
        if (r < I_UKV) { p0_transpose_item(kin(13) + (size_t)l * 256 * DKV, DKV, kin(12) + l * 256, (bf16_t*)(ws + WS_WUKV) + (size_t)l * 768 * 256, 256, scr, r, lane); continue; } r -= I_UKV;
        if (r < I_G) { const int h = r >> 1; p0_transpose_item(kin(5) + (size_t)(l * 6 + h) * 4096, 64, nullptr, (bf16_t*)(ws + WS_SMALL) + (size_t)(l * 6 + h) * 4096, 64, scr, r & 1, lane); continue; } r -= I_G;
        if (r < I_G) { const int h = r >> 1; p0_transpose_item(kin(7) + (size_t)(l * 6 + h) * 4096, 64, nullptr, (bf16_t*)(ws + WS_SMALL + 196608) + (size_t)(l * 6 + h) * 4096, 64, scr, r & 1, lane); continue; } r -= I_G;
        { const int gq = r >> 1; p0_transpose_item(kin(14) + (size_t)(l * 4 + gq) * 4096, 64, nullptr, (bf16_t*)(ws + WS_SMALL + 393216) + (size_t)(l * 4 + gq) * 4096, 64, scr, r & 1, lane); }
    }
}
__device__ __forceinline__ void phase_prologue(Frame& F) {
    const int gw = F.bid * NWAVES + F.wave, NGW = F.G * NWAVES, lane = F.lane;
    unsigned char* ws = F.ws;
    convert_layer_weights(F, 0, gw, NGW);
    if (F.G != 256) { for (int l = 1; l < NL; ++l) convert_layer_weights(F, l, gw, NGW); }
    {
        const int gt = F.bid * NTHREADS + F.tid, NGT = F.G * NTHREADS;
        constexpr int ZIN = 224 * 1024 * 2 / 16, ZUQ = 192 * 384 * 2 / 16;
        for (int i = gt; i < NL * (ZIN + ZUQ); i += NGT) {
            const int l = i / (ZIN + ZUQ), r = i % (ZIN + ZUQ);
            u32x4* p = (r < ZIN) ? (u32x4*)(ws + WS_WIN + ((size_t)l * ZW + D_IN) * 1024 * 2) + r : (u32x4*)(ws + WS_WUQ + ((size_t)l * 768 + DQ) * 384 * 2) + (r - ZIN);
            *p = (u32x4){0u, 0u, 0u, 0u};
        }
        float* SP = (float*)(ws + WS_SMALL + 524288);
        for (int i = gt; i < NL * DLRU; i += NGT) SP[i] = log1pf(expf(-kin(9)[i]));
        float* cosT = (float*)(ws + WS_ROPE); float* sinT = cosT + SEQ * 16;
        for (int i = gt; i < SEQ * 16; i += NGT) {
            const int pos = i >> 4, fi = i & 15, j = fi & 3, k = fi >> 2;
            double inv = (j == 0) ? 1.0 : (j == 1) ? 0.56234132519034908 : (j == 2) ? 0.31622776601683794 : 0.17782794100389228;
            inv *= (k == 0) ? 1.0 : (k == 1) ? 0.1 : (k == 2) ? 0.01 : 0.001;
            const double ang = (double)pos * inv;
            const double n = __builtin_rint(ang * 0.15915494309189535);
            double rr = __builtin_fma(-n, 6.283185307179586, ang); rr = __builtin_fma(-n, 2.4492935982947064e-16, rr);
            const double r2 = rr * rr; double tc = 1.0, sc = 1.0, tsn = rr, ss = rr;
#pragma unroll 1
            for (int q = 1; q <= 15; ++q) { tc *= -r2 / (double)((2 * q - 1) * (2 * q)); sc += tc; tsn *= -r2 / (double)((2 * q) * (2 * q + 1)); ss += tsn; }
            cosT[i] = (float)sc; sinT[i] = (float)ss;
        }
    }
    {
        const float* x = kin(0); bf16_t* XB = (bf16_t*)(ws + WS_XB); ssum_t* ssx = (ssum_t*)(ws + WS_ACC + OFF_SSX);
#pragma unroll 4
        for (int m = gw; m < M; m += NGW) {
            const f32x4* xr = (const f32x4*)(x + (size_t)m * DM) + lane; u32x2* o = (u32x2*)(XB + (size_t)m * DM) + lane;
            float s = 0.f;
#pragma unroll
            for (int j = 0; j < 4; ++j) { const f32x4 v = xr[64 * j]; s += (v.x * v.x + v.y * v.y) + (v.z * v.z + v.w * v.w); o[64 * j] = (u32x2){pk2(v.x, v.y), pk2(v.z, v.w)}; }
            s = wave_sum(s);
            if (lane == 0) ssx[m] = (ssum_t)(s * 16777216.0f);
        }
    }
}

__device__ __forceinline__ bf16x8 ld_x_frag(const LAS float* p) {
    const f32x4 a = *(const LAS f32x4*)p, b = *(const LAS f32x4*)(p + 4);
    u32x4 w; w.x = pg8::cvt_pk_bf16(a[0], a[1]); w.y = pg8::cvt_pk_bf16(a[2], a[3]); w.z = pg8::cvt_pk_bf16(b[0], b[1]); w.w = pg8::cvt_pk_bf16(b[2], b[3]);
    return __builtin_bit_cast(bf16x8, w);
}
constexpr int XAP16 = 392, PLP16 = 264;
constexpr int L2_LA = 64 * XAP16 * 2, L2_UU = L2_LA + 64 * DLRU * 2, L2_END = L2_UU + 64 * DLRU * 2;
static_assert(L2_END <= 150016, "phase-2 LDS map (below the barrier's LDS words)");
template <int W> __device__ __forceinline__ void pool_rows(const float (&c0)[31], const float (&c1)[31], const float (&v0)[31], const float (&v1)[31], int tpos0, LAS bf16_t* dst) {
#pragma unroll
    for (int j = 0; j < 16; ++j) {
        const int idx = 15 + j; const int tp = tpos0 + j;
        float s0 = c0[idx], s1 = c1[idx];
        if (idx - W >= 0) { s0 -= c0[idx - W >= 0 ? idx - W : 0]; s1 -= c1[idx - W >= 0 ? idx - W : 0]; }
        const float rc = __builtin_amdgcn_rcpf((float)((tp + 1 < W) ? tp + 1 : W));
        *(LAS unsigned*)(dst + j * PLP16) = pg8::cvt_pk_bf16(s0 * rc - v0[idx], s1 * rc - v1[idx]);
    }
}
__device__ __forceinline__ void phase2_tile(Frame& F, int l, int u) {
    const int tid = F.tid, lane = F.lane, wave = F.wave;
    unsigned char* ws = F.ws;
    const bf16_t* Z = (const bf16_t*)(ws + WS_Z);
    const int row0 = u * 64, t0 = (u & 127) * 64;
    LAS bf16_t* XA = (LAS bf16_t*)F.lds;
    LAS bf16_t* LA = (LAS bf16_t*)(F.lds + L2_LA); LAS bf16_t* UU = (LAS bf16_t*)(F.lds + L2_UU);
    bf16_t* A16 = (bf16_t*)(ws + WS_A32); bf16_t* U16 = (bf16_t*)(ws + WS_U32);
    if (tid < 384) {
        const int p = tid % 192, half = tid / 192, c = 2 * p;
        const float* cw = kin(3) + (size_t)l * 4 * DLRU; const float* cb = kin(4) + (size_t)l * DLRU;
        const f32x2 w0 = *(const f32x2*)(cw + c), w1 = *(const f32x2*)(cw + DLRU + c), w2 = *(const f32x2*)(cw + 2 * DLRU + c), w3 = *(const f32x2*)(cw + 3 * DLRU + c), bb = *(const f32x2*)(cb + c);
        const int ts = t0 + 32 * half;
        const bf16_t* zp = Z + (size_t)(row0 + 32 * half) * ZW + Z_ZA + c;
        unsigned zr[35];
#pragma unroll
        for (int j = 0; j < 35; ++j) { zr[j] = 0u; if (j >= 3 || ts >= 3) zr[j] = *(const unsigned*)(zp + (ptrdiff_t)(j - 3) * ZW); }
#pragma unroll
        for (int j = 0; j < 32; ++j) {
            const f32x2 x0 = {bflo(zr[j]), bfhi(zr[j])}, x1 = {bflo(zr[j + 1]), bfhi(zr[j + 1])}, x2 = {bflo(zr[j + 2]), bfhi(zr[j + 2])}, x3 = {bflo(zr[j + 3]), bfhi(zr[j + 3])};
            const f32x2 y = bb + w0 * x0 + w1 * x1 + w2 * x2 + w3 * x3;
            *(LAS unsigned*)(XA + (32 * half + j) * XAP16 + c) = pg8::cvt_pk_bf16(y.x, y.y);
        }
    } else {
        const float* cosT = (const float*)(ws + WS_ROPE); const float* sinT = cosT + SEQ * 16;
        bf16_t* KR = (bf16_t*)((unsigned char*)F.out + OUT_KR);
        float ka[8], kb2[8], kc[8], ks[8];
#pragma unroll
        for (int q = 0; q < 8; ++q) { const int it = tid - 384 + 128 * q, tk = it >> 4, i = it & 15, row = row0 + tk, pos = t0 + tk;
            ka[q] = bf2f(Z[(size_t)row * ZW + Z_KR + i]); kb2[q] = bf2f(Z[(size_t)row * ZW + Z_KR + 16 + i]); kc[q] = cosT[pos * 16 + i]; ks[q] = sinT[pos * 16 + i]; }
#pragma unroll
        for (int q = 0; q < 8; ++q) { const int it = tid - 384 + 128 * q, tk = it >> 4, i = it & 15, row = row0 + tk;
            KR[(size_t)row * 32 + i] = (bf16_t)f2bf(ka[q] * kc[q] - kb2[q] * ks[q]); KR[(size_t)row * 32 + 16 + i] = (bf16_t)f2bf(ka[q] * ks[q] + kb2[q] * kc[q]); }
    }
    __syncthreads();
    {
        const int mt = wave & 3, hg = wave >> 2, fr = lane & 15, fq = lane >> 4;
        const bf16_t* Wr = (const bf16_t*)(ws + WS_SMALL) + (size_t)l * 6 * 4096; const bf16_t* Wi = (const bf16_t*)(ws + WS_SMALL + 196608) + (size_t)l * 6 * 4096;
        const float* br = kin(6) + l * DLRU; const float* bi = kin(8) + l * DLRU; const float* SP = (const float*)(ws + WS_SMALL + 524288) + l * DLRU;
        const LAS bf16_t* xrow = XA + (16 * mt + fr) * XAP16; const int lrow = (16 * mt + fr) * DLRU;
        const size_t grow = (size_t)(row0 + 16 * mt + fr) * DLRU;
#pragma unroll 1
        for (int hh = 0; hh < 3; ++hh) {
            const int h = 3 * hg + hh;
            const bf16x8 xb0 = *(const LAS bf16x8*)(xrow + 64 * h + 8 * fq), xb1 = *(const LAS bf16x8*)(xrow + 64 * h + 32 + 8 * fq);
            bf16x8 wfr[4][4]; f32x4 brq[4], biq[4], spq[4];
#pragma unroll
            for (int nt = 0; nt < 4; ++nt) {
                const bf16_t* wr_ = Wr + (size_t)h * 4096 + (16 * nt + fr) * 64 + 8 * fq; const bf16_t* wi_ = Wi + (size_t)h * 4096 + (16 * nt + fr) * 64 + 8 * fq;
                wfr[nt][0] = *(const bf16x8*)wr_; wfr[nt][1] = *(const bf16x8*)(wr_ + 32); wfr[nt][2] = *(const bf16x8*)wi_; wfr[nt][3] = *(const bf16x8*)(wi_ + 32);
                const int c = 64 * h + 16 * nt + 4 * fq;
                brq[nt] = *(const f32x4*)(br + c); biq[nt] = *(const f32x4*)(bi + c); spq[nt] = *(const f32x4*)(SP + c);
            }
#pragma unroll
            for (int nt = 0; nt < 4; ++nt) {
                const bf16x8 ar0 = wfr[nt][0], ar1 = wfr[nt][1], ai0 = wfr[nt][2], ai1 = wfr[nt][3];
                f32x4 accR = {0.f, 0.f, 0.f, 0.f}, accI = {0.f, 0.f, 0.f, 0.f};
                accR = __builtin_amdgcn_mfma_f32_16x16x32_bf16(ar0, xb0, accR, 0, 0, 0); accR = __builtin_amdgcn_mfma_f32_16x16x32_bf16(ar1, xb1, accR, 0, 0, 0);
                accI = __builtin_amdgcn_mfma_f32_16x16x32_bf16(ai0, xb0, accI, 0, 0, 0); accI = __builtin_amdgcn_mfma_f32_16x16x32_bf16(ai1, xb1, accI, 0, 0, 0);
                const int c = 64 * h + 16 * nt + 4 * fq;
                const u32x2 xw_ = *(const LAS u32x2*)(xrow + c);
                const f32x4 brv = brq[nt], biv = biq[nt], spv = spq[nt], xav = {bflo(xw_.x), bfhi(xw_.x), bflo(xw_.y), bfhi(xw_.y)};
                f32x4 lv, uv;
#pragma unroll
                for (int v = 0; v < 4; ++v) {
                    const float r = fast_sigmoid(accR[v] + brv[v]), ig = fast_sigmoid(accI[v] + biv[v]);
                    const float la = -8.0f * r * spv[v];
                    lv[v] = la; uv[v] = __builtin_amdgcn_sqrtf(neg_expm1(2.0f * la)) * (ig * xav[v]);
                }
                *(LAS u32x2*)(LA + lrow + c) = (u32x2){pg8::cvt_pk_bf16(lv[0], lv[1]), pg8::cvt_pk_bf16(lv[2], lv[3])};
                *(LAS u32x2*)(UU + lrow + c) = (u32x2){pg8::cvt_pk_bf16(uv[0], uv[1]), pg8::cvt_pk_bf16(uv[2], uv[3])};
            }
        }
    }
    __syncthreads();
    unsigned zpool[31];
    {
        const int p_ = tid & 127, tq_ = tid >> 7, c_ = 2 * p_, tp0_ = t0 + 16 * tq_;
#pragma unroll
        for (int i = 0; i < 31; ++i) { zpool[i] = 0u; if (tp0_ - 15 + i >= 0) zpool[i] = *(const unsigned*)(Z + (size_t)(row0 + 16 * tq_ - 15 + i) * ZW + Z_ZC + c_); }
    }
    if (tid < DLRU) {
        float ap = 1.0f, hh = 0.0f;
#pragma unroll 1
        for (int jb = 0; jb < 64; jb += 16) {
            unsigned short lq[16], uq16[16], pq[16], hq[16];
#pragma unroll
            for (int j = 0; j < 16; ++j) { lq[j] = LA[(jb + j) * DLRU + tid]; uq16[j] = UU[(jb + j) * DLRU + tid]; }
#pragma unroll
            for (int j = 0; j < 16; ++j) { const float a = __expf(bf2f(lq[j])); hh = a * hh + bf2f(uq16[j]); ap *= a; const unsigned w_ = pg8::cvt_pk_bf16(ap, hh); pq[j] = (unsigned short)(w_ & 0xffffu); hq[j] = (unsigned short)(w_ >> 16); }
#pragma unroll
            for (int j = 0; j < 16; ++j) { LA[(jb + j) * DLRU + tid] = pq[j]; UU[(jb + j) * DLRU + tid] = hq[j]; }
        }
        float* CA = (float*)(ws + WS_CHS); float* CH = CA + 256 * DLRU;
        CA[u * DLRU + tid] = ap; CH[u * DLRU + tid] = hh;
    }
    LAS bf16_t* PL = (LAS bf16_t*)F.lds;
    {
        const int p = tid & 127, tq = tid >> 7, c = 2 * p, g = c >> 6;
        const int tp0 = t0 + 16 * tq;
        float v0[31], v1[31], c0[31], c1[31];
#pragma unroll
        for (int i = 0; i < 31; ++i) {
            const unsigned a = zpool[i];
            v0[i] = bflo(a); v1[i] = bfhi(a);
            c0[i] = (i ? c0[i - 1] : 0.f) + v0[i]; c1[i] = (i ? c1[i - 1] : 0.f) + v1[i];
        }
        LAS bf16_t* dst = PL + (16 * tq) * PLP16 + c;
        if (g == 0) pool_rows<2>(c0, c1, v0, v1, tp0, dst); else if (g == 1) pool_rows<4>(c0, c1, v0, v1, tp0, dst); else if (g == 2) pool_rows<8>(c0, c1, v0, v1, tp0, dst); else pool_rows<16>(c0, c1, v0, v1, tp0, dst);
    }
    __syncthreads();
#pragma unroll
    for (int k = 0; k < 6; ++k) { const int idx = tid + NTHREADS * k;
        const u32x4 va = *(const LAS u32x4*)(LA + idx * 8), vu = *(const LAS u32x4*)(UU + idx * 8);
        *(u32x4*)(A16 + (size_t)row0 * DLRU + idx * 8) = va; *(u32x4*)(U16 + (size_t)row0 * DLRU + idx * 8) = vu; }
    {
        const int mt = wave & 3, gg = wave >> 2, fr = lane & 15, fq = lane >> 4;
        const bf16_t* Wp = (const bf16_t*)(ws + WS_SMALL + 393216) + (size_t)l * 4 * 4096; const float* psc = kin(15) + l * DPOOL;
        bf16_t* Y = (bf16_t*)(ws + WS_Y);
        const LAS bf16_t* prow = PL + (16 * mt + fr) * PLP16; const size_t row = (size_t)(row0 + 16 * mt + fr);
        u32x2 gcq[2][4]; f32x4 psq[2][4]; bf16x8 wpq[2][4][2];
#pragma unroll
        for (int q = 0; q < 2; ++q)
#pragma unroll
            for (int nt = 0; nt < 4; ++nt) { const int g = 2 * gg + q, c = 64 * g + 16 * nt + 4 * fq;
                gcq[q][nt] = *(const u32x2*)(Z + row * ZW + Z_GC + c); psq[q][nt] = *(const f32x4*)(psc + c);
                const bf16_t* wp_ = Wp + (size_t)g * 4096 + (16 * nt + fr) * 64 + 8 * fq; wpq[q][nt][0] = *(const bf16x8*)wp_; wpq[q][nt][1] = *(const bf16x8*)(wp_ + 32); }
#pragma unroll
        for (int q = 0; q < 2; ++q) {
            const int g = 2 * gg + q;
            const bf16x8 xb0 = *(const LAS bf16x8*)(prow + 64 * g + 8 * fq), xb1 = *(const LAS bf16x8*)(prow + 64 * g + 32 + 8 * fq);
#pragma unroll
            for (int nt = 0; nt < 4; ++nt) {
                const bf16x8 a0 = wpq[q][nt][0], a1 = wpq[q][nt][1];
                f32x4 acc = {0.f, 0.f, 0.f, 0.f};
                acc = __builtin_amdgcn_mfma_f32_16x16x32_bf16(a0, xb0, acc, 0, 0, 0); acc = __builtin_amdgcn_mfma_f32_16x16x32_bf16(a1, xb1, acc, 0, 0, 0);
                const int c = 64 * g + 16 * nt + 4 * fq;
                const f32x4 ps = psq[q][nt]; const u32x2 gw_ = gcq[q][nt];
                const float y0 = acc[0] * ps[0] * siluf_(bflo(gw_.x)), y1 = acc[1] * ps[1] * siluf_(bfhi(gw_.x)), y2 = acc[2] * ps[2] * siluf_(bflo(gw_.y)), y3 = acc[3] * ps[3] * siluf_(bfhi(gw_.y));
                *(u32x2*)(Y + row * DM + 768 + c) = (u32x2){pg8::cvt_pk_bf16(y0, y1), pg8::cvt_pk_bf16(y2, y3)};
            }
        }
    }
    __syncthreads();
}

__device__ __forceinline__ void lru_final_unit(Frame& F, int u) {
    const int tid = F.tid; unsigned char* ws = F.ws;
    LAS float* carry = (LAS float*)F.lds;
    if (tid < DLRU) {
        const float* CA = (const float*)(ws + WS_CHS); const float* CH = CA + 256 * DLRU;
        const int b0 = u & ~127;
        float hh = 0.f;
#pragma unroll 16
        for (int j = b0; j < u; ++j) hh = CA[j * DLRU + tid] * hh + CH[j * DLRU + tid];
        carry[tid] = hh;
    }
    __syncthreads();
    const bf16_t* PA = (const bf16_t*)(ws + WS_A32) + (size_t)u * 64 * DLRU; const bf16_t* HL = (const bf16_t*)(ws + WS_U32) + (size_t)u * 64 * DLRU;
    const bf16_t* zg = (const bf16_t*)(ws + WS_Z) + (size_t)u * 64 * ZW + Z_GA; bf16_t* Y = (bf16_t*)(ws + WS_Y) + (size_t)u * 64 * DM;
#pragma unroll
    for (int k0 = 0; k0 < 12; k0 += 6) {
        u32x2 pq[6], hq[6]; u32x2 gq[6];
#pragma unroll
        for (int k = 0; k < 6; ++k) { const int idx = tid + NTHREADS * (k0 + k), row = idx / 96, c = 4 * (idx % 96);
            pq[k] = *(const u32x2*)(PA + (size_t)row * DLRU + c); hq[k] = *(const u32x2*)(HL + (size_t)row * DLRU + c); gq[k] = *(const u32x2*)(zg + (size_t)row * ZW + c); }
#pragma unroll
        for (int k = 0; k < 6; ++k) { const int idx = tid + NTHREADS * (k0 + k), row = idx / 96, c = 4 * (idx % 96);
            const f32x4 cr = *(const LAS f32x4*)(carry + c);
            const f32x4 pv = {bflo(pq[k].x), bfhi(pq[k].x), bflo(pq[k].y), bfhi(pq[k].y)}, hv = {bflo(hq[k].x), bfhi(hq[k].x), bflo(hq[k].y), bfhi(hq[k].y)};
            const f32x4 h = hv + pv * cr; const u32x2 gw_ = gq[k];
            const float y0 = h[0] * siluf_(bflo(gw_.x)), y1 = h[1] * siluf_(bfhi(gw_.x)), y2 = h[2] * siluf_(bflo(gw_.y)), y3 = h[3] * siluf_(bfhi(gw_.y));
            *(u32x2*)(Y + (size_t)row * DM + c) = (u32x2){pg8::cvt_pk_bf16(y0, y1), pg8::cvt_pk_bf16(y2, y3)}; }
    }
    __syncthreads();
}

namespace att {
constexpr int KSLOT = 12288, VSLOT = 8192;
constexpr int L_K = 0, L_V = 3 * KSLOT, L_WS = L_V + 3 * VSLOT, L_OST = L_WS + NWAVES * 256, L_END = L_OST + NWAVES * 8192;
static_assert(L_END <= 131072, "attention LDS");
__device__ __forceinline__ int crow(int r, int hi) { return (r & 3) + 8 * (r >> 2) + 4 * hi; }
__device__ __forceinline__ void glds16(const void* gsrc, unsigned lds_dst) {
    unsigned keep;
    asm volatile("s_mov_b32 %0, m0\n\ts_mov_b32 m0, %2\n\ts_nop 0\n\tglobal_load_lds_dwordx4 %1, off\n\ts_mov_b32 m0, %0" : "=&s"(keep) : "v"(gsrc), "s"(lds_dst) : "memory");
}
__device__ __forceinline__ void glds16s(const void* sbase, unsigned voff, unsigned lds_dst) {
    unsigned keep;
    asm volatile("s_mov_b32 %0, m0\n\ts_mov_b32 m0, %3\n\ts_nop 0\n\tglobal_load_lds_dwordx4 %1, %2\n\ts_mov_b32 m0, %0" : "=&s"(keep) : "v"(voff), "s"(sbase), "s"(lds_dst) : "memory");
}
typedef short v4i16_t __attribute__((ext_vector_type(4)));
__device__ __forceinline__ s16x4 vtr(const LAS char* p) { return __builtin_bit_cast(s16x4, __builtin_amdgcn_ds_read_tr16_b64_v4i16((LAS v4i16_t*)p)); }
typedef float f32x2_t __attribute__((ext_vector_type(2))); typedef __bf16 bf16x2_t __attribute__((ext_vector_type(2)));
__device__ __forceinline__ unsigned cvtpk_s(float lo, float hi) { f32x2_t v = {lo, hi}; bf16x2_t b = __builtin_convertvector(v, bf16x2_t); return __builtin_bit_cast(unsigned, b); }
__device__ __forceinline__ float swapmax(float m) { auto rr = __builtin_amdgcn_permlane32_swap(__float_as_uint(m), __float_as_uint(m), false, false); return fmaxf(__uint_as_float(rr[0]), __uint_as_float(rr[1])); }
__device__ __forceinline__ float swapsum(float m) { auto rr = __builtin_amdgcn_permlane32_swap(__float_as_uint(m), __float_as_uint(m), false, false); return __uint_as_float(rr[0]) + __uint_as_float(rr[1]); }
#define ATT_WAIT_BAR() asm volatile("s_waitcnt vmcnt(0) lgkmcnt(0)\n\ts_barrier" ::: "memory")

__device__ __forceinline__ void attn_unit(Frame& F, int b, int h, int qb) {
    const int lane = F.lane, r32 = lane & 31, hi = lane >> 5, wid = F.wave;
    unsigned char* ws = F.ws;
    const bf16_t* Q = (const bf16_t*)((const unsigned char*)F.out + OUT_Q); const bf16_t* KV = (const bf16_t*)(ws + WS_KV); const bf16_t* KR = (const bf16_t*)((const unsigned char*)F.out + OUT_KR);
    const LAS char* shm = (const LAS char*)F.lds;
    const unsigned lds0 = (unsigned)(uintptr_t)F.lds;
    const long rowbase = (long)b * SEQ; const int q0 = qb * 256;
    const bf16_t* kbase = KV + rowbase * DKV + h * 128 + wid * 8;
    const bf16_t* krbase = KR + rowbase * 32 + (wid & 3) * 8;
    const bf16_t* vbase = KV + (rowbase + 16 * (wid & 3)) * DKV + h * 128 + 64 + (wid >> 2) * 32;
    const unsigned kroffv = (unsigned)lane * 64u, voffv = (unsigned)(lane >> 2) * (DKV * 2) + (unsigned)(lane & 3) * 16u;
    const unsigned kdst = (unsigned)__builtin_amdgcn_readfirstlane(lds0 + L_K + wid * 1024), krdst = kdst + 8 * 1024  , vdst = kdst + (L_V - L_K);
#define ATT_ISSUE_K(t, sl) do { unsigned ko_ = kroffv; asm volatile("" : "+v"(ko_));   glds16s(kbase + (long)(t) * 64 * DKV, ko_ * 24u, kdst + (sl) * KSLOT); if (wid < 4) glds16s(krbase + (long)(t) * 64 * 32, kroffv, krdst + (sl) * KSLOT); } while (0)
#define ATT_ISSUE_V(t, sl) do { glds16s(vbase + (long)(t) * 64 * DKV, voffv, vdst + (sl) * VSLOT); } while (0)
#define ATT_QK(P0, P1, sl) do { const LAS char* kb_ = kfb + (sl) * KSLOT; P0 = f32x16{}; P1 = f32x16{}; \
        _Pragma("unroll") for (int d0 = 0; d0 < 6; ++d0) { \
            const bf16x8 k0_ = *(const LAS bf16x8*)(kb_ + d0 * 2048), k1_ = *(const LAS bf16x8*)(kb_ + d0 * 2048 + 512); \
            P0 = __builtin_amdgcn_mfma_f32_32x32x16_bf16(k0_, qr[d0], P0, 0, 0, 0); \
            P1 = __builtin_amdgcn_mfma_f32_32x32x16_bf16(k1_, qr[d0], P1, 0, 0, 0); } } while (0)
#define MX3(a, b, c) __builtin_fmaxf(__builtin_fmaxf((a), (b)), (c))
#define ATT_THR 8.0f
#define ATT_QKN(P0, P1, sl) do { const LAS char* kb_ = kfb + (sl) * KSLOT; \
        _Pragma("unroll") for (int d0 = 0; d0 < 6; ++d0) { \
            const bf16x8 k0_ = *(const LAS bf16x8*)(kb_ + d0 * 2048), k1_ = *(const LAS bf16x8*)(kb_ + d0 * 2048 + 512); \
            if (d0 == 0) { P0 = __builtin_amdgcn_mfma_f32_32x32x16_bf16(k0_, qr[0], negm, 0, 0, 0); P1 = __builtin_amdgcn_mfma_f32_32x32x16_bf16(k1_, qr[0], negm, 0, 0, 0); } \
            else { P0 = __builtin_amdgcn_mfma_f32_32x32x16_bf16(k0_, qr[d0], P0, 0, 0, 0); P1 = __builtin_amdgcn_mfma_f32_32x32x16_bf16(k1_, qr[d0], P1, 0, 0, 0); } } } while (0)
#define ATT_VF(d0, ks) ({ const s16x4 lo_ = vtr(vb + (d0) * 4096 + (ks) * 1024), hi_ = vtr(vb + (d0) * 4096 + (ks) * 1024 + 512); (bf16x8){lo_[0], lo_[1], lo_[2], lo_[3], hi_[0], hi_[1], hi_[2], hi_[3]}; })
#define ATT_STEP(C0, C1, N0, N1, tt) do { \
        ATT_WAIT_BAR(); \
        const int sl = (tt) & 1; \
        if ((tt) + 2 < NT) ATT_ISSUE_K((tt) + 2, sl); \
        if ((tt) + 1 < NT) ATT_ISSUE_V((tt) + 1, sl ^ 1); \
        if ((tt) <= tmax) { \
            if ((tt) == tmax) { const int kbase = 64 * (tt); \
                _Pragma("unroll") for (int r = 0; r < 16; ++r) { const int kv = kbase + crow(r, hi); if (kv > qabs) C0[r] = -INFINITY; if (kv + 32 > qabs) C1[r] = -INFINITY; } } \
            float ra = MX3(C0[0], C0[1], C1[0]), rb = MX3(C0[2], C0[3], C1[1]); ra = MX3(ra, C1[2], C1[3]); \
            _Pragma("unroll") for (int r = 4; r < 16; r += 4) { ra = MX3(ra, C0[r], C0[r + 1]); rb = MX3(rb, C0[r + 2], C0[r + 3]); ra = MX3(ra, C1[r], C1[r + 1]); rb = MX3(rb, C1[r + 2], C1[r + 3]); } \
            const float rm = swapmax(fmaxf(ra, rb)); \
            if ((tt) == 0 || __any(rm > ATT_THR)) {                                     \
                const float dl = ((tt) == 0) ? rm : fmaxf(rm, 0.f); \
                mref += dl; \
                _Pragma("unroll") for (int r = 0; r < 16; ++r) { C0[r] -= dl; C1[r] -= dl; } \
                _Pragma("unroll") for (int r = 0; r < 16; ++r) negm[r] = -mref; \
                asm volatile("" : "+v"(negm)); \
                if ((tt) != 0) { const float f = __builtin_amdgcn_exp2f(-dl); lrun *= f; \
                    if (hi == 0) wsf[r32] = f; \
                    LDS_WAIT(); \
                    _Pragma("unroll") for (int g4 = 0; g4 < 4; ++g4) { const f32x4 fv = *(const LAS f32x4*)(wsf + 8 * g4 + 4 * hi); \
                        _Pragma("unroll") for (int j = 0; j < 4; ++j) { o0[4 * g4 + j] *= fv[j]; o1[4 * g4 + j] *= fv[j]; } } \
                    LDS_WAIT(); } \
            } \
            ATT_QKN(N0, N1, sl ^ 1);                                                    \
            _Pragma("unroll") for (int r = 0; r < 16; ++r) { C0[r] = __builtin_amdgcn_exp2f(C0[r]); C1[r] = __builtin_amdgcn_exp2f(C1[r]); } \
            float sa = C0[0];                                                           \
            _Pragma("unroll") for (int r = 1; r < 16; ++r) sa += C0[r]; \
            _Pragma("unroll") for (int r = 0; r < 16; ++r) sa += C1[r]; \
            lrun += sa; \
            const u32x4 pw0 = (u32x4){cvtpk_s(C0[0], C0[1]), cvtpk_s(C0[2], C0[3]), cvtpk_s(C0[4], C0[5]), cvtpk_s(C0[6], C0[7])}; \
            const u32x4 pw1 = (u32x4){cvtpk_s(C0[8], C0[9]), cvtpk_s(C0[10], C0[11]), cvtpk_s(C0[12], C0[13]), cvtpk_s(C0[14], C0[15])}; \
            const u32x4 pw2 = (u32x4){cvtpk_s(C1[0], C1[1]), cvtpk_s(C1[2], C1[3]), cvtpk_s(C1[4], C1[5]), cvtpk_s(C1[6], C1[7])}; \
            const u32x4 pw3 = (u32x4){cvtpk_s(C1[8], C1[9]), cvtpk_s(C1[10], C1[11]), cvtpk_s(C1[12], C1[13]), cvtpk_s(C1[14], C1[15])}; \
            const LAS char* vb = vfb + sl * VSLOT; \
            o0 = __builtin_amdgcn_mfma_f32_32x32x16_bf16(__builtin_bit_cast(bf16x8, pw0), ATT_VF(0, 0), o0, 0, 0, 0); \
            o1 = __builtin_amdgcn_mfma_f32_32x32x16_bf16(__builtin_bit_cast(bf16x8, pw0), ATT_VF(1, 0), o1, 0, 0, 0); \
            o0 = __builtin_amdgcn_mfma_f32_32x32x16_bf16(__builtin_bit_cast(bf16x8, pw1), ATT_VF(0, 1), o0, 0, 0, 0); \
            o1 = __builtin_amdgcn_mfma_f32_32x32x16_bf16(__builtin_bit_cast(bf16x8, pw1), ATT_VF(1, 1), o1, 0, 0, 0); \
            o0 = __builtin_amdgcn_mfma_f32_32x32x16_bf16(__builtin_bit_cast(bf16x8, pw2), ATT_VF(0, 2), o0, 0, 0, 0); \
            o1 = __builtin_amdgcn_mfma_f32_32x32x16_bf16(__builtin_bit_cast(bf16x8, pw2), ATT_VF(1, 2), o1, 0, 0, 0); \
            o0 = __builtin_amdgcn_mfma_f32_32x32x16_bf16(__builtin_bit_cast(bf16x8, pw3), ATT_VF(0, 3), o0, 0, 0, 0); \
            o1 = __builtin_amdgcn_mfma_f32_32x32x16_bf16(__builtin_bit_cast(bf16x8, pw3), ATT_VF(1, 3), o1, 0, 0, 0); \
        } } while (0)
    const int NT = 4 * qb + 4, tmax = 4 * qb + (wid >> 1);
    ATT_ISSUE_K(0, 0); ATT_ISSUE_V(0, 0); ATT_ISSUE_K(1, 1);
    bf16x8 qr[6];
    { const bf16_t* qp = Q + (rowbase + q0 + wid * 32 + r32) * DQ + h * 96 + hi * 8;
#pragma unroll
      for (int d0 = 0; d0 < 6; ++d0) qr[d0] = *(const bf16x8*)(qp + d0 * 16); }
    float mref = 0.f, lrun = 0.f;
    f32x16 o0 = {}, o1 = {};
    f32x16 negm = {}; asm volatile("" : "+v"(negm));
    LAS float* wsf = (LAS float*)(F.lds + L_WS) + wid * 64;
    const int qabs = q0 + wid * 32 + r32;
    const LAS char* kfb = shm + L_K + hi * 1024 + r32 * 16;
    const LAS char* vfb = shm + L_V + ((lane >> 4) & 1) * 32 + (lane & 3) * 8 + (4 * hi + ((lane & 15) >> 2)) * 64;
    f32x16 pa0, pa1, pb0, pb1;
    if (wid >= 4) __builtin_amdgcn_s_setprio(1);
    ATT_WAIT_BAR();
    ATT_QKN(pa0, pa1, 0);
#pragma unroll 1
    for (int t = 0; t < NT; t += 2) {
        ATT_STEP(pa0, pa1, pb0, pb1, t);
        ATT_STEP(pb0, pb1, pa0, pa1, t + 1);
    }
    __builtin_amdgcn_s_setprio(0);
#undef ATT_STEP
#undef ATT_VF
#undef ATT_QKN
#undef ATT_THR
#undef MX3
    {
        const bf16_t* Z = (const bf16_t*)((const unsigned char*)kin(19) + WS_Z); bf16_t* Y = (bf16_t*)((unsigned char*)kin(19) + WS_Y);
        int lane_e = lane; asm volatile("" : "+v"(lane_e));
        const float lt = swapsum(lrun);
        if (hi == 0) wsf[r32] = 1.0f / lt;
        LDS_WAIT();
        LAS float* stg = (LAS float*)(F.lds + L_OST) + wid * 2048;
#pragma unroll
        for (int g4 = 0; g4 < 4; ++g4) { const f32x4 f = *(const LAS f32x4*)(wsf + 8 * g4 + 4 * hi);
#pragma unroll
            for (int j = 0; j < 4; ++j) { const int r = 4 * g4 + j, orow = crow(r, hi); stg[orow * 64 + r32] = o0[r] * f[j]; stg[orow * 64 + 32 + r32] = o1[r] * f[j]; } }
        LDS_WAIT();
        const size_t grow0 = (size_t)(rowbase + q0 + wid * 32);
        u32x2 gbq[8];
#pragma unroll
        for (int i = 0; i < 8; ++i) { const int row = i * 4 + (lane_e >> 4), ch = lane_e & 15; gbq[i] = *(const u32x2*)(Z + (grow0 + row) * ZW + Z_GB + 64 * h + 4 * ch); }
#pragma unroll
        for (int i = 0; i < 8; ++i) {
            const int row = i * 4 + (lane_e >> 4), ch = lane_e & 15;
            const f32x4 ov = *(const LAS f32x4*)(stg + row * 64 + ch * 4);
            const u32x2 gw_ = gbq[i];
            const float y0 = ov[0] * siluf_(bflo(gw_.x)), y1 = ov[1] * siluf_(bfhi(gw_.x)), y2 = ov[2] * siluf_(bflo(gw_.y)), y3 = ov[3] * siluf_(bfhi(gw_.y));
            *(u32x2*)(Y + (grow0 + row) * DM + 384 + 64 * h + 4 * ch) = (u32x2){pg8::cvt_pk_bf16(y0, y1), pg8::cvt_pk_bf16(y2, y3)};
        }
        LDS_WAIT();
    }
#undef ATT_ISSUE_K
#undef ATT_ISSUE_V
}
}

__device__ __forceinline__ void phase_final(Frame& F) {
    const int gw = F.bid * NWAVES + F.wave, NGW = F.G * NWAVES, lane = F.lane;
    const ssum_t* ssx = (const ssum_t*)(F.ws + WS_ACC + OFF_SSX) + 4 * M; const float* g = kin(17);
    const bf16_t* XB = (const bf16_t*)(F.ws + WS_XB);
#pragma unroll 4
    for (int m = gw; m < M; m += NGW) {
        const u32x2* xr = (const u32x2*)(XB + (size_t)m * DM) + lane; f32x4* orow = (f32x4*)(F.out + (size_t)m * DM) + lane; const f32x4* gr = (const f32x4*)g + lane;
        const float rs = rsqrtf(ldfx(ssx + m) * (1.0f / 1024.0f) + EPS);
#pragma unroll
        for (int j = 0; j < 4; ++j) { const u32x2 w = xr[64 * j]; const f32x4 v = {bflo(w.x), bfhi(w.x), bflo(w.y), bfhi(w.y)}; orow[64 * j] = v * rs * gr[64 * j]; }
    }
}

#define XB_TMO      128
#define XB_XCNT(j)  (256  + 64 * (j))
#define XB_XSUB(j)  (1280 + 64 * (j))
#define XB_XGEN(j)  (2304 + 64 * (j))
#define XB_TOP      3328
#define XB_TOPGEN   3392
#define XCD_BAR_WORDS 3456
#define XB_SPIN_CAP (1u << 18)

__device__ __forceinline__ unsigned xb_ld(unsigned* p)              { return __hip_atomic_load(p, __ATOMIC_RELAXED, __HIP_MEMORY_SCOPE_AGENT); }
__device__ __forceinline__ unsigned xb_add(unsigned* p, unsigned v) { return __hip_atomic_fetch_add(p, v, __ATOMIC_RELAXED, __HIP_MEMORY_SCOPE_AGENT); }
__device__ __forceinline__ unsigned xb_xcc_id() { return (unsigned)__builtin_amdgcn_s_getreg((3 << 11) | 20) & 0xFu; }
#define XB_SPIN(cond, bar) do { unsigned _sp = 0; while (cond) { __builtin_amdgcn_s_sleep(1); \
    if ((++_sp & 255u) == 0u) { if (xb_ld(&(bar)[XB_TMO])) break; if (_sp > XB_SPIN_CAP) { atomicAdd(&(bar)[XB_TMO], 1u); break; } } } } while (0)

struct XcdBarrier {
    unsigned* bar; unsigned x;
    volatile LAS unsigned* st;
};

__device__ __forceinline__ XcdBarrier xcd_barrier_post(unsigned* bar, volatile LAS unsigned* st) {
    XcdBarrier b; b.bar = bar; b.x = xb_xcc_id(); b.st = st;
    if (threadIdx.x == 0) (void)xb_add(&bar[XB_XCNT(b.x)], 1u);
    return b;
}
__device__ __forceinline__ void xcd_barrier_complete(unsigned* bar, unsigned x, unsigned& nloc, unsigned& nx) {
    const unsigned G = gridDim.x * gridDim.y * gridDim.z;
    unsigned sum, cnt, mine, sp = 0u;
    for (;;) {
        sum = 0u; cnt = 0u; mine = 0u;
#pragma unroll
        for (unsigned j = 0; j < 16; ++j) { const unsigned c = xb_ld(&bar[XB_XCNT(j)]); sum += c; cnt += (c > 0u) ? 1u : 0u; mine = (j == x) ? c : mine; }
        if (sum == G) break;
        __builtin_amdgcn_s_sleep(1);
        if ((++sp & 255u) == 0u) { if (xb_ld(&bar[XB_TMO])) break; if (sp > XB_SPIN_CAP) { atomicAdd(&bar[XB_TMO], 1u); break; } }
    }
    nloc = mine > 0u ? mine : 1u; nx = cnt > 0u ? cnt : 1u;
}

__device__ __forceinline__ void xcd_barrier(const XcdBarrier& b) {
    asm volatile("s_waitcnt vmcnt(0)" ::: "memory");
    __syncthreads();
    if (threadIdx.x == 0) {
        unsigned* bar = b.bar;
        __builtin_amdgcn_s_waitcnt(0);
        unsigned nloc = b.st[0], nx = b.st[1];
        if (nloc == 0u) { xcd_barrier_complete(bar, b.x, nloc, nx); b.st[0] = nloc; b.st[1] = nx; }
        const unsigned old = xb_add(&bar[XB_XSUB(b.x)], 1u);
        const unsigned gen = old / nloc;
        if (old + 1u == (gen + 1u) * nloc) {
            __builtin_amdgcn_fence(__ATOMIC_RELEASE, "agent");
            asm volatile("s_waitcnt vmcnt(0)" ::: "memory");
            const unsigned og = xb_add(&bar[XB_TOP], 1u);
            const unsigned tg = og / nx;
            if (og + 1u == (tg + 1u) * nx) xb_add(&bar[XB_TOPGEN], 1u);
            else XB_SPIN(xb_ld(&bar[XB_TOPGEN]) == tg, bar);
            __builtin_amdgcn_fence(__ATOMIC_ACQUIRE, "agent");
            xb_add(&bar[XB_XGEN(b.x)], 1u);
            asm volatile("s_waitcnt vmcnt(0)" ::: "memory");
        } else {
            XB_SPIN(xb_ld(&bar[XB_XGEN(b.x)]) == gen, bar);
            __builtin_amdgcn_fence(__ATOMIC_ACQUIRE, "agent");
            asm volatile("s_waitcnt vmcnt(0)" ::: "memory");
        }
    }
    __syncthreads();
}

constexpr size_t OFF_BAR = 900 * 1024;
constexpr int LDS_BARST = 150016;
#define MK_FRAME() \
    Frame F; F.lds = (LAS unsigned char*)lds; \
    { int t_ = threadIdx.x; asm volatile("" : "+v"(t_)); F.tid = t_; } \
    F.lane = F.tid & 63; F.wave = __builtin_amdgcn_readfirstlane(F.tid >> 6); \
    F.bid = blockIdx.x; F.G = gridDim.x; F.out = (float*)kin(18); F.ws = (unsigned char*)kin(19); \
    unsigned char* ws = F.ws; (void)ws; \
    ssum_t* ssx = (ssum_t*)(ws + WS_ACC + OFF_SSX); ssum_t* ssq = (ssum_t*)(ws + WS_ACC + OFF_SSQ); ssum_t* sskv = (ssum_t*)(ws + WS_ACC + OFF_SSKV); (void)ssx; (void)ssq; (void)sskv; \
    const float* cosT = (const float*)(ws + WS_ROPE); const float* sinT = cosT + SEQ * 16; (void)cosT; (void)sinT;
#define MK_IN(k) (ph_lo <= (k) && (k) < ph_hi)
#define MK_SEAM(k) do { if ((k) + 1 < ph_hi) { if ((k) == 0 && ph_hi > 18) cg::this_grid().sync();   else { XcdBarrier xb_; xb_.bar = (unsigned*)(kin(19)) + OFF_BAR / 4; xb_.x = xb_xcc_id(); xb_.st = (volatile LAS unsigned*)((LAS unsigned char*)lds + LDS_BARST); xcd_barrier(xb_); } } } while (0)

template <int l> __device__ __forceinline__ void layer_phases(unsigned char* lds, int ph_lo, int ph_hi) {
    if (MK_IN(1 + 4 * l)) {
        MK_FRAME();
#if !defined(NO_GEMM) && !defined(NO_G1)
        pg8::Gemm g{(const pg8::bf16_t*)(ws + WS_XB), (const pg8::bf16_t*)(ws + WS_WIN) + (size_t)l * ZW * 1024, M, ZW, 1024, 1024, 1024};
        pg8::StaticOrder S; S.init(M, ZW, F.G, F.bid);
        EpiZ E{(bf16_t*)(ws + WS_Z), ssx + l * M, ssq + l * M, sskv + l * M};
        pg8::gemm_phase<EpiZ, pg8::StaticOrder, PG8_ALIGN, PG8_SP2>(F.lds, g, S, E);
#endif
        if (F.G == 256 && l + 1 < NL && F.bid >= 128) convert_layer_weights(F, l + 1, (F.bid - 128) * NWAVES + F.wave, 128 * NWAVES);
        MK_SEAM(1 + 4 * l);
    }
    if (MK_IN(2 + 4 * l)) for (int rep2_ = 0; rep2_ < P2_REPEAT; ++rep2_) {
        {
            MK_FRAME();
#if !defined(NO_GEMM) && !defined(NO_G2)
            pg8::Gemm g{(const pg8::bf16_t*)(ws + WS_Z) + Z_CQ, (const pg8::bf16_t*)(ws + WS_WUQ) + (size_t)l * 768 * 384, M, 768, 384, ZW, 384};
            pg8::StaticOrder S; S.init(M, 768, F.G, F.bid);
            EpiQ E{(bf16_t*)((unsigned char*)F.out + OUT_Q), ssq + l * M, cosT, sinT};
            pg8::gemm_phase<EpiQ, pg8::StaticOrder, PG8_ALIGN, PG8_SP2>(F.lds, g, S, E);
#endif
        }
        {
            MK_FRAME();
#if !defined(NO_GEMM) && !defined(NO_G3)
            pg8::Gemm g{(const pg8::bf16_t*)(ws + WS_Z) + Z_CKV, (const pg8::bf16_t*)(ws + WS_WUKV) + (size_t)l * 768 * 256, M, 768, 256, ZW, 256};
            pg8::StaticOrder S; S.init(M, 768, F.G, (F.bid + F.G / 2) % F.G);
            EpiKV E{(bf16_t*)(ws + WS_KV), sskv + l * M};
            pg8::gemm_phase<EpiKV, pg8::StaticOrder, PG8_ALIGN, PG8_SP2>(F.lds, g, S, E);
#endif
        }
        __syncthreads();
        {
            MK_FRAME();
#if !defined(NO_P2)
            for (int u = F.bid; u < 256; u += F.G) phase2_tile(F, l, u);
#endif
        }
        MK_SEAM(2 + 4 * l);
    }
    if (MK_IN(3 + 4 * l)) {
        MK_FRAME();
#ifndef ATT_REPEAT
#define ATT_REPEAT 1
#endif
        int i1 = F.bid;
        if (F.G == 256) { const int v = (F.bid & 7) * 32 + (F.bid >> 3); i1 = (v < 252) ? (v % 21) * 12 + v / 21 : v; }
        for (int rep = 0; rep < ATT_REPEAT; ++rep)
        for (int r = 0;; ++r) {
            int i;
            if (F.G == 256) { if (r >= 2 || (r == 1 && i1 < 128)) break; i = r ? 511 - i1 : i1; }
            else { if (r * F.G >= 384) break; i = (r & 1) ? r * F.G + (F.G - 1 - F.bid) : r * F.G + F.bid; }
#if !defined(NO_ATT)
            if (i < 384) att::attn_unit(F, (i % 12) / 6, (i % 12) % 6, 31 - i / 12);
#endif
        }
        __syncthreads();
        { const int hg = F.G / 2;
          if (i1 >= F.G - hg) for (int u = F.G - 1 - i1; u < 256; u += hg) lru_final_unit(F, u); }
        MK_SEAM(3 + 4 * l);
    }
    if (MK_IN(4 + 4 * l)) {
        MK_FRAME();
#if !defined(NO_GEMM) && !defined(NO_G4)
        pg8::Gemm g{(const pg8::bf16_t*)(ws + WS_Y), (const pg8::bf16_t*)(ws + WS_WOUT) + (size_t)l * 1024 * 1024, M, 1024, 1024, 1024, 1024};
        pg8::StaticOrder S; S.init(M, 1024, F.G, F.bid);
        EpiOut E{(bf16_t*)(ws + WS_XB), ssx + (l + 1) * M};
        pg8::gemm_phase<EpiOut, pg8::StaticOrder, PG8_ALIGN, PG8_SP2>(F.lds, g, S, E);
#endif
        MK_SEAM(4 + 4 * l);
    }
}

__global__ void __launch_bounds__(NTHREADS, 2) mk_fwd(Args args) {
    extern __shared__ __attribute__((aligned(16))) unsigned char lds[];
    const int ph_lo = *(__attribute__((address_space(4))) const int*)((__attribute__((address_space(4))) const char*)__builtin_amdgcn_kernarg_segment_ptr() + 160);
    const int ph_hi = *(__attribute__((address_space(4))) const int*)((__attribute__((address_space(4))) const char*)__builtin_amdgcn_kernarg_segment_ptr() + 164);
    if (threadIdx.x < 2) ((LAS unsigned*)((LAS unsigned char*)lds + LDS_BARST))[threadIdx.x] = 0u;
    __syncthreads();
    (void)xcd_barrier_post((unsigned*)(kin(19)) + OFF_BAR / 4, (volatile LAS unsigned*)((LAS unsigned char*)lds + LDS_BARST));
    if (MK_IN(0)) {
        MK_FRAME();
#if !defined(NO_PRO)
        phase_prologue(F);
#endif
        MK_SEAM(0);
    }
    layer_phases<0>(lds, ph_lo, ph_hi);
    layer_phases<1>(lds, ph_lo, ph_hi);
    layer_phases<2>(lds, ph_lo, ph_hi);
    layer_phases<3>(lds, ph_lo, ph_hi);
    if (MK_IN(17)) {
        MK_FRAME();
        phase_final(F);
    }
}

extern "C" void kernel_launch(void* const* d_in, const int* in_sizes, int n_in, void* d_out, int out_size, void* d_ws, size_t ws_size, hipStream_t stream) {
    static int grid = 0;
    if (grid == 0) {
        if (n_in != 18 || in_sizes[0] != M * DM || out_size != M * DM || ws_size < WS_END) { fprintf(stderr, "kernel_launch: unexpected shapes (n_in %d, in0 %d, out %d, ws %zu)\n", n_in, n_in > 0 ? in_sizes[0] : -1, out_size, ws_size); grid = -1; return; }
        int dev = 0, cus = 0, per_cu = 0;
        hipGetDevice(&dev); hipDeviceGetAttribute(&cus, hipDeviceAttributeMultiprocessorCount, dev);
        if (hipFuncSetAttribute((const void*)mk_fwd, hipFuncAttributeMaxDynamicSharedMemorySize, LDS_BYTES) != hipSuccess) { fprintf(stderr, "kernel_launch: hipFuncSetAttribute failed\n"); grid = -1; return; }
        if (hipOccupancyMaxActiveBlocksPerMultiprocessor(&per_cu, (const void*)mk_fwd, NTHREADS, LDS_BYTES) != hipSuccess || per_cu < 1) { fprintf(stderr, "kernel_launch: occupancy query says %d\n", per_cu); per_cu = 1; }
        (void)hipGetLastError();
        grid = cus;
        if (grid > 256) grid = 256;
    }
    if (grid < 0) return;
    hipMemsetAsync((char*)d_ws + WS_CTL, 0, CTL_ZERO_BYTES, stream);
    hipMemsetAsync((char*)d_ws + WS_ACC, 0, ACC_BYTES, stream);
    Args a{};
    for (int i = 0; i < 18; ++i) a.in[i] = (const float*)d_in[i];
    a.out = (float*)d_out; a.ws = (unsigned char*)d_ws;
#if MK_ONE_LAUNCH
    a.ph_lo = 0; a.ph_hi = 18;
    void* kargs[] = {&a};
    hipError_t e = hipLaunchCooperativeKernel((const void*)mk_fwd, dim3(grid), dim3(NTHREADS), kargs, LDS_BYTES, stream);
    if (e != hipSuccess) fprintf(stderr, "cooperative launch failed: %s (grid %d)\n", hipGetErrorString(e), grid);
#else
    for (int ph = 0; ph < 18; ++ph) {
        a.ph_lo = ph; a.ph_hi = ph + 1;
        hipLaunchKernelGGL(mk_fwd, dim3(grid), dim3(NTHREADS), LDS_BYTES, stream, a);
    }
#endif
}
```

```cpp
#include <hip/hip_runtime.h>
#include <hip/hip_cooperative_groups.h>
#include <cstdio>
#include <cstdint>
#include <cmath>
namespace cg = cooperative_groups;
namespace pg8 {
#define PG8_LAS __attribute__((address_space(3)))
typedef unsigned short bf16_t;
typedef short bf16x8 __attribute__((ext_vector_type(8)));
typedef float f32x4 __attribute__((ext_vector_type(4)));
typedef unsigned u32x4 __attribute__((ext_vector_type(4)));
constexpr int BM = 256, BK = 64, HALF = 128, HTB = HALF * BK * 2  , STAGE_BYTES = 8 * HTB, NXCD = 8, WGM = 8;

__host__ __device__ __forceinline__ int lds_byte(int r, int c) { const int st = (r >> 4) * 2 + (c >> 5), rr = r & 15, cc = c & 31, ob = rr * 64 + cc * 2; return st * 1024 + (ob ^ (((ob >> 9) & 1) << 5)); }
__host__ __device__ __forceinline__ void stage_rc(int b, int& R, int& C) { const int st = b / 1024, sb = b % 1024, swz = sb ^ (((sb >> 9) & 1) << 5); R = (st >> 1) * 16 + swz / 64; C = (st & 1) * 32 + (swz % 64) / 2; }
__host__ __device__ __forceinline__ int perm32(int rho) { const int n = rho >> 4, i = rho & 15; return 8 * (i >> 2) + 4 * n + (i & 3); }

struct Unit { int pm, pn; };
struct Gemm { const bf16_t* A; const bf16_t* Bt; int M, N, K, lda, ldb; };

struct StaticOrder {
    int nM, nN, nwg, G, c;
    __host__ __device__ void init(int M, int N, int G_, int c_) { nM = M / BM; nN = N / BM; nwg = nM * nN; G = G_; c = c_; }
    __host__ __device__ bool next(int i, Unit& u) const {
        const long L = (long)i * G + c; if (L >= nwg) return false;
        int wgid = (int)L; { const int q = nwg / NXCD, r = nwg % NXCD, xcd = wgid % NXCD, off = wgid / NXCD; wgid = (xcd < r ? xcd * (q + 1) : r * (q + 1) + (xcd - r) * q) + off; }
        const int nig = WGM * nN, gid = wgid / nig, fm = gid * WGM, gsz = (nM - fm) < WGM ? (nM - fm) : WGM;
        u.pm = fm + ((wgid % nig) % gsz); u.pn = (wgid % nig) / gsz; return true;
    }
    __device__ __forceinline__ void a_ready(const Unit&) const {}
    __device__ __forceinline__ void done(const Unit&) const {}
};

__device__ __forceinline__ unsigned cvt_pk_bf16(float lo, float hi) { unsigned r; asm volatile("v_cvt_pk_bf16_f32 %0, %1, %2" : "=v"(r) : "v"(lo), "v"(hi)); return r; }
typedef float f32x2 __attribute__((ext_vector_type(2)));
template <class Epi, class Sched, bool ALIGN_EPI, bool SP2>
__device__ __forceinline__ void gemm_phase(PG8_LAS unsigned char* lds, const Gemm g, const Sched& S, const Epi& E) {
    int tid_ = threadIdx.x; asm volatile("" : "+v"(tid_));
    const int tid = tid_, wid = __builtin_amdgcn_readfirstlane(tid >> 6), lane = tid & 63, wr = wid >> 2, wc = wid & 3, fr = lane & 15, fq = lane >> 4;
    const int K = g.K; int nt = K / BK; asm volatile("" : "+s"(nt));
    unsigned voffA[2], voffB[2];
#pragma unroll
    for (int i = 0; i < 2; ++i) { int R, C; stage_rc(tid * 16 + i * 8192, R, C); const int Rb = Epi::PERM ? ((R & ~31) + perm32(R & 31)) : R;
        voffA[i] = (unsigned)(R * g.lda + C) * 2u; voffB[i] = (unsigned)(Rb * g.ldb + C) * 2u; }
    const size_t kstep = (size_t)(BK * 2);
    const size_t hstepA = (size_t)HALF * g.lda * 2, hstepB = (size_t)HALF * g.ldb * 2;
    const size_t tstepA = 2 * hstepA, tstepB = 2 * hstepB;
    const unsigned ldsw = (unsigned)wid * 1024u;
    const int aoff = lds_byte(wr * 64 + fr, fq * 8), boff = lds_byte(wc * 32 + fr, fq * 8);
#define PG8_SA(b, h) (((b) * 2 + (h)) * HTB)
#define PG8_SB(b, h) ((4 + (b) * 2 + (h)) * HTB)
#define PG8_STAGE(bufoff, gbase, voff) do { _Pragma("unroll") for (int _i = 0; _i < 2; ++_i) \
        __builtin_amdgcn_global_load_lds((const unsigned*)((const char*)(gbase) + (voff)[_i]), (PG8_LAS unsigned*)(lds + (bufoff) + ldsw + _i * 8192), 16, 0, 0); } while (0)
#define PG8_LDA(dst, b, h) do { _Pragma("unroll") for (int m = 0; m < 4; ++m) _Pragma("unroll") for (int k = 0; k < 2; ++k) dst[m][k] = *(const PG8_LAS bf16x8*)(lds + PG8_SA(b, h) + aoff + m * 2048 + k * 1024); } while (0)
#define PG8_LDB(dst, b, h) do { _Pragma("unroll") for (int n = 0; n < 2; ++n) _Pragma("unroll") for (int k = 0; k < 2; ++k) dst[n][k] = *(const PG8_LAS bf16x8*)(lds + PG8_SB(b, h) + boff + n * 2048 + k * 1024); } while (0)
#define PG8_MMA(ai, bj, At, Bt) do { __builtin_amdgcn_s_setprio(1); _Pragma("unroll") for (int m = 0; m < 4; ++m) _Pragma("unroll") for (int n = 0; n < 2; ++n) _Pragma("unroll") for (int k = 0; k < 2; ++k) \
        acc[ai][bj][m][n] = __builtin_amdgcn_mfma_f32_16x16x32_bf16(Bt[n][k], At[m][k], acc[ai][bj][m][n], 0, 0, 0); __builtin_amdgcn_s_setprio(0); } while (0)
#define PG8_WAIT_V(n) asm volatile("s_waitcnt vmcnt(" #n ")" ::: "memory")
#define PG8_WAIT_L(n) asm volatile("s_waitcnt lgkmcnt(" #n ")" ::: "memory")
#define PG8_BAR __builtin_amdgcn_s_barrier()
#define PG8_SCHED __builtin_amdgcn_sched_barrier(0)
    Unit cur, nxt; int ui = 0;
    if (!S.next(0, cur)) return;
    f32x4 acc[2][2][4][2];
#pragma unroll
    for (int a = 0; a < 2; ++a)
#pragma unroll
        for (int b = 0; b < 2; ++b)
#pragma unroll
            for (int m = 0; m < 4; ++m)
#pragma unroll
                for (int n = 0; n < 2; ++n) acc[a][b][m][n] = (f32x4){0.f, 0.f, 0.f, 0.f};
    bf16x8 At[4][2], B0[2][2], B1[2][2];
    const char* cA = (const char*)g.A + (size_t)cur.pm * tstepA; const char* cB = (const char*)g.Bt + (size_t)cur.pn * tstepB;
    S.a_ready(cur);
    if constexpr (SP2) {
        PG8_STAGE(PG8_SB(0, 0), cB, voffB); PG8_STAGE(PG8_SB(0, 1), cB + hstepB, voffB); PG8_STAGE(PG8_SA(0, 0), cA, voffA); PG8_STAGE(PG8_SA(0, 1), cA + hstepA, voffA);
        if (wr == 1) PG8_BAR;
        PG8_WAIT_V(2); PG8_BAR;
        PG8_STAGE(PG8_SB(1, 0), cB + kstep, voffB); PG8_STAGE(PG8_SA(1, 0), cA + kstep, voffA); PG8_STAGE(PG8_SB(1, 1), cB + hstepB + kstep, voffB);
        PG8_WAIT_V(6); PG8_BAR;
    } else {
        PG8_STAGE(PG8_SB(0, 0), cB, voffB); PG8_STAGE(PG8_SA(0, 0), cA, voffA); PG8_STAGE(PG8_SB(0, 1), cB + hstepB, voffB); PG8_STAGE(PG8_SA(0, 1), cA + hstepA, voffA);
        if (wr == 1) PG8_BAR;
        PG8_WAIT_V(4); PG8_BAR;
        PG8_STAGE(PG8_SB(1, 0), cB + kstep, voffB); PG8_STAGE(PG8_SA(1, 0), cA + kstep, voffA); PG8_STAGE(PG8_SB(1, 1), cB + hstepB + kstep, voffB);
        PG8_WAIT_V(6); PG8_BAR;
    }
    for (;;) {
        const bool has_next = S.next(ui + 1, nxt);
        const char* nA = has_next ? (const char*)g.A + (size_t)nxt.pm * tstepA : cA; const char* nB = has_next ? (const char*)g.Bt + (size_t)nxt.pn * tstepB : cB;
        for (int t = 0; t < nt; t += 2) {
            const bool last = (t == nt - 2);
            const char* a1 = cA + (size_t)(t + 1) * kstep;
            const char* a2 = last ? nA : cA + (size_t)(t + 2) * kstep; const char* b2 = last ? nB : cB + (size_t)(t + 2) * kstep;
            const char* a3 = a2 + kstep; const char* b3 = b2 + kstep;
            if (last && has_next) S.a_ready(nxt);
            if constexpr (SP2) {
            PG8_LDB(B0, 0, 0); PG8_LDB(B1, 0, 1); PG8_SCHED; PG8_LDA(At, 0, 0); PG8_STAGE(PG8_SA(1, 1), a1 + hstepA, voffA);
            PG8_WAIT_V(8); PG8_WAIT_L(0); PG8_BAR; PG8_MMA(0, 0, At, B0); PG8_MMA(0, 1, At, B1); PG8_BAR; PG8_SCHED;
            PG8_LDA(At, 0, 1); PG8_STAGE(PG8_SB(0, 0), b2, voffB); PG8_STAGE(PG8_SB(0, 1), b2 + hstepB, voffB); PG8_STAGE(PG8_SA(0, 0), a2, voffA);
            PG8_WAIT_V(8); PG8_WAIT_L(0); PG8_BAR; PG8_MMA(1, 0, At, B0); PG8_MMA(1, 1, At, B1); PG8_BAR; PG8_SCHED;
            PG8_LDB(B0, 1, 0); PG8_LDB(B1, 1, 1); PG8_SCHED; PG8_LDA(At, 1, 0); PG8_STAGE(PG8_SA(0, 1), a2 + hstepA, voffA);
            PG8_WAIT_V(8); PG8_WAIT_L(0); PG8_BAR; PG8_MMA(0, 0, At, B0); PG8_MMA(0, 1, At, B1); PG8_BAR; PG8_SCHED;
            PG8_LDA(At, 1, 1); PG8_STAGE(PG8_SB(1, 0), b3, voffB); PG8_STAGE(PG8_SB(1, 1), b3 + hstepB, voffB); PG8_STAGE(PG8_SA(1, 0), a3, voffA);
            PG8_WAIT_V(8); PG8_WAIT_L(0); PG8_BAR; PG8_MMA(1, 0, At, B0); PG8_MMA(1, 1, At, B1); PG8_BAR; PG8_SCHED;
            } else {
            PG8_LDB(B0, 0, 0); PG8_SCHED; PG8_LDA(At, 0, 0); PG8_STAGE(PG8_SA(1, 1), a1 + hstepA, voffA);
            PG8_WAIT_L(8); PG8_BAR; PG8_WAIT_L(0); PG8_MMA(0, 0, At, B0); PG8_BAR; PG8_SCHED;
            PG8_LDB(B1, 0, 1); PG8_STAGE(PG8_SB(0, 0), b2, voffB);
            PG8_BAR; PG8_WAIT_L(0); PG8_MMA(0, 1, At, B1); PG8_BAR;
            PG8_LDA(At, 0, 1); PG8_STAGE(PG8_SA(0, 0), a2, voffA);
            PG8_BAR; PG8_WAIT_L(0); PG8_MMA(1, 0, At, B0); PG8_BAR; PG8_SCHED;
            PG8_STAGE(PG8_SB(0, 1), b2 + hstepB, voffB);
            PG8_WAIT_V(6); PG8_BAR; PG8_MMA(1, 1, At, B1); PG8_BAR;
            PG8_LDB(B0, 1, 0); PG8_SCHED; PG8_LDA(At, 1, 0); PG8_STAGE(PG8_SA(0, 1), a2 + hstepA, voffA);
            PG8_WAIT_L(8); PG8_BAR; PG8_WAIT_L(0); PG8_MMA(0, 0, At, B0); PG8_BAR; PG8_SCHED;
            PG8_LDB(B1, 1, 1); PG8_STAGE(PG8_SB(1, 0), b3, voffB);
            PG8_BAR; PG8_WAIT_L(0); PG8_MMA(0, 1, At, B1); PG8_BAR;
            PG8_LDA(At, 1, 1); PG8_STAGE(PG8_SA(1, 0), a3, voffA);
            PG8_BAR; PG8_WAIT_L(0); PG8_MMA(1, 0, At, B0); PG8_BAR; PG8_SCHED;
            PG8_STAGE(PG8_SB(1, 1), b3 + hstepB, voffB);
            PG8_WAIT_V(6); PG8_BAR; PG8_MMA(1, 1, At, B1); PG8_BAR;
            }
        }
        if constexpr (ALIGN_EPI) { if (wr == 0) PG8_BAR; }
        if constexpr (!Epi::AFTER_DRAIN) { E(acc, cur, wr, wc, fr, fq); S.done(cur); }
        if (!has_next) break;
#pragma unroll
        for (int a = 0; a < 2; ++a)
#pragma unroll
            for (int b = 0; b < 2; ++b)
#pragma unroll
                for (int m = 0; m < 4; ++m)
#pragma unroll
                    for (int n = 0; n < 2; ++n) acc[a][b][m][n] = (f32x4){0.f, 0.f, 0.f, 0.f};
        cur = nxt; cA = nA; cB = nB; ++ui;
        if constexpr (ALIGN_EPI) { if (wr == 1) PG8_BAR; }
    }
    PG8_WAIT_V(0);
    if constexpr (!ALIGN_EPI) { if (wr == 0) PG8_BAR; }
    PG8_BAR;
    if constexpr (Epi::AFTER_DRAIN) { E.fused(acc, cur, wr, wc, fr, fq, lds, wid, lane); S.done(cur); }
#undef PG8_SA
#undef PG8_SB
#undef PG8_STAGE
#undef PG8_LDA
#undef PG8_LDB
#undef PG8_MMA
#undef PG8_WAIT_V
#undef PG8_WAIT_L
#undef PG8_BAR
#undef PG8_SCHED
}
}

#ifndef PG8_SP2
#define PG8_SP2 true
#endif
#ifndef PG8_ALIGN
#define PG8_ALIGN true
#endif
#ifndef P2_REPEAT
#define P2_REPEAT 1
#endif
#ifndef MK_ONE_LAUNCH
#define MK_ONE_LAUNCH 1
#endif

#define LAS __attribute__((address_space(3)))
typedef unsigned short bf16_t;
typedef short bf16x8 __attribute__((ext_vector_type(8)));
typedef short s16x4 __attribute__((ext_vector_type(4)));
typedef float f32x4 __attribute__((ext_vector_type(4)));
typedef float f32x2 __attribute__((ext_vector_type(2)));
typedef float f32x16 __attribute__((ext_vector_type(16)));
typedef unsigned u32x4 __attribute__((ext_vector_type(4)));
typedef unsigned u32x2 __attribute__((ext_vector_type(2)));

constexpr int NB = 2, SEQ = 8192, M = NB * SEQ, DM = 1024, NL = 4;
constexpr int ZW = 2560, DQ = 576, DKV = 768, DLRU = 384, DPOOL = 256;
constexpr int Z_ZA = 0, Z_GA = 384, Z_CQ = 768, Z_CKV = 1152, Z_KR = 1408, Z_GB = 1440, Z_ZC = 1824, Z_GC = 2080, D_IN = 2336;
constexpr float EPS = 1e-6f;
constexpr float QSCALE = 0.10206207261596577f * 1.4426950408889634f;
constexpr int NWAVES = 8, NTHREADS = 512;
constexpr int LDS_BYTES = 155648;

constexpr size_t MiB = 1u << 20;
constexpr size_t WS_CTL = 0, CTL_ZERO_BYTES = 1 * MiB;
typedef unsigned long long ssum_t;
constexpr size_t WS_ACC = 254 * MiB;
constexpr size_t OFF_SSX = 0, OFF_SSQ = (size_t)5 * 16384 * 8, OFF_SSKV = (size_t)9 * 16384 * 8, ACC_BYTES = (size_t)13 * 16384 * 8;
constexpr size_t WS_ROPE = 1 * MiB;
constexpr size_t WS_CHS = 2 * MiB;
constexpr size_t WS_SMALL = 3 * MiB;
constexpr size_t WS_WIN = 4 * MiB, WS_WOUT = 24 * MiB, WS_WUQ = 32 * MiB, WS_WUKV = 35 * MiB;
constexpr size_t WS_XB = 38 * MiB;
constexpr size_t OUT_Q = 0, OUT_KR = 20 * MiB;
constexpr size_t WS_Z = 70 * MiB, WS_KV = 150 * MiB, WS_A32 = 174 * MiB, WS_U32 = 198 * MiB, WS_Y = 222 * MiB, WS_END = 256 * MiB;

struct Args { const float* in[18]; float* out; unsigned char* ws; int ph_lo, ph_hi; };

struct Frame {
    LAS unsigned char* lds;
    int tid, lane, wave, bid, G;
    float* out; unsigned char* ws;
};
typedef __attribute__((address_space(1))) const float* gfp_t;
__device__ __forceinline__ const float* kin(int i) {
    __attribute__((address_space(4))) const char* k = (__attribute__((address_space(4))) const char*)__builtin_amdgcn_kernarg_segment_ptr();
    asm volatile("" : "+s"(k));
    gfp_t p_ = *(__attribute__((address_space(4))) const gfp_t*)(k + 8 * i);
    return (const float*)p_; }

__device__ __forceinline__ unsigned f2bf(float f) { unsigned u = __builtin_bit_cast(unsigned, f); return (u + 0x7fffu + ((u >> 16) & 1u)) >> 16; }
__device__ __forceinline__ unsigned pk2(float lo, float hi) { return f2bf(lo) | (f2bf(hi) << 16); }
__device__ __forceinline__ float bf2f(unsigned short b) { return __builtin_bit_cast(float, (unsigned)b << 16); }
__device__ __forceinline__ float bflo(unsigned w) { return __builtin_bit_cast(float, w << 16); }
__device__ __forceinline__ float bfhi(unsigned w) { return __builtin_bit_cast(float, w & 0xffff0000u); }
__device__ __forceinline__ float sigmoidf_(float x) { return 1.0f / (1.0f + __expf(-x)); }
__device__ __forceinline__ float siluf_(float x) { return x * __builtin_amdgcn_rcpf(1.0f + __expf(-x)); }
__device__ __forceinline__ float wave_sum(float v) {
#pragma unroll
    for (int o = 1; o < 64; o <<= 1) v += __shfl_xor(v, o);
    return v;
}
__device__ __forceinline__ void atomic_addf(ssum_t* p, float v) { (void)__hip_atomic_fetch_add(p, (ssum_t)(v * 16777216.0f), __ATOMIC_RELAXED, __HIP_MEMORY_SCOPE_AGENT); }
__device__ __forceinline__ float ldfx(const ssum_t* p) { return (float)(*p) * (1.0f / 16777216.0f); }
#define LDS_WAIT() asm volatile("s_waitcnt lgkmcnt(0)" ::: "memory")
__device__ __forceinline__ float fast_sigmoid(float x) { return __builtin_amdgcn_rcpf(1.0f + __expf(-x)); }
__device__ __forceinline__ float neg_expm1(float x) {
    const float ser = -x * (1.0f + x * (0.5f + x * (0.16666667f + x * (0.041666668f + x * 0.0083333338f))));
    const float dir = 1.0f - __expf(x);
    return (x > -0.25f) ? ser : dir;
}

struct EpiZ {
    static constexpr bool PERM = true, AFTER_DRAIN = false;
    bf16_t* Zb; const ssum_t* ssx; ssum_t* ssq; ssum_t* sskv;
    __device__ __forceinline__ void operator()(const pg8::f32x4 (&acc)[2][2][4][2], const pg8::Unit& u, int wr, int wc, int fr, int fq) const {
        const int row0 = u.pm * 256 + wr * 64 + fr, col0 = u.pn * 256 + wc * 32 + 8 * fq;
#pragma unroll
        for (int ai = 0; ai < 2; ++ai)
#pragma unroll
            for (int m = 0; m < 4; ++m) {
                const int row = row0 + ai * 128 + m * 16;
                const float rs = rsqrtf(ldfx(ssx + row) * (1.0f / 1024.0f) + EPS);
#pragma unroll
                for (int bj = 0; bj < 2; ++bj) {
                    const f32x4 v0 = acc[ai][bj][m][0] * rs, v1 = acc[ai][bj][m][1] * rs;
                    u32x4 w; w.x = pg8::cvt_pk_bf16(v0[0], v0[1]); w.y = pg8::cvt_pk_bf16(v0[2], v0[3]); w.z = pg8::cvt_pk_bf16(v1[0], v1[1]); w.w = pg8::cvt_pk_bf16(v1[2], v1[3]);
                    if (u.pn * 256 + bj * 128 + wc * 32 < D_IN) *(u32x4*)(Zb + (size_t)row * ZW + col0 + bj * 128) = w;
                    const int ht = u.pn * 2 + bj;
                    if (ht >= 6 && ht <= 10) {
                        float s = (v0[0] * v0[0] + v0[1] * v0[1]) + (v0[2] * v0[2] + v0[3] * v0[3]) + (v1[0] * v1[0] + v1[1] * v1[1]) + (v1[2] * v1[2] + v1[3] * v1[3]);
                        s += __shfl_xor(s, 16); s += __shfl_xor(s, 32);
                        if (fq == 0) atomic_addf((ht <= 8 ? ssq : sskv) + row, s);
                    }
                }
                asm volatile("" ::: "memory");
            }
    }
};
struct EpiQ {
    static constexpr bool PERM = true, AFTER_DRAIN = false;
    bf16_t* Qb; const ssum_t* ssq; const float* cosT; const float* sinT;
    __device__ __forceinline__ void operator()(const pg8::f32x4 (&acc)[2][2][4][2], const pg8::Unit& u, int wr, int wc, int fr, int fq) const {
        const int row0 = u.pm * 256 + wr * 64 + fr;
#pragma unroll
        for (int bj = 0; bj < 2; ++bj) {
            const int cg0 = u.pn * 256 + bj * 128 + wc * 32;
            if (cg0 >= DQ) continue;
            const bool rope = ((cg0 >> 5) % 3) == 2;
#pragma unroll
            for (int ai = 0; ai < 2; ++ai)
#pragma unroll
                for (int m = 0; m < 4; ++m) {
                    const int row = row0 + ai * 128 + m * 16;
                    const float rs = rsqrtf(ldfx(ssq + row) * (1.0f / 384.0f) + EPS) * QSCALE;
                    f32x4 v0 = acc[ai][bj][m][0] * rs, v1 = acc[ai][bj][m][1] * rs;
                    if (rope) {
                        const int pos = row & (SEQ - 1);
                        const f32x4 c0 = *(const f32x4*)(cosT + pos * 16 + 8 * (fq & 1)), c1 = *(const f32x4*)(cosT + pos * 16 + 8 * (fq & 1) + 4);
                        const f32x4 s0 = *(const f32x4*)(sinT + pos * 16 + 8 * (fq & 1)), s1 = *(const f32x4*)(sinT + pos * 16 + 8 * (fq & 1) + 4);
                        const float sg = (fq < 2) ? -1.0f : 1.0f;
                        f32x4 p0, p1;
#pragma unroll
                        for (int j = 0; j < 4; ++j) { p0[j] = __shfl_xor(v0[j], 32); p1[j] = __shfl_xor(v1[j], 32); }
                        v0 = v0 * c0 + (p0 * s0) * sg; v1 = v1 * c1 + (p1 * s1) * sg;
                    }
                    u32x4 w; w.x = pg8::cvt_pk_bf16(v0[0], v0[1]); w.y = pg8::cvt_pk_bf16(v0[2], v0[3]); w.z = pg8::cvt_pk_bf16(v1[0], v1[1]); w.w = pg8::cvt_pk_bf16(v1[2], v1[3]);
                    *(u32x4*)(Qb + (size_t)row * DQ + cg0 + 8 * fq) = w;
                    asm volatile("" ::: "memory");
                }
        }
    }
};
struct EpiKV {
    static constexpr bool PERM = true, AFTER_DRAIN = false;
    bf16_t* KVb; const ssum_t* sskv;
    __device__ __forceinline__ void operator()(const pg8::f32x4 (&acc)[2][2][4][2], const pg8::Unit& u, int wr, int wc, int fr, int fq) const {
        const int row0 = u.pm * 256 + wr * 64 + fr, col0 = u.pn * 256 + wc * 32 + 8 * fq;
#pragma unroll
        for (int ai = 0; ai < 2; ++ai)
#pragma unroll
            for (int m = 0; m < 4; ++m) {
                const int row = row0 + ai * 128 + m * 16;
                const float rs = rsqrtf(ldfx(sskv + row) * (1.0f / 256.0f) + EPS);
#pragma unroll
                for (int bj = 0; bj < 2; ++bj) {
                    const f32x4 v0 = acc[ai][bj][m][0] * rs, v1 = acc[ai][bj][m][1] * rs;
                    u32x4 w; w.x = pg8::cvt_pk_bf16(v0[0], v0[1]); w.y = pg8::cvt_pk_bf16(v0[2], v0[3]); w.z = pg8::cvt_pk_bf16(v1[0], v1[1]); w.w = pg8::cvt_pk_bf16(v1[2], v1[3]);
                    *(u32x4*)(KVb + (size_t)row * DKV + col0 + bj * 128) = w;
                }
                asm volatile("" ::: "memory");
            }
    }
};
struct EpiOut {
    static constexpr bool PERM = true, AFTER_DRAIN = false;
    bf16_t* XB; ssum_t* ssn;
    __device__ __forceinline__ void operator()(const pg8::f32x4 (&acc)[2][2][4][2], const pg8::Unit& u, int wr, int wc, int fr, int fq) const {
        const int row0 = u.pm * 256 + wr * 64 + fr, col0 = u.pn * 256 + wc * 32 + 8 * fq;
#pragma unroll
        for (int ai = 0; ai < 2; ++ai)
#pragma unroll
            for (int m = 0; m < 4; ++m) {
                const int row = row0 + ai * 128 + m * 16;
                float s = 0.f;
#pragma unroll
                for (int bj = 0; bj < 2; ++bj) {
                    const size_t off = (size_t)row * DM + col0 + bj * 128;
                    const u32x4 xw = *(const u32x4*)(XB + off);
                    const f32x4 v0 = (f32x4){bflo(xw.x), bfhi(xw.x), bflo(xw.y), bfhi(xw.y)} + acc[ai][bj][m][0], v1 = (f32x4){bflo(xw.z), bfhi(xw.z), bflo(xw.w), bfhi(xw.w)} + acc[ai][bj][m][1];
                    u32x4 w; w.x = pg8::cvt_pk_bf16(v0[0], v0[1]); w.y = pg8::cvt_pk_bf16(v0[2], v0[3]); w.z = pg8::cvt_pk_bf16(v1[0], v1[1]); w.w = pg8::cvt_pk_bf16(v1[2], v1[3]);
                    *(u32x4*)(XB + off) = w;
                    s += (v0[0] * v0[0] + v0[1] * v0[1]) + (v0[2] * v0[2] + v0[3] * v0[3]) + (v1[0] * v1[0] + v1[1] * v1[1]) + (v1[2] * v1[2] + v1[3] * v1[3]);
                }
                s += __shfl_xor(s, 16); s += __shfl_xor(s, 32);
                if (fq == 0) atomic_addf(ssn + row, s);
                asm volatile("" ::: "memory");
            }
    }
};

struct EpiAll {
    static constexpr bool PERM = true, AFTER_DRAIN = false;
    int mode; void* a; void* b; void* c; void* d;
    __device__ __forceinline__ void operator()(const pg8::f32x4 (&acc)[2][2][4][2], const pg8::Unit& u, int wr, int wc, int fr, int fq) const {
#ifdef ONLY_MODE
        if (mode != ONLY_MODE) return;
#endif
        if (mode == 0) { EpiZ E{(bf16_t*)a, (const ssum_t*)b, (ssum_t*)c, (ssum_t*)d}; E(acc, u, wr, wc, fr, fq); }
        else if (mode == 1) { EpiQ E{(bf16_t*)a, (const ssum_t*)b, (const float*)c, (const float*)d}; E(acc, u, wr, wc, fr, fq); }
        else if (mode == 2) { EpiKV E{(bf16_t*)a, (const ssum_t*)b}; E(acc, u, wr, wc, fr, fq); }
        else { EpiOut E{(bf16_t*)c, (ssum_t*)d}; E(acc, u, wr, wc, fr, fq); }
    }
};

__device__ __forceinline__ void p0_transpose_item(const float* W, int N, const float* g, bf16_t* WT, int ldt, LAS float* scr, int item, int lane) {
    const int nblk = N / 32, kb = item / nblk, nb = item % nblk, k0 = 64 * kb, n0 = 32 * nb;
#pragma unroll 8
    for (int i = 0; i < 32; ++i) { const int kk = 2 * i + (lane >> 5); float v = W[(size_t)(k0 + kk) * N + n0 + (lane & 31)]; if (g) v *= g[k0 + kk]; scr[kk * 33 + (lane & 31)] = v; }
    LDS_WAIT(); asm volatile("" ::: "memory");
    const int c = lane & 7;
#pragma unroll
    for (int j = 0; j < 4; ++j) { const int n = (lane >> 3) + 8 * j; const LAS float* s = scr + (8 * c) * 33 + n;
        u32x4 o; o.x = pk2(s[0 * 33], s[1 * 33]); o.y = pk2(s[2 * 33], s[3 * 33]); o.z = pk2(s[4 * 33], s[5 * 33]); o.w = pk2(s[6 * 33], s[7 * 33]);
        *(u32x4*)(WT + (size_t)(n0 + n) * ldt + k0 + 8 * c) = o; }
    LDS_WAIT(); asm volatile("" ::: "memory");
}
__device__ __forceinline__ void convert_layer_weights(Frame& F, int l, int gw, int NGW) {
    LAS float* scr = (LAS float*)(F.lds + F.wave * 16384);
    const int lane = F.lane;
    unsigned char* ws = F.ws;
    constexpr int I_IN = 16 * 73, I_OUT = 16 * 32, I_UQ = 6 * 18, I_UKV = 4 * 24, I_G = 12, I_P = 8;
    constexpr int I_L = I_IN + I_OUT + I_UQ + I_UKV + 2 * I_G + I_P;
    for (int it = gw; it < I_L; it += NGW) {
        int r = it;
        if (r < I_IN) { p0_transpose_item(kin(2) + (size_t)l * 1024 * D_IN, D_IN, kin(1) + l * 1024, (bf16_t*)(ws + WS_WIN) + (size_t)l * ZW * 1024, 1024, scr, r, lane); continue; } r -= I_IN;
        if (r < I_OUT) { p0_transpose_item(kin(16) + (size_t)l * 1024 * 1024, 1024, nullptr, (bf16_t*)(ws + WS_WOUT) + (size_t)l * 1024 * 1024, 1024, scr, r, lane); continue; } r -= I_OUT;
        if (r < I_UQ) { p0_transpose_item(kin(11) + (size_t)l * 384 * DQ, DQ, kin(10) + l * 384, (bf16_t*)(ws + WS_WUQ) + (size_t)l * 768 * 384, 384, scr, r, lane); continue; } r -= I_UQ;
        if (r < I_UKV) { p0_transpose_item(kin(13) + (size_t)l * 256 * DKV, DKV, kin(12) + l * 256, (bf16_t*)(ws + WS_WUKV) + (size_t)l * 768 * 256, 256, scr, r, lane); continue; } r -= I_UKV;
        if (r < I_G) { const int h = r >> 1; p0_transpose_item(kin(5) + (size_t)(l * 6 + h) * 4096, 64, nullptr, (bf16_t*)(ws + WS_SMALL) + (size_t)(l * 6 + h) * 4096, 64, scr, r & 1, lane); continue; } r -= I_G;
        if (r < I_G) { const int h = r >> 1; p0_transpose_item(kin(7) + (size_t)(l * 6 + h) * 4096, 64, nullptr, (bf16_t*)(ws + WS_SMALL + 196608) + (size_t)(l * 6 + h) * 4096, 64, scr, r & 1, lane); continue; } r -= I_G;
        { const int gq = r >> 1; p0_transpose_item(kin(14) + (size_t)(l * 4 + gq) * 4096, 64, nullptr, (bf16_t*)(ws + WS_SMALL + 393216) + (size_t)(l * 4 + gq) * 4096, 64, scr, r & 1, lane); }
    }
}
__device__ __forceinline__ void phase_prologue(Frame& F) {
    const int gw = F.bid * NWAVES + F.wave, NGW = F.G * NWAVES, lane = F.lane;
    unsigned char* ws = F.ws;
    convert_layer_weights(F, 0, gw, NGW);
    if (F.G != 256) { for (int l = 1; l < NL; ++l) convert_layer_weights(F, l, gw, NGW); }
    {
        const int gt = F.bid * NTHREADS + F.tid, NGT = F.G * NTHREADS;
        constexpr int ZIN = 224 * 1024 * 2 / 16, ZUQ = 192 * 384 * 2 / 16;
        for (int i = gt; i < NL * (ZIN + ZUQ); i += NGT) {
            const int l = i / (ZIN + ZUQ), r = i % (ZIN + ZUQ);
            u32x4* p = (r < ZIN) ? (u32x4*)(ws + WS_WIN + ((size_t)l * ZW + D_IN) * 1024 * 2) + r : (u32x4*)(ws + WS_WUQ + ((size_t)l * 768 + DQ) * 384 * 2) + (r - ZIN);
            *p = (u32x4){0u, 0u, 0u, 0u};
        }
        float* SP = (float*)(ws + WS_SMALL + 524288);
        for (int i = gt; i < NL * DLRU; i += NGT) SP[i] = log1pf(expf(-kin(9)[i]));
        float* cosT = (float*)(ws + WS_ROPE); float* sinT = cosT + SEQ * 16;
        for (int i = gt; i < SEQ * 16; i += NGT) {
            const int pos = i >> 4, fi = i & 15, j = fi & 3, k = fi >> 2;
            double inv = (j == 0) ? 1.0 : (j == 1) ? 0.56234132519034908 : (j == 2) ? 0.31622776601683794 : 0.17782794100389228;
            inv *= (k == 0) ? 1.0 : (k == 1) ? 0.1 : (k == 2) ? 0.01 : 0.001;
            const double ang = (double)pos * inv;
            const double n = __builtin_rint(ang * 0.15915494309189535);
            double rr = __builtin_fma(-n, 6.283185307179586, ang); rr = __builtin_fma(-n, 2.4492935982947064e-16, rr);
            const double r2 = rr * rr; double tc = 1.0, sc = 1.0, tsn = rr, ss = rr;
#pragma unroll 1
            for (int q = 1; q <= 15; ++q) { tc *= -r2 / (double)((2 * q - 1) * (2 * q)); sc += tc; tsn *= -r2 / (double)((2 * q) * (2 * q + 1)); ss += tsn; }
            cosT[i] = (float)sc; sinT[i] = (float)ss;
        }
    }
    {
        const float* x = kin(0); bf16_t* XB = (bf16_t*)(ws + WS_XB); ssum_t* ssx = (ssum_t*)(ws + WS_ACC + OFF_SSX);
#pragma unroll 4
        for (int m = gw; m < M; m += NGW) {
            const f32x4* xr = (const f32x4*)(x + (size_t)m * DM) + lane; u32x2* o = (u32x2*)(XB + (size_t)m * DM) + lane;
            float s = 0.f;
#pragma unroll
            for (int j = 0; j < 4; ++j) { const f32x4 v = xr[64 * j]; s += (v.x * v.x + v.y * v.y) + (v.z * v.z + v.w * v.w); o[64 * j] = (u32x2){pk2(v.x, v.y), pk2(v.z, v.w)}; }
            s = wave_sum(s);
            if (lane == 0) ssx[m] = (ssum_t)(s * 16777216.0f);
        }
    }
}

__device__ __forceinline__ bf16x8 ld_x_frag(const LAS float* p) {
    const f32x4 a = *(const LAS f32x4*)p, b = *(const LAS f32x4*)(p + 4);
    u32x4 w; w.x = pg8::cvt_pk_bf16(a[0], a[1]); w.y = pg8::cvt_pk_bf16(a[2], a[3]); w.z = pg8::cvt_pk_bf16(b[0], b[1]); w.w = pg8::cvt_pk_bf16(b[2], b[3]);
    return __builtin_bit_cast(bf16x8, w);
}
constexpr int XAP16 = 392, PLP16 = 264;
constexpr int L2_LA = 64 * XAP16 * 2, L2_UU = L2_LA + 64 * DLRU * 2, L2_END = L2_UU + 64 * DLRU * 2;
static_assert(L2_END <= 150016, "phase-2 LDS map (below the barrier's LDS words)");
template <int W> __device__ __forceinline__ void pool_rows(const float (&c0)[31], const float (&c1)[31], const float (&v0)[31], const float (&v1)[31], int tpos0, LAS bf16_t* dst) {
#pragma unroll
    for (int j = 0; j < 16; ++j) {
        const int idx = 15 + j; const int tp = tpos0 + j;
        float s0 = c0[idx], s1 = c1[idx];
        if (idx - W >= 0) { s0 -= c0[idx - W >= 0 ? idx - W : 0]; s1 -= c1[idx - W >= 0 ? idx - W : 0]; }
        const float rc = __builtin_amdgcn_rcpf((float)((tp + 1 < W) ? tp + 1 : W));
        *(LAS unsigned*)(dst + j * PLP16) = pg8::cvt_pk_bf16(s0 * rc - v0[idx], s1 * rc - v1[idx]);
    }
}
__device__ __forceinline__ void phase2_tile(Frame& F, int l, int u) {
    const int tid = F.tid, lane = F.lane, wave = F.wave;
    unsigned char* ws = F.ws;
    const bf16_t* Z = (const bf16_t*)(ws + WS_Z);
    const int row0 = u * 64, t0 = (u & 127) * 64;
    LAS bf16_t* XA = (LAS bf16_t*)F.lds;
    LAS bf16_t* LA = (LAS bf16_t*)(F.lds + L2_LA); LAS bf16_t* UU = (LAS bf16_t*)(F.lds + L2_UU);
    bf16_t* A16 = (bf16_t*)(ws + WS_A32); bf16_t* U16 = (bf16_t*)(ws + WS_U32);
    if (tid < 384) {
        const int p = tid % 192, half = tid / 192, c = 2 * p;
        const float* cw = kin(3) + (size_t)l * 4 * DLRU; const float* cb = kin(4) + (size_t)l * DLRU;
        const f32x2 w0 = *(const f32x2*)(cw + c), w1 = *(const f32x2*)(cw + DLRU + c), w2 = *(const f32x2*)(cw + 2 * DLRU + c), w3 = *(const f32x2*)(cw + 3 * DLRU + c), bb = *(const f32x2*)(cb + c);
        const int ts = t0 + 32 * half;
        const bf16_t* zp = Z + (size_t)(row0 + 32 * half) * ZW + Z_ZA + c;
        unsigned zr[35];
#pragma unroll
        for (int j = 0; j < 35; ++j) { zr[j] = 0u; if (j >= 3 || ts >= 3) zr[j] = *(const unsigned*)(zp + (ptrdiff_t)(j - 3) * ZW); }
#pragma unroll
        for (int j = 0; j < 32; ++j) {
            const f32x2 x0 = {bflo(zr[j]), bfhi(zr[j])}, x1 = {bflo(zr[j + 1]), bfhi(zr[j + 1])}, x2 = {bflo(zr[j + 2]), bfhi(zr[j + 2])}, x3 = {bflo(zr[j + 3]), bfhi(zr[j + 3])};
            const f32x2 y = bb + w0 * x0 + w1 * x1 + w2 * x2 + w3 * x3;
            *(LAS unsigned*)(XA + (32 * half + j) * XAP16 + c) = pg8::cvt_pk_bf16(y.x, y.y);
        }
    } else {
        const float* cosT = (const float*)(ws + WS_ROPE); const float* sinT = cosT + SEQ * 16;
        bf16_t* KR = (bf16_t*)((unsigned char*)F.out + OUT_KR);
        float ka[8], kb2[8], kc[8], ks[8];
#pragma unroll
        for (int q = 0; q < 8; ++q) { const int it = tid - 384 + 128 * q, tk = it >> 4, i = it & 15, row = row0 + tk, pos = t0 + tk;
            ka[q] = bf2f(Z[(size_t)row * ZW + Z_KR + i]); kb2[q] = bf2f(Z[(size_t)row * ZW + Z_KR + 16 + i]); kc[q] = cosT[pos * 16 + i]; ks[q] = sinT[pos * 16 + i]; }
#pragma unroll
        for (int q = 0; q < 8; ++q) { const int it = tid - 384 + 128 * q, tk = it >> 4, i = it & 15, row = row0 + tk;
            KR[(size_t)row * 32 + i] = (bf16_t)f2bf(ka[q] * kc[q] - kb2[q] * ks[q]); KR[(size_t)row * 32 + 16 + i] = (bf16_t)f2bf(ka[q] * ks[q] + kb2[q] * kc[q]); }
    }
    __syncthreads();
    {
        const int mt = wave & 3, hg = wave >> 2, fr = lane & 15, fq = lane >> 4;
        const bf16_t* Wr = (const bf16_t*)(ws + WS_SMALL) + (size_t)l * 6 * 4096; const bf16_t* Wi = (const bf16_t*)(ws + WS_SMALL + 196608) + (size_t)l * 6 * 4096;
        const float* br = kin(6) + l * DLRU; const float* bi = kin(8) + l * DLRU; const float* SP = (const float*)(ws + WS_SMALL + 524288) + l * DLRU;
        const LAS bf16_t* xrow = XA + (16 * mt + fr) * XAP16; const int lrow = (16 * mt + fr) * DLRU;
        const size_t grow = (size_t)(row0 + 16 * mt + fr) * DLRU;
#pragma unroll 1
        for (int hh = 0; hh < 3; ++hh) {
            const int h = 3 * hg + hh;
            const bf16x8 xb0 = *(const LAS bf16x8*)(xrow + 64 * h + 8 * fq), xb1 = *(const LAS bf16x8*)(xrow + 64 * h + 32 + 8 * fq);
            bf16x8 wfr[4][4]; f32x4 brq[4], biq[4], spq[4];
#pragma unroll
            for (int nt = 0; nt < 4; ++nt) {
                const bf16_t* wr_ = Wr + (size_t)h * 4096 + (16 * nt + fr) * 64 + 8 * fq; const bf16_t* wi_ = Wi + (size_t)h * 4096 + (16 * nt + fr) * 64 + 8 * fq;
                wfr[nt][0] = *(const bf16x8*)wr_; wfr[nt][1] = *(const bf16x8*)(wr_ + 32); wfr[nt][2] = *(const bf16x8*)wi_; wfr[nt][3] = *(const bf16x8*)(wi_ + 32);
                const int c = 64 * h + 16 * nt + 4 * fq;
                brq[nt] = *(const f32x4*)(br + c); biq[nt] = *(const f32x4*)(bi + c); spq[nt] = *(const f32x4*)(SP + c);
            }
#pragma unroll
            for (int nt = 0; nt < 4; ++nt) {
                const bf16x8 ar0 = wfr[nt][0], ar1 = wfr[nt][1], ai0 = wfr[nt][2], ai1 = wfr[nt][3];
                f32x4 accR = {0.f, 0.f, 0.f, 0.f}, accI = {0.f, 0.f, 0.f, 0.f};
                accR = __builtin_amdgcn_mfma_f32_16x16x32_bf16(ar0, xb0, accR, 0, 0, 0); accR = __builtin_amdgcn_mfma_f32_16x16x32_bf16(ar1, xb1, accR, 0, 0, 0);
                accI = __builtin_amdgcn_mfma_f32_16x16x32_bf16(ai0, xb0, accI, 0, 0, 0); accI = __builtin_amdgcn_mfma_f32_16x16x32_bf16(ai1, xb1, accI, 0, 0, 0);
                const int c = 64 * h + 16 * nt + 4 * fq;
                const u32x2 xw_ = *(const LAS u32x2*)(xrow + c);
                const f32x4 brv = brq[nt], biv = biq[nt], spv = spq[nt], xav = {bflo(xw_.x), bfhi(xw_.x), bflo(xw_.y), bfhi(xw_.y)};
                f32x4 lv, uv;
#pragma unroll
                for (int v = 0; v < 4; ++v) {
                    const float r = fast_sigmoid(accR[v] + brv[v]), ig = fast_sigmoid(accI[v] + biv[v]);
                    const float la = -8.0f * r * spv[v];
                    lv[v] = la; uv[v] = __builtin_amdgcn_sqrtf(neg_expm1(2.0f * la)) * (ig * xav[v]);
                }
                *(LAS u32x2*)(LA + lrow + c) = (u32x2){pg8::cvt_pk_bf16(lv[0], lv[1]), pg8::cvt_pk_bf16(lv[2], lv[3])};
                *(LAS u32x2*)(UU + lrow + c) = (u32x2){pg8::cvt_pk_bf16(uv[0], uv[1]), pg8::cvt_pk_bf16(uv[2], uv[3])};
            }
        }
    }
    __syncthreads();
    unsigned zpool[31];
    {
        const int p_ = tid & 127, tq_ = tid >> 7, c_ = 2 * p_, tp0_ = t0 + 16 * tq_;
#pragma unroll
        for (int i = 0; i < 31; ++i) { zpool[i] = 0u; if (tp0_ - 15 + i >= 0) zpool[i] = *(const unsigned*)(Z + (size_t)(row0 + 16 * tq_ - 15 + i) * ZW + Z_ZC + c_); }
    }
    if (tid < DLRU) {
        float ap = 1.0f, hh = 0.0f;
#pragma unroll 1
        for (int jb = 0; jb < 64; jb += 16) {
            unsigned short lq[16], uq16[16], pq[16], hq[16];
#pragma unroll
            for (int j = 0; j < 16; ++j) { lq[j] = LA[(jb + j) * DLRU + tid]; uq16[j] = UU[(jb + j) * DLRU + tid]; }
#pragma unroll
            for (int j = 0; j < 16; ++j) { const float a = __expf(bf2f(lq[j])); hh = a * hh + bf2f(uq16[j]); ap *= a; const unsigned w_ = pg8::cvt_pk_bf16(ap, hh); pq[j] = (unsigned short)(w_ & 0xffffu); hq[j] = (unsigned short)(w_ >> 16); }
#pragma unroll
            for (int j = 0; j < 16; ++j) { LA[(jb + j) * DLRU + tid] = pq[j]; UU[(jb + j) * DLRU + tid] = hq[j]; }
        }
        float* CA = (float*)(ws + WS_CHS); float* CH = CA + 256 * DLRU;
        CA[u * DLRU + tid] = ap; CH[u * DLRU + tid] = hh;
    }
    LAS bf16_t* PL = (LAS bf16_t*)F.lds;
    {
        const int p = tid & 127, tq = tid >> 7, c = 2 * p, g = c >> 6;
        const int tp0 = t0 + 16 * tq;
        float v0[31], v1[31], c0[31], c1[31];
#pragma unroll
        for (int i = 0; i < 31; ++i) {
            const unsigned a = zpool[i];
            v0[i] = bflo(a); v1[i] = bfhi(a);
            c0[i] = (i ? c0[i - 1] : 0.f) + v0[i]; c1[i] = (i ? c1[i - 1] : 0.f) + v1[i];
        }
        LAS bf16_t* dst = PL + (16 * tq) * PLP16 + c;
        if (g == 0) pool_rows<2>(c0, c1, v0, v1, tp0, dst); else if (g == 1) pool_rows<4>(c0, c1, v0, v1, tp0, dst); else if (g == 2) pool_rows<8>(c0, c1, v0, v1, tp0, dst); else pool_rows<16>(c0, c1, v0, v1, tp0, dst);
    }
    __syncthreads();
#pragma unroll
    for (int k = 0; k < 6; ++k) { const int idx = tid + NTHREADS * k;
        const u32x4 va = *(const LAS u32x4*)(LA + idx * 8), vu = *(const LAS u32x4*)(UU + idx * 8);
        *(u32x4*)(A16 + (size_t)row0 * DLRU + idx * 8) = va; *(u32x4*)(U16 + (size_t)row0 * DLRU + idx * 8) = vu; }
    {
        const int mt = wave & 3, gg = wave >> 2, fr = lane & 15, fq = lane >> 4;
        const bf16_t* Wp = (const bf16_t*)(ws + WS_SMALL + 393216) + (size_t)l * 4 * 4096; const float* psc = kin(15) + l * DPOOL;
        bf16_t* Y = (bf16_t*)(ws + WS_Y);
        const LAS bf16_t* prow = PL + (16 * mt + fr) * PLP16; const size_t row = (size_t)(row0 + 16 * mt + fr);
        u32x2 gcq[2][4]; f32x4 psq[2][4]; bf16x8 wpq[2][4][2];
#pragma unroll
        for (int q = 0; q < 2; ++q)
#pragma unroll
            for (int nt = 0; nt < 4; ++nt) { const int g = 2 * gg + q, c = 64 * g + 16 * nt + 4 * fq;
                gcq[q][nt] = *(const u32x2*)(Z + row * ZW + Z_GC + c); psq[q][nt] = *(const f32x4*)(psc + c);
                const bf16_t* wp_ = Wp + (size_t)g * 4096 + (16 * nt + fr) * 64 + 8 * fq; wpq[q][nt][0] = *(const bf16x8*)wp_; wpq[q][nt][1] = *(const bf16x8*)(wp_ + 32); }
#pragma unroll
        for (int q = 0; q < 2; ++q) {
            const int g = 2 * gg + q;
            const bf16x8 xb0 = *(const LAS bf16x8*)(prow + 64 * g + 8 * fq), xb1 = *(const LAS bf16x8*)(prow + 64 * g + 32 + 8 * fq);
#pragma unroll
            for (int nt = 0; nt < 4; ++nt) {
                const bf16x8 a0 = wpq[q][nt][0], a1 = wpq[q][nt][1];
                f32x4 acc = {0.f, 0.f, 0.f, 0.f};
                acc = __builtin_amdgcn_mfma_f32_16x16x32_bf16(a0, xb0, acc, 0, 0, 0); acc = __builtin_amdgcn_mfma_f32_16x16x32_bf16(a1, xb1, acc, 0, 0, 0);
                const int c = 64 * g + 16 * nt + 4 * fq;
                const f32x4 ps = psq[q][nt]; const u32x2 gw_ = gcq[q][nt];
                const float y0 = acc[0] * ps[0] * siluf_(bflo(gw_.x)), y1 = acc[1] * ps[1] * siluf_(bfhi(gw_.x)), y2 = acc[2] * ps[2] * siluf_(bflo(gw_.y)), y3 = acc[3] * ps[3] * siluf_(bfhi(gw_.y));
                *(u32x2*)(Y + row * DM + 768 + c) = (u32x2){pg8::cvt_pk_bf16(y0, y1), pg8::cvt_pk_bf16(y2, y3)};
            }
        }
    }
    __syncthreads();
}

__device__ __forceinline__ void lru_final_unit(Frame& F, int u) {
    const int tid = F.tid; unsigned char* ws = F.ws;
    LAS float* carry = (LAS float*)F.lds;
    if (tid < DLRU) {
        const float* CA = (const float*)(ws + WS_CHS); const float* CH = CA + 256 * DLRU;
        const int b0 = u & ~127;
        float hh = 0.f;
#pragma unroll 16
        for (int j = b0; j < u; ++j) hh = CA[j * DLRU + tid] * hh + CH[j * DLRU + tid];
        carry[tid] = hh;
    }
    __syncthreads();
    const bf16_t* PA = (const bf16_t*)(ws + WS_A32) + (size_t)u * 64 * DLRU; const bf16_t* HL = (const bf16_t*)(ws + WS_U32) + (size_t)u * 64 * DLRU;
    const bf16_t* zg = (const bf16_t*)(ws + WS_Z) + (size_t)u * 64 * ZW + Z_GA; bf16_t* Y = (bf16_t*)(ws + WS_Y) + (size_t)u * 64 * DM;
    {
        u32x4 pq[6], hq[6], gq[6];
#pragma unroll
        for (int k = 0; k < 6; ++k) { const int idx = tid + NTHREADS * k, row = idx / 48, c = 8 * (idx % 48);
            pq[k] = *(const u32x4*)(PA + (size_t)row * DLRU + c); hq[k] = *(const u32x4*)(HL + (size_t)row * DLRU + c); gq[k] = *(const u32x4*)(zg + (size_t)row * ZW + c); }
#pragma unroll
        for (int k = 0; k < 6; ++k) { const int idx = tid + NTHREADS * k, row = idx / 48, c = 8 * (idx % 48);
            const f32x4 cr0 = *(const LAS f32x4*)(carry + c), cr1 = *(const LAS f32x4*)(carry + c + 4);
            const f32x4 p0 = {bflo(pq[k].x), bfhi(pq[k].x), bflo(pq[k].y), bfhi(pq[k].y)}, p1 = {bflo(pq[k].z), bfhi(pq[k].z), bflo(pq[k].w), bfhi(pq[k].w)};
            const f32x4 h0 = (f32x4){bflo(hq[k].x), bfhi(hq[k].x), bflo(hq[k].y), bfhi(hq[k].y)} + p0 * cr0, h1 = (f32x4){bflo(hq[k].z), bfhi(hq[k].z), bflo(hq[k].w), bfhi(hq[k].w)} + p1 * cr1;
            const u32x4 g = gq[k];
            u32x4 w;
            w.x = pg8::cvt_pk_bf16(h0[0] * siluf_(bflo(g.x)), h0[1] * siluf_(bfhi(g.x))); w.y = pg8::cvt_pk_bf16(h0[2] * siluf_(bflo(g.y)), h0[3] * siluf_(bfhi(g.y)));
            w.z = pg8::cvt_pk_bf16(h1[0] * siluf_(bflo(g.z)), h1[1] * siluf_(bfhi(g.z))); w.w = pg8::cvt_pk_bf16(h1[2] * siluf_(bflo(g.w)), h1[3] * siluf_(bfhi(g.w)));
            *(u32x4*)(Y + (size_t)row * DM + c) = w; }
    }
    __syncthreads();
}

namespace att {
constexpr int KSLOT = 12288, VSLOT = 8192;
constexpr int L_K = 0, L_V = 3 * KSLOT, L_WS = L_V + 3 * VSLOT, L_OST = L_WS + NWAVES * 256, L_END = L_OST + NWAVES * 8192;
static_assert(L_END <= 131072, "attention LDS");
__device__ __forceinline__ int crow(int r, int hi) { return (r & 3) + 8 * (r >> 2) + 4 * hi; }
__device__ __forceinline__ void glds16(const void* gsrc, unsigned lds_dst) {
    unsigned keep;
    asm volatile("s_mov_b32 %0, m0\n\ts_mov_b32 m0, %2\n\ts_nop 0\n\tglobal_load_lds_dwordx4 %1, off\n\ts_mov_b32 m0, %0" : "=&s"(keep) : "v"(gsrc), "s"(lds_dst) : "memory");
}
__device__ __forceinline__ void glds16s(const void* sbase, unsigned voff, unsigned lds_dst) {
    unsigned keep;
    asm volatile("s_mov_b32 %0, m0\n\ts_mov_b32 m0, %3\n\ts_nop 0\n\tglobal_load_lds_dwordx4 %1, %2\n\ts_mov_b32 m0, %0" : "=&s"(keep) : "v"(voff), "s"(sbase), "s"(lds_dst) : "memory");
}
typedef short v4i16_t __attribute__((ext_vector_type(4)));
__device__ __forceinline__ s16x4 vtr(const LAS char* p) { return __builtin_bit_cast(s16x4, __builtin_amdgcn_ds_read_tr16_b64_v4i16((LAS v4i16_t*)p)); }
typedef float f32x2_t __attribute__((ext_vector_type(2))); typedef __bf16 bf16x2_t __attribute__((ext_vector_type(2)));
__device__ __forceinline__ unsigned cvtpk_s(float lo, float hi) { f32x2_t v = {lo, hi}; bf16x2_t b = __builtin_convertvector(v, bf16x2_t); return __builtin_bit_cast(unsigned, b); }
__device__ __forceinline__ float swapmax(float m) { auto rr = __builtin_amdgcn_permlane32_swap(__float_as_uint(m), __float_as_uint(m), false, false); return fmaxf(__uint_as_float(rr[0]), __uint_as_float(rr[1])); }
__device__ __forceinline__ float swapsum(float m) { auto rr = __builtin_amdgcn_permlane32_swap(__float_as_uint(m), __float_as_uint(m), false, false); return __uint_as_float(rr[0]) + __uint_as_float(rr[1]); }
#define ATT_WAIT_BAR() asm volatile("s_waitcnt vmcnt(0) lgkmcnt(0)\n\ts_barrier" ::: "memory")

__device__ __forceinline__ void attn_unit(Frame& F, int b, int h, int qb) {
    const int lane = F.lane, r32 = lane & 31, hi = lane >> 5, wid = F.wave;
    unsigned char* ws = F.ws;
    const bf16_t* Q = (const bf16_t*)((const unsigned char*)F.out + OUT_Q); const bf16_t* KV = (const bf16_t*)(ws + WS_KV); const bf16_t* KR = (const bf16_t*)((const unsigned char*)F.out + OUT_KR);
    const LAS char* shm = (const LAS char*)F.lds;
    const unsigned lds0 = (unsigned)(uintptr_t)F.lds;
    const long rowbase = (long)b * SEQ; const int q0 = qb * 256;
    const bf16_t* kbase = KV + rowbase * DKV + h * 128 + wid * 8;
    const bf16_t* krbase = KR + rowbase * 32 + (wid & 3) * 8;
    const bf16_t* vbase = KV + (rowbase + 16 * (wid & 3)) * DKV + h * 128 + 64 + (wid >> 2) * 32;
    const unsigned kroffv = (unsigned)lane * 64u, voffv = (unsigned)(lane >> 2) * (DKV * 2) + (unsigned)(lane & 3) * 16u;
    const unsigned kdst = (unsigned)__builtin_amdgcn_readfirstlane(lds0 + L_K + wid * 1024), krdst = kdst + 8 * 1024  , vdst = kdst + (L_V - L_K);
#define ATT_ISSUE_K(t, sl) do { unsigned ko_ = kroffv; asm volatile("" : "+v"(ko_));   glds16s(kbase + (long)(t) * 64 * DKV, ko_ * 24u, kdst + (sl) * KSLOT); if (wid < 4) glds16s(krbase + (long)(t) * 64 * 32, kroffv, krdst + (sl) * KSLOT); } while (0)
#define ATT_ISSUE_V(t, sl) do { glds16s(vbase + (long)(t) * 64 * DKV, voffv, vdst + (sl) * VSLOT); } while (0)
#define ATT_QK(P0, P1, sl) do { const LAS char* kb_ = kfb + (sl) * KSLOT; P0 = f32x16{}; P1 = f32x16{}; \
        _Pragma("unroll") for (int d0 = 0; d0 < 6; ++d0) { \
            const bf16x8 k0_ = *(const LAS bf16x8*)(kb_ + d0 * 2048), k1_ = *(const LAS bf16x8*)(kb_ + d0 * 2048 + 512); \
            P0 = __builtin_amdgcn_mfma_f32_32x32x16_bf16(k0_, qr[d0], P0, 0, 0, 0); \
            P1 = __builtin_amdgcn_mfma_f32_32x32x16_bf16(k1_, qr[d0], P1, 0, 0, 0); } } while (0)
#define MX3(a, b, c) __builtin_fmaxf(__builtin_fmaxf((a), (b)), (c))
#define ATT_THR 8.0f
#define ATT_QKN(P0, P1, sl) do { const LAS char* kb_ = kfb + (sl) * KSLOT; \
        _Pragma("unroll") for (int d0 = 0; d0 < 6; ++d0) { \
            const bf16x8 k0_ = *(const LAS bf16x8*)(kb_ + d0 * 2048), k1_ = *(const LAS bf16x8*)(kb_ + d0 * 2048 + 512); \
            if (d0 == 0) { P0 = __builtin_amdgcn_mfma_f32_32x32x16_bf16(k0_, qr[0], negm, 0, 0, 0); P1 = __builtin_amdgcn_mfma_f32_32x32x16_bf16(k1_, qr[0], negm, 0, 0, 0); } \
            else { P0 = __builtin_amdgcn_mfma_f32_32x32x16_bf16(k0_, qr[d0], P0, 0, 0, 0); P1 = __builtin_amdgcn_mfma_f32_32x32x16_bf16(k1_, qr[d0], P1, 0, 0, 0); } } } while (0)
#define ATT_VF(d0, ks) ({ const s16x4 lo_ = vtr(vb + (d0) * 4096 + (ks) * 1024), hi_ = vtr(vb + (d0) * 4096 + (ks) * 1024 + 512); (bf16x8){lo_[0], lo_[1], lo_[2], lo_[3], hi_[0], hi_[1], hi_[2], hi_[3]}; })
#define ATT_STEP(C0, C1, N0, N1, tt) do { \
        ATT_WAIT_BAR(); \
        const int sl = (tt) & 1; \
        if ((tt) + 2 < NT) ATT_ISSUE_K((tt) + 2, sl); \
        if ((tt) + 1 < NT) ATT_ISSUE_V((tt) + 1, sl ^ 1); \
        if ((tt) <= tmax) { \
            if ((tt) == tmax) { const int kbase = 64 * (tt); \
                _Pragma("unroll") for (int r = 0; r < 16; ++r) { const int kv = kbase + crow(r, hi); if (kv > qabs) C0[r] = -INFINITY; if (kv + 32 > qabs) C1[r] = -INFINITY; } } \
            float ra = MX3(C0[0], C0[1], C1[0]), rb = MX3(C0[2], C0[3], C1[1]); ra = MX3(ra, C1[2], C1[3]); \
            _Pragma("unroll") for (int r = 4; r < 16; r += 4) { ra = MX3(ra, C0[r], C0[r + 1]); rb = MX3(rb, C0[r + 2], C0[r + 3]); ra = MX3(ra, C1[r], C1[r + 1]); rb = MX3(rb, C1[r + 2], C1[r + 3]); } \
            const float rm = swapmax(fmaxf(ra, rb)); \
            if ((tt) == 0 || __any(rm > ATT_THR)) {                                     \
                const float dl = ((tt) == 0) ? rm : fmaxf(rm, 0.f); \
                mref += dl; \
                _Pragma("unroll") for (int r = 0; r < 16; ++r) { C0[r] -= dl; C1[r] -= dl; } \
                _Pragma("unroll") for (int r = 0; r < 16; ++r) negm[r] = -mref; \
                asm volatile("" : "+v"(negm)); \
                if ((tt) != 0) { const float f = __builtin_amdgcn_exp2f(-dl); lrun *= f; \
                    if (hi == 0) wsf[r32] = f; \
                    LDS_WAIT(); \
                    _Pragma("unroll") for (int g4 = 0; g4 < 4; ++g4) { const f32x4 fv = *(const LAS f32x4*)(wsf + 8 * g4 + 4 * hi); \
                        _Pragma("unroll") for (int j = 0; j < 4; ++j) { o0[4 * g4 + j] *= fv[j]; o1[4 * g4 + j] *= fv[j]; } } \
                    LDS_WAIT(); } \
            } \
            ATT_QKN(N0, N1, sl ^ 1);                                                    \
            _Pragma("unroll") for (int r = 0; r < 16; ++r) { C0[r] = __builtin_amdgcn_exp2f(C0[r]); C1[r] = __builtin_amdgcn_exp2f(C1[r]); } \
            float sa = C0[0];                                                           \
            _Pragma("unroll") for (int r = 1; r < 16; ++r) sa += C0[r]; \
            _Pragma("unroll") for (int r = 0; r < 16; ++r) sa += C1[r]; \
            lrun += sa; \
            const u32x4 pw0 = (u32x4){cvtpk_s(C0[0], C0[1]), cvtpk_s(C0[2], C0[3]), cvtpk_s(C0[4], C0[5]), cvtpk_s(C0[6], C0[7])}; \
            const u32x4 pw1 = (u32x4){cvtpk_s(C0[8], C0[9]), cvtpk_s(C0[10], C0[11]), cvtpk_s(C0[12], C0[13]), cvtpk_s(C0[14], C0[15])}; \
            const u32x4 pw2 = (u32x4){cvtpk_s(C1[0], C1[1]), cvtpk_s(C1[2], C1[3]), cvtpk_s(C1[4], C1[5]), cvtpk_s(C1[6], C1[7])}; \
            const u32x4 pw3 = (u32x4){cvtpk_s(C1[8], C1[9]), cvtpk_s(C1[10], C1[11]), cvtpk_s(C1[12], C1[13]), cvtpk_s(C1[14], C1[15])}; \
            const LAS char* vb = vfb + sl * VSLOT; \
            o0 = __builtin_amdgcn_mfma_f32_32x32x16_bf16(__builtin_bit_cast(bf16x8, pw0), ATT_VF(0, 0), o0, 0, 0, 0); \
            o1 = __builtin_amdgcn_mfma_f32_32x32x16_bf16(__builtin_bit_cast(bf16x8, pw0), ATT_VF(1, 0), o1, 0, 0, 0); \
            o0 = __builtin_amdgcn_mfma_f32_32x32x16_bf16(__builtin_bit_cast(bf16x8, pw1), ATT_VF(0, 1), o0, 0, 0, 0); \
            o1 = __builtin_amdgcn_mfma_f32_32x32x16_bf16(__builtin_bit_cast(bf16x8, pw1), ATT_VF(1, 1), o1, 0, 0, 0); \
            o0 = __builtin_amdgcn_mfma_f32_32x32x16_bf16(__builtin_bit_cast(bf16x8, pw2), ATT_VF(0, 2), o0, 0, 0, 0); \
            o1 = __builtin_amdgcn_mfma_f32_32x32x16_bf16(__builtin_bit_cast(bf16x8, pw2), ATT_VF(1, 2), o1, 0, 0, 0); \
            o0 = __builtin_amdgcn_mfma_f32_32x32x16_bf16(__builtin_bit_cast(bf16x8, pw3), ATT_VF(0, 3), o0, 0, 0, 0); \
            o1 = __builtin_amdgcn_mfma_f32_32x32x16_bf16(__builtin_bit_cast(bf16x8, pw3), ATT_VF(1, 3), o1, 0, 0, 0); \
        } } while (0)
    const int NT = 4 * qb + 4, tmax = 4 * qb + (wid >> 1);
    ATT_ISSUE_K(0, 0); ATT_ISSUE_V(0, 0); ATT_ISSUE_K(1, 1);
    bf16x8 qr[6];
    { const bf16_t* qp = Q + (rowbase + q0 + wid * 32 + r32) * DQ + h * 96 + hi * 8;
#pragma unroll
      for (int d0 = 0; d0 < 6; ++d0) qr[d0] = *(const bf16x8*)(qp + d0 * 16); }
    float mref = 0.f, lrun = 0.f;
    f32x16 o0 = {}, o1 = {};
    f32x16 negm = {}; asm volatile("" : "+v"(negm));
    LAS float* wsf = (LAS float*)(F.lds + L_WS) + wid * 64;
    const int qabs = q0 + wid * 32 + r32;
    const LAS char* kfb = shm + L_K + hi * 1024 + r32 * 16;
    const LAS char* vfb = shm + L_V + ((lane >> 4) & 1) * 32 + (lane & 3) * 8 + (4 * hi + ((lane & 15) >> 2)) * 64;
    f32x16 pa0, pa1, pb0, pb1;
    if (wid >= 4) __builtin_amdgcn_s_setprio(1);
    ATT_WAIT_BAR();
    ATT_QKN(pa0, pa1, 0);
#pragma unroll 1
    for (int t = 0; t < NT; t += 2) {
        ATT_STEP(pa0, pa1, pb0, pb1, t);
        ATT_STEP(pb0, pb1, pa0, pa1, t + 1);
    }
    __builtin_amdgcn_s_setprio(0);
#undef ATT_STEP
#undef ATT_VF
#undef ATT_QKN
#undef ATT_THR
#undef MX3
    {
        const bf16_t* Z = (const bf16_t*)((const unsigned char*)kin(19) + WS_Z); bf16_t* Y = (bf16_t*)((unsigned char*)kin(19) + WS_Y);
        int lane_e = lane; asm volatile("" : "+v"(lane_e));
        const float lt = swapsum(lrun);
        if (hi == 0) wsf[r32] = 1.0f / lt;
        LDS_WAIT();
        LAS float* stg = (LAS float*)(F.lds + L_OST) + wid * 2048;
#pragma unroll
        for (int g4 = 0; g4 < 4; ++g4) { const f32x4 f = *(const LAS f32x4*)(wsf + 8 * g4 + 4 * hi);
#pragma unroll
            for (int j = 0; j < 4; ++j) { const int r = 4 * g4 + j, orow = crow(r, hi); stg[orow * 64 + r32] = o0[r] * f[j]; stg[orow * 64 + 32 + r32] = o1[r] * f[j]; } }
        LDS_WAIT();
        const size_t grow0 = (size_t)(rowbase + q0 + wid * 32);
        u32x4 gbq[4];
#pragma unroll
        for (int i = 0; i < 4; ++i) { const int row = i * 8 + (lane_e >> 3), ch = lane_e & 7; gbq[i] = *(const u32x4*)(Z + (grow0 + row) * ZW + Z_GB + 64 * h + 8 * ch); }
#pragma unroll
        for (int i = 0; i < 4; ++i) {
            const int row = i * 8 + (lane_e >> 3), ch = lane_e & 7;
            const f32x4 ov0 = *(const LAS f32x4*)(stg + row * 64 + ch * 8), ov1 = *(const LAS f32x4*)(stg + row * 64 + ch * 8 + 4);
            const u32x4 g = gbq[i];
            u32x4 w;
            w.x = pg8::cvt_pk_bf16(ov0[0] * siluf_(bflo(g.x)), ov0[1] * siluf_(bfhi(g.x))); w.y = pg8::cvt_pk_bf16(ov0[2] * siluf_(bflo(g.y)), ov0[3] * siluf_(bfhi(g.y)));
            w.z = pg8::cvt_pk_bf16(ov1[0] * siluf_(bflo(g.z)), ov1[1] * siluf_(bfhi(g.z))); w.w = pg8::cvt_pk_bf16(ov1[2] * siluf_(bflo(g.w)), ov1[3] * siluf_(bfhi(g.w)));
            *(u32x4*)(Y + (grow0 + row) * DM + 384 + 64 * h + 8 * ch) = w;
        }
        LDS_WAIT();
    }
#undef ATT_ISSUE_K
#undef ATT_ISSUE_V
}
}

__device__ __forceinline__ void phase_final(Frame& F) {
    const int gw = F.bid * NWAVES + F.wave, NGW = F.G * NWAVES, lane = F.lane;
    const ssum_t* ssx = (const ssum_t*)(F.ws + WS_ACC + OFF_SSX) + 4 * M; const float* g = kin(17);
    const bf16_t* XB = (const bf16_t*)(F.ws + WS_XB);
#pragma unroll 4
    for (int m = gw; m < M; m += NGW) {
        const u32x2* xr = (const u32x2*)(XB + (size_t)m * DM) + lane; f32x4* orow = (f32x4*)(F.out + (size_t)m * DM) + lane; const f32x4* gr = (const f32x4*)g + lane;
        const float rs = rsqrtf(ldfx(ssx + m) * (1.0f / 1024.0f) + EPS);
#pragma unroll
        for (int j = 0; j < 4; ++j) { const u32x2 w = xr[64 * j]; const f32x4 v = {bflo(w.x), bfhi(w.x), bflo(w.y), bfhi(w.y)}; orow[64 * j] = v * rs * gr[64 * j]; }
    }
}

#define XB_TMO      128
#define XB_XCNT(j)  (256  + 64 * (j))
#define XB_XSUB(j)  (1280 + 64 * (j))
#define XB_XGEN(j)  (2304 + 64 * (j))
#define XB_TOP      3328
#define XB_TOPGEN   3392
#define XCD_BAR_WORDS 3456
#define XB_SPIN_CAP (1u << 18)

__device__ __forceinline__ unsigned xb_ld(unsigned* p)              { return __hip_atomic_load(p, __ATOMIC_RELAXED, __HIP_MEMORY_SCOPE_AGENT); }
__device__ __forceinline__ unsigned xb_add(unsigned* p, unsigned v) { return __hip_atomic_fetch_add(p, v, __ATOMIC_RELAXED, __HIP_MEMORY_SCOPE_AGENT); }
__device__ __forceinline__ unsigned xb_xcc_id() { return (unsigned)__builtin_amdgcn_s_getreg((3 << 11) | 20) & 0xFu; }
#define XB_SPIN(cond, bar) do { unsigned _sp = 0; while (cond) { __builtin_amdgcn_s_sleep(1); \
    if ((++_sp & 255u) == 0u) { if (xb_ld(&(bar)[XB_TMO])) break; if (_sp > XB_SPIN_CAP) { atomicAdd(&(bar)[XB_TMO], 1u); break; } } } } while (0)

struct XcdBarrier {
    unsigned* bar; unsigned x;
    volatile LAS unsigned* st;
};

__device__ __forceinline__ XcdBarrier xcd_barrier_post(unsigned* bar, volatile LAS unsigned* st) {
    XcdBarrier b; b.bar = bar; b.x = xb_xcc_id(); b.st = st;
    if (threadIdx.x == 0) (void)xb_add(&bar[XB_XCNT(b.x)], 1u);
    return b;
}
__device__ __forceinline__ void xcd_barrier_complete(unsigned* bar, unsigned x, unsigned& nloc, unsigned& nx) {
    const unsigned G = gridDim.x * gridDim.y * gridDim.z;
    unsigned sum, cnt, mine, sp = 0u;
    for (;;) {
        sum = 0u; cnt = 0u; mine = 0u;
#pragma unroll
        for (unsigned j = 0; j < 16; ++j) { const unsigned c = xb_ld(&bar[XB_XCNT(j)]); sum += c; cnt += (c > 0u) ? 1u : 0u; mine = (j == x) ? c : mine; }
        if (sum == G) break;
        __builtin_amdgcn_s_sleep(1);
        if ((++sp & 255u) == 0u) { if (xb_ld(&bar[XB_TMO])) break; if (sp > XB_SPIN_CAP) { atomicAdd(&bar[XB_TMO], 1u); break; } }
    }
    nloc = mine > 0u ? mine : 1u; nx = cnt > 0u ? cnt : 1u;
}

__device__ __forceinline__ void xcd_barrier(const XcdBarrier& b) {
    asm volatile("s_waitcnt vmcnt(0)" ::: "memory");
    __syncthreads();
    if (threadIdx.x == 0) {
        unsigned* bar = b.bar;
        __builtin_amdgcn_s_waitcnt(0);
        unsigned nloc = b.st[0], nx = b.st[1];
        if (nloc == 0u) { xcd_barrier_complete(bar, b.x, nloc, nx); b.st[0] = nloc; b.st[1] = nx; }
        const unsigned old = xb_add(&bar[XB_XSUB(b.x)], 1u);
        const unsigned gen = old / nloc;
        if (old + 1u == (gen + 1u) * nloc) {
            __builtin_amdgcn_fence(__ATOMIC_RELEASE, "agent");
            asm volatile("s_waitcnt vmcnt(0)" ::: "memory");
            const unsigned og = xb_add(&bar[XB_TOP], 1u);
            const unsigned tg = og / nx;
            if (og + 1u == (tg + 1u) * nx) xb_add(&bar[XB_TOPGEN], 1u);
            else XB_SPIN(xb_ld(&bar[XB_TOPGEN]) == tg, bar);
            __builtin_amdgcn_fence(__ATOMIC_ACQUIRE, "agent");
            xb_add(&bar[XB_XGEN(b.x)], 1u);
            asm volatile("s_waitcnt vmcnt(0)" ::: "memory");
        } else {
            XB_SPIN(xb_ld(&bar[XB_XGEN(b.x)]) == gen, bar);
            __builtin_amdgcn_fence(__ATOMIC_ACQUIRE, "agent");
            asm volatile("s_waitcnt vmcnt(0)" ::: "memory");
        }
    }
    __syncthreads();
}

constexpr size_t OFF_BAR = 900 * 1024;
constexpr int LDS_BARST = 150016;
#define MK_FRAME() \
    Frame F; F.lds = (LAS unsigned char*)lds; \
    { int t_ = threadIdx.x; asm volatile("" : "+v"(t_)); F.tid = t_; } \
    F.lane = F.tid & 63; F.wave = __builtin_amdgcn_readfirstlane(F.tid >> 6); \
    F.bid = blockIdx.x; F.G = gridDim.x; F.out = (float*)kin(18); F.ws = (unsigned char*)kin(19); \
    unsigned char* ws = F.ws; (void)ws; \
    ssum_t* ssx = (ssum_t*)(ws + WS_ACC + OFF_SSX); ssum_t* ssq = (ssum_t*)(ws + WS_ACC + OFF_SSQ); ssum_t* sskv = (ssum_t*)(ws + WS_ACC + OFF_SSKV); (void)ssx; (void)ssq; (void)sskv; \
    const float* cosT = (const float*)(ws + WS_ROPE); const float* sinT = cosT + SEQ * 16; (void)cosT; (void)sinT;
#define MK_IN(k) (ph_lo <= (k) && (k) < ph_hi)
#define MK_SEAM(k) do { if ((k) + 1 < ph_hi) { if ((k) == 0 && ph_hi > 18) cg::this_grid().sync();   else { XcdBarrier xb_; xb_.bar = (unsigned*)(kin(19)) + OFF_BAR / 4; xb_.x = xb_xcc_id(); xb_.st = (volatile LAS unsigned*)((LAS unsigned char*)lds + LDS_BARST); xcd_barrier(xb_); } } } while (0)

template <int l> __device__ __forceinline__ void layer_phases(unsigned char* lds, int ph_lo, int ph_hi) {
    if (MK_IN(1 + 4 * l)) {
        MK_FRAME();
#if !defined(NO_GEMM) && !defined(NO_G1)
        pg8::Gemm g{(const pg8::bf16_t*)(ws + WS_XB), (const pg8::bf16_t*)(ws + WS_WIN) + (size_t)l * ZW * 1024, M, ZW, 1024, 1024, 1024};
        pg8::StaticOrder S; S.init(M, ZW, F.G, F.bid);
        EpiZ E{(bf16_t*)(ws + WS_Z), ssx + l * M, ssq + l * M, sskv + l * M};
        pg8::gemm_phase<EpiZ, pg8::StaticOrder, PG8_ALIGN, PG8_SP2>(F.lds, g, S, E);
#endif
        if (F.G == 256 && l + 1 < NL && F.bid >= 128) convert_layer_weights(F, l + 1, (F.bid - 128) * NWAVES + F.wave, 128 * NWAVES);
        MK_SEAM(1 + 4 * l);
    }
    if (MK_IN(2 + 4 * l)) for (int rep2_ = 0; rep2_ < P2_REPEAT; ++rep2_) {
        {
            MK_FRAME();
#if !defined(NO_GEMM) && !defined(NO_G2)
            pg8::Gemm g{(const pg8::bf16_t*)(ws + WS_Z) + Z_CQ, (const pg8::bf16_t*)(ws + WS_WUQ) + (size_t)l * 768 * 384, M, 768, 384, ZW, 384};
            pg8::StaticOrder S; S.init(M, 768, F.G, F.bid);
            EpiQ E{(bf16_t*)((unsigned char*)F.out + OUT_Q), ssq + l * M, cosT, sinT};
            pg8::gemm_phase<EpiQ, pg8::StaticOrder, PG8_ALIGN, PG8_SP2>(F.lds, g, S, E);
#endif
        }
        {
            MK_FRAME();
#if !defined(NO_GEMM) && !defined(NO_G3)
            pg8::Gemm g{(const pg8::bf16_t*)(ws + WS_Z) + Z_CKV, (const pg8::bf16_t*)(ws + WS_WUKV) + (size_t)l * 768 * 256, M, 768, 256, ZW, 256};
            pg8::StaticOrder S; S.init(M, 768, F.G, (F.bid + F.G / 2) % F.G);
            EpiKV E{(bf16_t*)(ws + WS_KV), sskv + l * M};
            pg8::gemm_phase<EpiKV, pg8::StaticOrder, PG8_ALIGN, PG8_SP2>(F.lds, g, S, E);
#endif
        }
        __syncthreads();
        {
            MK_FRAME();
#if !defined(NO_P2)
            for (int u = F.bid; u < 256; u += F.G) phase2_tile(F, l, u);
#endif
        }
        MK_SEAM(2 + 4 * l);
    }
    if (MK_IN(3 + 4 * l)) {
        MK_FRAME();
#ifndef ATT_REPEAT
#define ATT_REPEAT 1
#endif
        int i1 = F.bid;
        if (F.G == 256) { const int v = (F.bid & 7) * 32 + (F.bid >> 3); i1 = (v < 252) ? (v % 21) * 12 + v / 21 : v; }
        for (int rep = 0; rep < ATT_REPEAT; ++rep)
        for (int r = 0;; ++r) {
            int i;
            if (F.G == 256) { if (r >= 2 || (r == 1 && i1 < 128)) break; i = r ? 511 - i1 : i1; }
            else { if (r * F.G >= 384) break; i = (r & 1) ? r * F.G + (F.G - 1 - F.bid) : r * F.G + F.bid; }
#if !defined(NO_ATT)
            if (i < 384) att::attn_unit(F, (i % 12) / 6, (i % 12) % 6, 31 - i / 12);
#endif
        }
        __syncthreads();
        { const int hg = F.G / 2;
          if (i1 >= F.G - hg) for (int u = F.G - 1 - i1; u < 256; u += hg) lru_final_unit(F, u); }
        MK_SEAM(3 + 4 * l);
    }
    if (MK_IN(4 + 4 * l)) {
        MK_FRAME();
#if !defined(NO_GEMM) && !defined(NO_G4)
        pg8::Gemm g{(const pg8::bf16_t*)(ws + WS_Y), (const pg8::bf16_t*)(ws + WS_WOUT) + (size_t)l * 1024 * 1024, M, 1024, 1024, 1024, 1024};
        pg8::StaticOrder S; S.init(M, 1024, F.G, F.bid);
        EpiOut E{(bf16_t*)(ws + WS_XB), ssx + (l + 1) * M};
        pg8::gemm_phase<EpiOut, pg8::StaticOrder, PG8_ALIGN, PG8_SP2>(F.lds, g, S, E);
#endif
        MK_SEAM(4 + 4 * l);
    }
}

__global__ void __launch_bounds__(NTHREADS, 2) mk_fwd(Args args) {
    extern __shared__ __attribute__((aligned(16))) unsigned char lds[];
    const int ph_lo = *(__attribute__((address_space(4))) const int*)((__attribute__((address_space(4))) const char*)__builtin_amdgcn_kernarg_segment_ptr() + 160);
    const int ph_hi = *(__attribute__((address_space(4))) const int*)((__attribute__((address_space(4))) const char*)__builtin_amdgcn_kernarg_segment_ptr() + 164);
    if (threadIdx.x < 2) ((LAS unsigned*)((LAS unsigned char*)lds + LDS_BARST))[threadIdx.x] = 0u;
    __syncthreads();
    (void)xcd_barrier_post((unsigned*)(kin(19)) + OFF_BAR / 4, (volatile LAS unsigned*)((LAS unsigned char*)lds + LDS_BARST));
    if (MK_IN(0)) {
        MK_FRAME();
#if !defined(NO_PRO)
        phase_prologue(F);
#endif
        MK_SEAM(0);
    }
    layer_phases<0>(lds, ph_lo, ph_hi);
    layer_phases<1>(lds, ph_lo, ph_hi);
    layer_phases<2>(lds, ph_lo, ph_hi);
    layer_phases<3>(lds, ph_lo, ph_hi);
    if (MK_IN(17)) {
        MK_FRAME();
        phase_final(F);
    }
}

extern "C" void kernel_launch(void* const* d_in, const int* in_sizes, int n_in, void* d_out, int out_size, void* d_ws, size_t ws_size, hipStream_t stream) {
    static int grid = 0;
    if (grid == 0) {
        if (n_in != 18 || in_sizes[0] != M * DM || out_size != M * DM || ws_size < WS_END) { fprintf(stderr, "kernel_launch: unexpected shapes (n_in %d, in0 %d, out %d, ws %zu)\n", n_in, n_in > 0 ? in_sizes[0] : -1, out_size, ws_size); grid = -1; return; }
        int dev = 0, cus = 0, per_cu = 0;
        hipGetDevice(&dev); hipDeviceGetAttribute(&cus, hipDeviceAttributeMultiprocessorCount, dev);
        if (hipFuncSetAttribute((const void*)mk_fwd, hipFuncAttributeMaxDynamicSharedMemorySize, LDS_BYTES) != hipSuccess) { fprintf(stderr, "kernel_launch: hipFuncSetAttribute failed\n"); grid = -1; return; }
        if (hipOccupancyMaxActiveBlocksPerMultiprocessor(&per_cu, (const void*)mk_fwd, NTHREADS, LDS_BYTES) != hipSuccess || per_cu < 1) { fprintf(stderr, "kernel_launch: occupancy query says %d\n", per_cu); per_cu = 1; }
        (void)hipGetLastError();
        grid = cus;
        if (grid > 256) grid = 256;
    }
    if (grid < 0) return;
    hipMemsetAsync((char*)d_ws + WS_CTL, 0, CTL_ZERO_BYTES, stream);
    hipMemsetAsync((char*)d_ws + WS_ACC, 0, ACC_BYTES, stream);
    Args a{};
    for (int i = 0; i < 18; ++i) a.in[i] = (const float*)d_in[i];
    a.out = (float*)d_out; a.ws = (unsigned char*)d_ws;
#if MK_ONE_LAUNCH
    a.ph_lo = 0; a.ph_hi = 18;
    void* kargs[] = {&a};
    hipError_t e = hipLaunchCooperativeKernel((const void*)mk_fwd, dim3(grid), dim3(NTHREADS), kargs, LDS_BYTES, stream);
    if (e != hipSuccess) fprintf(stderr, "cooperative launch failed: %s (grid %d)\n", hipGetErrorString(e), grid);
#else
    for (int ph = 0; ph < 18; ++ph) {
        a.ph_lo = ph; a.ph_hi = ph + 1;
        hipLaunchKernelGGL(mk_fwd, dim3(grid), dim3(NTHREADS), LDS_BYTES, stream, a);
    }
#endif
}
```

```cpp
#include <hip/hip_runtime.h>
#include <hip/hip_cooperative_groups.h>
#include <cstdio>
#include <cstdint>
#include <cmath>
namespace cg = cooperative_groups;
namespace pg8 {
#define PG8_LAS __attribute__((address_space(3)))
typedef unsigned short bf16_t;
typedef short bf16x8 __attribute__((ext_vector_type(8)));
typedef float f32x4 __attribute__((ext_vector_type(4)));
typedef unsigned u32x4 __attribute__((ext_vector_type(4)));
constexpr int BM = 256, BK = 64, HALF = 128, HTB = HALF * BK * 2  , STAGE_BYTES = 8 * HTB, NXCD = 8, WGM = 8;

__host__ __device__ __forceinline__ int lds_byte(int r, int c) { const int st = (r >> 4) * 2 + (c >> 5), rr = r & 15, cc = c & 31, ob = rr * 64 + cc * 2; return st * 1024 + (ob ^ (((ob >> 9) & 1) << 5)); }
__host__ __device__ __forceinline__ void stage_rc(int b, int& R, int& C) { const int st = b / 1024, sb = b % 1024, swz = sb ^ (((sb >> 9) & 1) << 5); R = (st >> 1) * 16 + swz / 64; C = (st & 1) * 32 + (swz % 64) / 2; }
__host__ __device__ __forceinline__ int perm32(int rho) { const int n = rho >> 4, i = rho & 15; return 8 * (i >> 2) + 4 * n + (i & 3); }

struct Unit { int pm, pn; };
struct Gemm { const bf16_t* A; const bf16_t* Bt; int M, N, K, lda, ldb; };

struct StaticOrder {
    int nM, nN, nwg, G, c;
    __host__ __device__ void init(int M, int N, int G_, int c_) { nM = M / BM; nN = N / BM; nwg = nM * nN; G = G_; c = c_; }
    __host__ __device__ bool next(int i, Unit& u) const {
        const long L = (long)i * G + c; if (L >= nwg) return false;
        int wgid = (int)L; { const int q = nwg / NXCD, r = nwg % NXCD, xcd = wgid % NXCD, off = wgid / NXCD; wgid = (xcd < r ? xcd * (q + 1) : r * (q + 1) + (xcd - r) * q) + off; }
        const int nig = WGM * nN, gid = wgid / nig, fm = gid * WGM, gsz = (nM - fm) < WGM ? (nM - fm) : WGM;
        u.pm = fm + ((wgid % nig) % gsz); u.pn = (wgid % nig) / gsz; return true;
    }
    __device__ __forceinline__ void a_ready(const Unit&) const {}
    __device__ __forceinline__ void done(const Unit&) const {}
};

__device__ __forceinline__ unsigned cvt_pk_bf16(float lo, float hi) { unsigned r; asm volatile("v_cvt_pk_bf16_f32 %0, %1, %2" : "=v"(r) : "v"(lo), "v"(hi)); return r; }
typedef float f32x2 __attribute__((ext_vector_type(2)));
template <class Epi, class Sched, bool ALIGN_EPI, bool SP2>
__device__ __forceinline__ void gemm_phase(PG8_LAS unsigned char* lds, const Gemm g, const Sched& S, const Epi& E) {
    int tid_ = threadIdx.x; asm volatile("" : "+v"(tid_));
    const int tid = tid_, wid = __builtin_amdgcn_readfirstlane(tid >> 6), lane = tid & 63, wr = wid >> 2, wc = wid & 3, fr = lane & 15, fq = lane >> 4;
    const int K = g.K; int nt = K / BK; asm volatile("" : "+s"(nt));
    unsigned voffA[2], voffB[2];
#pragma unroll
    for (int i = 0; i < 2; ++i) { int R, C; stage_rc(tid * 16 + i * 8192, R, C); const int Rb = Epi::PERM ? ((R & ~31) + perm32(R & 31)) : R;
        voffA[i] = (unsigned)(R * g.lda + C) * 2u; voffB[i] = (unsigned)(Rb * g.ldb + C) * 2u; }
    const size_t kstep = (size_t)(BK * 2);
    const size_t hstepA = (size_t)HALF * g.lda * 2, hstepB = (size_t)HALF * g.ldb * 2;
    const size_t tstepA = 2 * hstepA, tstepB = 2 * hstepB;
    const unsigned ldsw = (unsigned)wid * 1024u;
    const int aoff = lds_byte(wr * 64 + fr, fq * 8), boff = lds_byte(wc * 32 + fr, fq * 8);
#define PG8_SA(b, h) (((b) * 2 + (h)) * HTB)
#define PG8_SB(b, h) ((4 + (b) * 2 + (h)) * HTB)
#define PG8_STAGE(bufoff, gbase, voff) do { _Pragma("unroll") for (int _i = 0; _i < 2; ++_i) \
        __builtin_amdgcn_global_load_lds((const unsigned*)((const char*)(gbase) + (voff)[_i]), (PG8_LAS unsigned*)(lds + (bufoff) + ldsw + _i * 8192), 16, 0, 0); } while (0)
#define PG8_LDA(dst, b, h) do { _Pragma("unroll") for (int m = 0; m < 4; ++m) _Pragma("unroll") for (int k = 0; k < 2; ++k) dst[m][k] = *(const PG8_LAS bf16x8*)(lds + PG8_SA(b, h) + aoff + m * 2048 + k * 1024); } while (0)
#define PG8_LDB(dst, b, h) do { _Pragma("unroll") for (int n = 0; n < 2; ++n) _Pragma("unroll") for (int k = 0; k < 2; ++k) dst[n][k] = *(const PG8_LAS bf16x8*)(lds + PG8_SB(b, h) + boff + n * 2048 + k * 1024); } while (0)
#define PG8_MMA(ai, bj, At, Bt) do { __builtin_amdgcn_s_setprio(1); _Pragma("unroll") for (int m = 0; m < 4; ++m) _Pragma("unroll") for (int n = 0; n < 2; ++n) _Pragma("unroll") for (int k = 0; k < 2; ++k) \
        acc[ai][bj][m][n] = __builtin_amdgcn_mfma_f32_16x16x32_bf16(Bt[n][k], At[m][k], acc[ai][bj][m][n], 0, 0, 0); __builtin_amdgcn_s_setprio(0); } while (0)
#define PG8_WAIT_V(n) asm volatile("s_waitcnt vmcnt(" #n ")" ::: "memory")
#define PG8_WAIT_L(n) asm volatile("s_waitcnt lgkmcnt(" #n ")" ::: "memory")
#define PG8_BAR __builtin_amdgcn_s_barrier()
#define PG8_SCHED __builtin_amdgcn_sched_barrier(0)
    Unit cur, nxt; int ui = 0;
    if (!S.next(0, cur)) return;
    f32x4 acc[2][2][4][2];
#pragma unroll
    for (int a = 0; a < 2; ++a)
#pragma unroll
        for (int b = 0; b < 2; ++b)
#pragma unroll
            for (int m = 0; m < 4; ++m)
#pragma unroll
                for (int n = 0; n < 2; ++n) acc[a][b][m][n] = (f32x4){0.f, 0.f, 0.f, 0.f};
    bf16x8 At[4][2], B0[2][2], B1[2][2];
    const char* cA = (const char*)g.A + (size_t)cur.pm * tstepA; const char* cB = (const char*)g.Bt + (size_t)cur.pn * tstepB;
    S.a_ready(cur);
    if constexpr (SP2) {
        PG8_STAGE(PG8_SB(0, 0), cB, voffB); PG8_STAGE(PG8_SB(0, 1), cB + hstepB, voffB); PG8_STAGE(PG8_SA(0, 0), cA, voffA); PG8_STAGE(PG8_SA(0, 1), cA + hstepA, voffA);
        if (wr == 1) PG8_BAR;
        PG8_WAIT_V(2); PG8_BAR;
        PG8_STAGE(PG8_SB(1, 0), cB + kstep, voffB); PG8_STAGE(PG8_SA(1, 0), cA + kstep, voffA); PG8_STAGE(PG8_SB(1, 1), cB + hstepB + kstep, voffB);
        PG8_WAIT_V(6); PG8_BAR;
    } else {
        PG8_STAGE(PG8_SB(0, 0), cB, voffB); PG8_STAGE(PG8_SA(0, 0), cA, voffA); PG8_STAGE(PG8_SB(0, 1), cB + hstepB, voffB); PG8_STAGE(PG8_SA(0, 1), cA + hstepA, voffA);
        if (wr == 1) PG8_BAR;
        PG8_WAIT_V(4); PG8_BAR;
        PG8_STAGE(PG8_SB(1, 0), cB + kstep, voffB); PG8_STAGE(PG8_SA(1, 0), cA + kstep, voffA); PG8_STAGE(PG8_SB(1, 1), cB + hstepB + kstep, voffB);
        PG8_WAIT_V(6); PG8_BAR;
    }
    for (;;) {
        const bool has_next = S.next(ui + 1, nxt);
        const char* nA = has_next ? (const char*)g.A + (size_t)nxt.pm * tstepA : cA; const char* nB = has_next ? (const char*)g.Bt + (size_t)nxt.pn * tstepB : cB;
        for (int t = 0; t < nt; t += 2) {
            const bool last = (t == nt - 2);
            const char* a1 = cA + (size_t)(t + 1) * kstep;
            const char* a2 = last ? nA : cA + (size_t)(t + 2) * kstep; const char* b2 = last ? nB : cB + (size_t)(t + 2) * kstep;
            const char* a3 = a2 + kstep; const char* b3 = b2 + kstep;
            if (last && has_next) S.a_ready(nxt);
            if constexpr (SP2) {
            PG8_LDB(B0, 0, 0); PG8_LDB(B1, 0, 1); PG8_SCHED; PG8_LDA(At, 0, 0); PG8_STAGE(PG8_SA(1, 1), a1 + hstepA, voffA);
            PG8_WAIT_V(8); PG8_WAIT_L(0); PG8_BAR; PG8_MMA(0, 0, At, B0); PG8_MMA(0, 1, At, B1); PG8_BAR; PG8_SCHED;
            PG8_LDA(At, 0, 1); PG8_STAGE(PG8_SB(0, 0), b2, voffB); PG8_STAGE(PG8_SB(0, 1), b2 + hstepB, voffB); PG8_STAGE(PG8_SA(0, 0), a2, voffA);
            PG8_WAIT_V(8); PG8_WAIT_L(0); PG8_BAR; PG8_MMA(1, 0, At, B0); PG8_MMA(1, 1, At, B1); PG8_BAR; PG8_SCHED;
            PG8_LDB(B0, 1, 0); PG8_LDB(B1, 1, 1); PG8_SCHED; PG8_LDA(At, 1, 0); PG8_STAGE(PG8_SA(0, 1), a2 + hstepA, voffA);
            PG8_WAIT_V(8); PG8_WAIT_L(0); PG8_BAR; PG8_MMA(0, 0, At, B0); PG8_MMA(0, 1, At, B1); PG8_BAR; PG8_SCHED;
            PG8_LDA(At, 1, 1); PG8_STAGE(PG8_SB(1, 0), b3, voffB); PG8_STAGE(PG8_SB(1, 1), b3 + hstepB, voffB); PG8_STAGE(PG8_SA(1, 0), a3, voffA);
            PG8_WAIT_V(8); PG8_WAIT_L(0); PG8_BAR; PG8_MMA(1, 0, At, B0); PG8_MMA(1, 1, At, B1); PG8_BAR; PG8_SCHED;
            } else {
            PG8_LDB(B0, 0, 0); PG8_SCHED; PG8_LDA(At, 0, 0); PG8_STAGE(PG8_SA(1, 1), a1 + hstepA, voffA);
            PG8_WAIT_L(8); PG8_BAR; PG8_WAIT_L(0); PG8_MMA(0, 0, At, B0); PG8_BAR; PG8_SCHED;
            PG8_LDB(B1, 0, 1); PG8_STAGE(PG8_SB(0, 0), b2, voffB);
            PG8_BAR; PG8_WAIT_L(0); PG8_MMA(0, 1, At, B1); PG8_BAR;
            PG8_LDA(At, 0, 1); PG8_STAGE(PG8_SA(0, 0), a2, voffA);
            PG8_BAR; PG8_WAIT_L(0); PG8_MMA(1, 0, At, B0); PG8_BAR; PG8_SCHED;
            PG8_STAGE(PG8_SB(0, 1), b2 + hstepB, voffB);
            PG8_WAIT_V(6); PG8_BAR; PG8_MMA(1, 1, At, B1); PG8_BAR;
            PG8_LDB(B0, 1, 0); PG8_SCHED; PG8_LDA(At, 1, 0); PG8_STAGE(PG8_SA(0, 1), a2 + hstepA, voffA);
            PG8_WAIT_L(8); PG8_BAR; PG8_WAIT_L(0); PG8_MMA(0, 0, At, B0); PG8_BAR; PG8_SCHED;
            PG8_LDB(B1, 1, 1); PG8_STAGE(PG8_SB(1, 0), b3, voffB);
            PG8_BAR; PG8_WAIT_L(0); PG8_MMA(0, 1, At, B1); PG8_BAR;
            PG8_LDA(At, 1, 1); PG8_STAGE(PG8_SA(1, 0), a3, voffA);
            PG8_BAR; PG8_WAIT_L(0); PG8_MMA(1, 0, At, B0); PG8_BAR; PG8_SCHED;
            PG8_STAGE(PG8_SB(1, 1), b3 + hstepB, voffB);
            PG8_WAIT_V(6); PG8_BAR; PG8_MMA(1, 1, At, B1); PG8_BAR;
            }
        }
        if constexpr (ALIGN_EPI) { if (wr == 0) PG8_BAR; }
        if constexpr (!Epi::AFTER_DRAIN) { E(acc, cur, wr, wc, fr, fq); S.done(cur); }
        if (!has_next) break;
#pragma unroll
        for (int a = 0; a < 2; ++a)
#pragma unroll
            for (int b = 0; b < 2; ++b)
#pragma unroll
                for (int m = 0; m < 4; ++m)
#pragma unroll
                    for (int n = 0; n < 2; ++n) acc[a][b][m][n] = (f32x4){0.f, 0.f, 0.f, 0.f};
        cur = nxt; cA = nA; cB = nB; ++ui;
        if constexpr (ALIGN_EPI) { if (wr == 1) PG8_BAR; }
    }
    PG8_WAIT_V(0);
    if constexpr (!ALIGN_EPI) { if (wr == 0) PG8_BAR; }
    PG8_BAR;
    if constexpr (Epi::AFTER_DRAIN) { E.fused(acc, cur, wr, wc, fr, fq, lds, wid, lane); S.done(cur); }
#undef PG8_SA
#undef PG8_SB
#undef PG8_STAGE
#undef PG8_LDA
#undef PG8_LDB
#undef PG8_MMA
#undef PG8_WAIT_V
#undef PG8_WAIT_L
#undef PG8_BAR
#undef PG8_SCHED
}
}

#ifndef PG8_SP2
#define PG8_SP2 true
#endif
#ifndef PG8_ALIGN
#define PG8_ALIGN true
#endif
#ifndef P2_REPEAT
#define P2_REPEAT 1
#endif
#ifndef MK_ONE_LAUNCH
#define MK_ONE_LAUNCH 1
#endif

#define LAS __attribute__((address_space(3)))
typedef unsigned short bf16_t;
typedef short bf16x8 __attribute__((ext_vector_type(8)));
typedef short s16x4 __attribute__((ext_vector_type(4)));
typedef float f32x4 __attribute__((ext_vector_type(4)));
typedef float f32x2 __attribute__((ext_vector_type(2)));
typedef float f32x16 __attribute__((ext_vector_type(16)));
typedef unsigned u32x4 __attribute__((ext_vector_type(4)));
typedef unsigned u32x2 __attribute__((ext_vector_type(2)));

constexpr int NB = 2, SEQ = 8192, M = NB * SEQ, DM = 1024, NL = 4;
constexpr int ZW = 2560, DQ = 576, DKV = 768, DLRU = 384, DPOOL = 256;
constexpr int Z_ZA = 0, Z_GA = 384, Z_CQ = 768, Z_CKV = 1152, Z_KR = 1408, Z_GB = 1440, Z_ZC = 1824, Z_GC = 2080, D_IN = 2336;
constexpr float EPS = 1e-6f;
constexpr float QSCALE = 0.10206207261596577f * 1.4426950408889634f;
constexpr int NWAVES = 8, NTHREADS = 512;
constexpr int LDS_BYTES = 155648;

constexpr size_t MiB = 1u << 20;
constexpr size_t WS_CTL = 0, CTL_ZERO_BYTES = 1 * MiB;
typedef unsigned long long ssum_t;
constexpr size_t WS_ACC = 254 * MiB;
constexpr size_t OFF_SSX = 0, OFF_SSQ = (size_t)5 * 16384 * 8, OFF_SSKV = (size_t)9 * 16384 * 8, ACC_BYTES = (size_t)13 * 16384 * 8;
constexpr size_t WS_ROPE = 1 * MiB;
constexpr size_t WS_CHS = 2 * MiB;
constexpr size_t WS_SMALL = 3 * MiB;
constexpr size_t WS_WIN = 4 * MiB, WS_WOUT = 24 * MiB, WS_WUQ = 32 * MiB, WS_WUKV = 35 * MiB;
constexpr size_t WS_XB = 38 * MiB;
constexpr size_t OUT_Q = 0, OUT_KR = 20 * MiB;
constexpr size_t WS_Z = 70 * MiB, WS_KV = 150 * MiB, WS_A32 = 174 * MiB, WS_U32 = 198 * MiB, WS_Y = 222 * MiB, WS_END = 256 * MiB;

struct Args { const float* in[18]; float* out; unsigned char* ws; int ph_lo, ph_hi; };

struct Frame {
    LAS unsigned char* lds;
    int tid, lane, wave, bid, G;
    float* out; unsigned char* ws;
};
typedef __attribute__((address_space(1))) const float* gfp_t;
__device__ __forceinline__ const float* kin(int i) {
    __attribute__((address_space(4))) const char* k = (__attribute__((address_space(4))) const char*)__builtin_amdgcn_kernarg_segment_ptr();
    asm volatile("" : "+s"(k));
    gfp_t p_ = *(__attribute__((address_space(4))) const gfp_t*)(k + 8 * i);
    return (const float*)p_; }

__device__ __forceinline__ unsigned f2bf(float f) { unsigned u = __builtin_bit_cast(unsigned, f); return (u + 0x7fffu + ((u >> 16) & 1u)) >> 16; }
__device__ __forceinline__ unsigned pk2(float lo, float hi) { return f2bf(lo) | (f2bf(hi) << 16); }
__device__ __forceinline__ float bf2f(unsigned short b) { return __builtin_bit_cast(float, (unsigned)b << 16); }
__device__ __forceinline__ float bflo(unsigned w) { return __builtin_bit_cast(float, w << 16); }
__device__ __forceinline__ float bfhi(unsigned w) { return __builtin_bit_cast(float, w & 0xffff0000u); }
__device__ __forceinline__ float sigmoidf_(float x) { return 1.0f / (1.0f + __expf(-x)); }
__device__ __forceinline__ float siluf_(float x) { return x * __builtin_amdgcn_rcpf(1.0f + __expf(-x)); }
__device__ __forceinline__ float wave_sum(float v) {
#pragma unroll
    for (int o = 1; o < 64; o <<= 1) v += __shfl_xor(v, o);
    return v;
}
__device__ __forceinline__ void atomic_addf(ssum_t* p, float v) { (void)__hip_atomic_fetch_add(p, (ssum_t)(v * 16777216.0f), __ATOMIC_RELAXED, __HIP_MEMORY_SCOPE_AGENT); }
__device__ __forceinline__ float ldfx(const ssum_t* p) { return (float)(*p) * (1.0f / 16777216.0f); }
#define LDS_WAIT() asm volatile("s_waitcnt lgkmcnt(0)" ::: "memory")
__device__ __forceinline__ float fast_sigmoid(float x) { return __builtin_amdgcn_rcpf(1.0f + __expf(-x)); }
__device__ __forceinline__ float neg_expm1(float x) {
    const float ser = -x * (1.0f + x * (0.5f + x * (0.16666667f + x * (0.041666668f + x * 0.0083333338f))));
    const float dir = 1.0f - __expf(x);
    return (x > -0.25f) ? ser : dir;
}

struct EpiZ {
    static constexpr bool PERM = true, AFTER_DRAIN = false;
    bf16_t* Zb; const ssum_t* ssx; ssum_t* ssq; ssum_t* sskv;
    __device__ __forceinline__ void operator()(const pg8::f32x4 (&acc)[2][2][4][2], const pg8::Unit& u, int wr, int wc, int fr, int fq) const {
        const int row0 = u.pm * 256 + wr * 64 + fr, col0 = u.pn * 256 + wc * 32 + 8 * fq;
#pragma unroll
        for (int ai = 0; ai < 2; ++ai)
#pragma unroll
            for (int m = 0; m < 4; ++m) {
                const int row = row0 + ai * 128 + m * 16;
                const float rs = rsqrtf(ldfx(ssx + row) * (1.0f / 1024.0f) + EPS);
#pragma unroll
                for (int bj = 0; bj < 2; ++bj) {
                    const f32x4 v0 = acc[ai][bj][m][0] * rs, v1 = acc[ai][bj][m][1] * rs;
                    u32x4 w; w.x = pg8::cvt_pk_bf16(v0[0], v0[1]); w.y = pg8::cvt_pk_bf16(v0[2], v0[3]); w.z = pg8::cvt_pk_bf16(v1[0], v1[1]); w.w = pg8::cvt_pk_bf16(v1[2], v1[3]);
                    if (u.pn * 256 + bj * 128 + wc * 32 < D_IN) *(u32x4*)(Zb + (size_t)row * ZW + col0 + bj * 128) = w;
                    const int ht = u.pn * 2 + bj;
                    if (ht >= 6 && ht <= 10) {
                        float s = (v0[0] * v0[0] + v0[1] * v0[1]) + (v0[2] * v0[2] + v0[3] * v0[3]) + (v1[0] * v1[0] + v1[1] * v1[1]) + (v1[2] * v1[2] + v1[3] * v1[3]);
                        s += __shfl_xor(s, 16); s += __shfl_xor(s, 32);
                        if (fq == 0) atomic_addf((ht <= 8 ? ssq : sskv) + row, s);
                    }
                }
                asm volatile("" ::: "memory");
            }
    }
};
struct EpiQ {
    static constexpr bool PERM = true, AFTER_DRAIN = false;
    bf16_t* Qb; const ssum_t* ssq; const float* cosT; const float* sinT;
    __device__ __forceinline__ void operator()(const pg8::f32x4 (&acc)[2][2][4][2], const pg8::Unit& u, int wr, int wc, int fr, int fq) const {
        const int row0 = u.pm * 256 + wr * 64 + fr;
#pragma unroll
        for (int bj = 0; bj < 2; ++bj) {
            const int cg0 = u.pn * 256 + bj * 128 + wc * 32;
            if (cg0 >= DQ) continue;
            const bool rope = ((cg0 >> 5) % 3) == 2;
#pragma unroll
            for (int ai = 0; ai < 2; ++ai)
#pragma unroll
                for (int m = 0; m < 4; ++m) {
                    const int row = row0 + ai * 128 + m * 16;
                    const float rs = rsqrtf(ldfx(ssq + row) * (1.0f / 384.0f) + EPS) * QSCALE;
                    f32x4 v0 = acc[ai][bj][m][0] * rs, v1 = acc[ai][bj][m][1] * rs;
                    if (rope) {
                        const int pos = row & (SEQ - 1);
                        const f32x4 c0 = *(const f32x4*)(cosT + pos * 16 + 8 * (fq & 1)), c1 = *(const f32x4*)(cosT + pos * 16 + 8 * (fq & 1) + 4);
                        const f32x4 s0 = *(const f32x4*)(sinT + pos * 16 + 8 * (fq & 1)), s1 = *(const f32x4*)(sinT + pos * 16 + 8 * (fq & 1) + 4);
                        const float sg = (fq < 2) ? -1.0f : 1.0f;
                        f32x4 p0, p1;
#pragma unroll
                        for (int j = 0; j < 4; ++j) { p0[j] = __shfl_xor(v0[j], 32); p1[j] = __shfl_xor(v1[j], 32); }
                        v0 = v0 * c0 + (p0 * s0) * sg; v1 = v1 * c1 + (p1 * s1) * sg;
                    }
                    u32x4 w; w.x = pg8::cvt_pk_bf16(v0[0], v0[1]); w.y = pg8::cvt_pk_bf16(v0[2], v0[3]); w.z = pg8::cvt_pk_bf16(v1[0], v1[1]); w.w = pg8::cvt_pk_bf16(v1[2], v1[3]);
                    *(u32x4*)(Qb + (size_t)row * DQ + cg0 + 8 * fq) = w;
                    asm volatile("" ::: "memory");
                }
        }
    }
};
struct EpiKV {
    static constexpr bool PERM = true, AFTER_DRAIN = false;
    bf16_t* KVb; const ssum_t* sskv;
    __device__ __forceinline__ void operator()(const pg8::f32x4 (&acc)[2][2][4][2], const pg8::Unit& u, int wr, int wc, int fr, int fq) const {
        const int row0 = u.pm * 256 + wr * 64 + fr, col0 = u.pn * 256 + wc * 32 + 8 * fq;
#pragma unroll
        for (int ai = 0; ai < 2; ++ai)
#pragma unroll
            for (int m = 0; m < 4; ++m) {
                const int row = row0 + ai * 128 + m * 16;
                const float rs = rsqrtf(ldfx(sskv + row) * (1.0f / 256.0f) + EPS);
#pragma unroll
                for (int bj = 0; bj < 2; ++bj) {
                    const f32x4 v0 = acc[ai][bj][m][0] * rs, v1 = acc[ai][bj][m][1] * rs;
                    u32x4 w; w.x = pg8::cvt_pk_bf16(v0[0], v0[1]); w.y = pg8::cvt_pk_bf16(v0[2], v0[3]); w.z = pg8::cvt_pk_bf16(v1[0], v1[1]); w.w = pg8::cvt_pk_bf16(v1[2], v1[3]);
                    *(u32x4*)(KVb + (size_t)row * DKV + col0 + bj * 128) = w;
                }
                asm volatile("" ::: "memory");
            }
    }
};
struct EpiOut {
    static constexpr bool PERM = true, AFTER_DRAIN = false;
    bf16_t* XB; ssum_t* ssn;
    __device__ __forceinline__ void operator()(const pg8::f32x4 (&acc)[2][2][4][2], const pg8::Unit& u, int wr, int wc, int fr, int fq) const {
        const int row0 = u.pm * 256 + wr * 64 + fr, col0 = u.pn * 256 + wc * 32 + 8 * fq;
#pragma unroll
        for (int ai = 0; ai < 2; ++ai)
#pragma unroll
            for (int m = 0; m < 4; ++m) {
                const int row = row0 + ai * 128 + m * 16;
                float s = 0.f;
#pragma unroll
                for (int bj = 0; bj < 2; ++bj) {
                    const size_t off = (size_t)row * DM + col0 + bj * 128;
                    const u32x4 xw = *(const u32x4*)(XB + off);
                    const f32x4 v0 = (f32x4){bflo(xw.x), bfhi(xw.x), bflo(xw.y), bfhi(xw.y)} + acc[ai][bj][m][0], v1 = (f32x4){bflo(xw.z), bfhi(xw.z), bflo(xw.w), bfhi(xw.w)} + acc[ai][bj][m][1];
                    u32x4 w; w.x = pg8::cvt_pk_bf16(v0[0], v0[1]); w.y = pg8::cvt_pk_bf16(v0[2], v0[3]); w.z = pg8::cvt_pk_bf16(v1[0], v1[1]); w.w = pg8::cvt_pk_bf16(v1[2], v1[3]);
                    *(u32x4*)(XB + off) = w;
                    s += (v0[0] * v0[0] + v0[1] * v0[1]) + (v0[2] * v0[2] + v0[3] * v0[3]) + (v1[0] * v1[0] + v1[1] * v1[1]) + (v1[2] * v1[2] + v1[3] * v1[3]);
                }
                s += __shfl_xor(s, 16); s += __shfl_xor(s, 32);
                if (fq == 0) atomic_addf(ssn + row, s);
                asm volatile("" ::: "memory");
            }
    }
};

struct EpiAll {
    static constexpr bool PERM = true, AFTER_DRAIN = false;
    int mode; void* a; void* b; void* c; void* d;
    __device__ __forceinline__ void operator()(const pg8::f32x4 (&acc)[2][2][4][2], const pg8::Unit& u, int wr, int wc, int fr, int fq) const {
#ifdef ONLY_MODE
        if (mode != ONLY_MODE) return;
#endif
        if (mode == 0) { EpiZ E{(bf16_t*)a, (const ssum_t*)b, (ssum_t*)c, (ssum_t*)d}; E(acc, u, wr, wc, fr, fq); }
        else if (mode == 1) { EpiQ E{(bf16_t*)a, (const ssum_t*)b, (const float*)c, (const float*)d}; E(acc, u, wr, wc, fr, fq); }
        else if (mode == 2) { EpiKV E{(bf16_t*)a, (const ssum_t*)b}; E(acc, u, wr, wc, fr, fq); }
        else { EpiOut E{(bf16_t*)c, (ssum_t*)d}; E(acc, u, wr, wc, fr, fq); }
    }
};

__device__ __forceinline__ void p0_transpose_item(const float* W, int N, const float* g, bf16_t* WT, int ldt, LAS float* scr, int item, int lane) {
    const int nblk = N / 32, kb = item / nblk, nb = item % nblk, k0 = 64 * kb, n0 = 32 * nb;
#pragma unroll 8
    for (int i = 0; i < 32; ++i) { const int kk = 2 * i + (lane >> 5); float v = W[(size_t)(k0 + kk) * N + n0 + (lane & 31)]; if (g) v *= g[k0 + kk]; scr[kk * 33 + (lane & 31)] = v; }
    LDS_WAIT(); asm volatile("" ::: "memory");
    const int c = lane & 7;
#pragma unroll
    for (int j = 0; j < 4; ++j) { const int n = (lane >> 3) + 8 * j; const LAS float* s = scr + (8 * c) * 33 + n;
        u32x4 o; o.x = pk2(s[0 * 33], s[1 * 33]); o.y = pk2(s[2 * 33], s[3 * 33]); o.z = pk2(s[4 * 33], s[5 * 33]); o.w = pk2(s[6 * 33], s[7 * 33]);
        *(u32x4*)(WT + (size_t)(n0 + n) * ldt + k0 + 8 * c) = o; }
    LDS_WAIT(); asm volatile("" ::: "memory");
}
__device__ __forceinline__ void convert_layer_weights(Frame& F, int l, int gw, int NGW) {
    LAS float* scr = (LAS float*)(F.lds + F.wave * 16384);
    const int lane = F.lane;
    unsigned char* ws = F.ws;
    constexpr int I_IN = 16 * 73, I_OUT = 16 * 32, I_UQ = 6 * 18, I_UKV = 4 * 24, I_G = 12, I_P = 8;
    constexpr int I_L = I_IN + I_OUT + I_UQ + I_UKV + 2 * I_G + I_P;
    for (int it = gw; it < I_L; it += NGW) {
        int r = it;
        if (r < I_IN) { p0_transpose_item(kin(2) + (size_t)l * 1024 * D_IN, D_IN, kin(1) + l * 1024, (bf16_t*)(ws + WS_WIN) + (size_t)l * ZW * 1024, 1024, scr, r, lane); continue; } r -= I_IN;
        if (r < I_OUT) { p0_transpose_item(kin(16) + (size_t)l * 1024 * 1024, 1024, nullptr, (bf16_t*)(ws + WS_WOUT) + (size_t)l * 1024 * 1024, 1024, scr, r, lane); continue; } r -= I_OUT;
        if (r < I_UQ) { p0_transpose_item(kin(11) + (size_t)l * 384 * DQ, DQ, kin(10) + l * 384, (bf16_t*)(ws + WS_WUQ) + (size_t)l * 768 * 384, 384, scr, r, lane); continue; } r -= I_UQ;
        if (r < I_UKV) { p0_transpose_item(kin(13) + (size_t)l * 256 * DKV, DKV, kin(12) + l * 256, (bf16_t*)(ws + WS_WUKV) + (size_t)l * 768 * 256, 256, scr, r, lane); continue; } r -= I_UKV;
        if (r < I_G) { const int h = r >> 1; p0_transpose_item(kin(5) + (size_t)(l * 6 + h) * 4096, 64, nullptr, (bf16_t*)(ws + WS_SMALL) + (size_t)(l * 6 + h) * 4096, 64, scr, r & 1, lane); continue; } r -= I_G;
        if (r < I_G) { const int h = r >> 1; p0_transpose_item(kin(7) + (size_t)(l * 6 + h) * 4096, 64, nullptr, (bf16_t*)(ws + WS_SMALL + 196608) + (size_t)(l * 6 + h) * 4096, 64, scr, r & 1, lane); continue; } r -= I_G;
        { const int gq = r >> 1; p0_transpose_item(kin(14) + (size_t)(l * 4 + gq) * 4096, 64, nullptr, (bf16_t*)(ws + WS_SMALL + 393216) + (size_t)(l * 4 + gq) * 4096, 64, scr, r & 1, lane); }
    }
}
__device__ __forceinline__ void phase_prologue(Frame& F) {
    const int gw = F.bid * NWAVES + F.wave, NGW = F.G * NWAVES, lane = F.lane;
    unsigned char* ws = F.ws;
    convert_layer_weights(F, 0, gw, NGW);
    if (F.G != 256) { for (int l = 1; l < NL; ++l) convert_layer_weights(F, l, gw, NGW); }
    {
        const int gt = F.bid * NTHREADS + F.tid, NGT = F.G * NTHREADS;
        constexpr int ZIN = 224 * 1024 * 2 / 16, ZUQ = 192 * 384 * 2 / 16;
        for (int i = gt; i < NL * (ZIN + ZUQ); i += NGT) {
            const int l = i / (ZIN + ZUQ), r = i % (ZIN + ZUQ);
            u32x4* p = (r < ZIN) ? (u32x4*)(ws + WS_WIN + ((size_t)l * ZW + D_IN) * 1024 * 2) + r : (u32x4*)(ws + WS_WUQ + ((size_t)l * 768 + DQ) * 384 * 2) + (r - ZIN);
            *p = (u32x4){0u, 0u, 0u, 0u};
        }
        float* SP = (float*)(ws + WS_SMALL + 524288);
        for (int i = gt; i < NL * DLRU; i += NGT) SP[i] = log1pf(expf(-kin(9)[i]));
        float* cosT = (float*)(ws + WS_ROPE); float* sinT = cosT + SEQ * 16;
        for (int i = gt; i < SEQ * 16; i += NGT) {
            const int pos = i >> 4, fi = i & 15, j = fi & 3, k = fi >> 2;
            double inv = (j == 0) ? 1.0 : (j == 1) ? 0.56234132519034908 : (j == 2) ? 0.31622776601683794 : 0.17782794100389228;
            inv *= (k == 0) ? 1.0 : (k == 1) ? 0.1 : (k == 2) ? 0.01 : 0.001;
            const double ang = (double)pos * inv;
            const double n = __builtin_rint(ang * 0.15915494309189535);
            double rr = __builtin_fma(-n, 6.283185307179586, ang); rr = __builtin_fma(-n, 2.4492935982947064e-16, rr);
            const double r2 = rr * rr; double tc = 1.0, sc = 1.0, tsn = rr, ss = rr;
#pragma unroll 1
            for (int q = 1; q <= 15; ++q) { tc *= -r2 / (double)((2 * q - 1) * (2 * q)); sc += tc; tsn *= -r2 / (double)((2 * q) * (2 * q + 1)); ss += tsn; }
            cosT[i] = (float)sc; sinT[i] = (float)ss;
        }
    }
    {
        const float* x = kin(0); bf16_t* XB = (bf16_t*)(ws + WS_XB); ssum_t* ssx = (ssum_t*)(ws + WS_ACC + OFF_SSX);
#pragma unroll 4
        for (int m = gw; m < M; m += NGW) {
            const f32x4* xr = (const f32x4*)(x + (size_t)m * DM) + lane; u32x2* o = (u32x2*)(XB + (size_t)m * DM) + lane;
            float s = 0.f;
#pragma unroll
            for (int j = 0; j < 4; ++j) { const f32x4 v = __builtin_nontemporal_load(&xr[64 * j]);   s += (v.x * v.x + v.y * v.y) + (v.z * v.z + v.w * v.w); o[64 * j] = (u32x2){pk2(v.x, v.y), pk2(v.z, v.w)}; }
            s = wave_sum(s);
            if (lane == 0) ssx[m] = (ssum_t)(s * 16777216.0f);
        }
    }
}

__device__ __forceinline__ bf16x8 ld_x_frag(const LAS float* p) {
    const f32x4 a = *(const LAS f32x4*)p, b = *(const LAS f32x4*)(p + 4);
    u32x4 w; w.x = pg8::cvt_pk_bf16(a[0], a[1]); w.y = pg8::cvt_pk_bf16(a[2], a[3]); w.z = pg8::cvt_pk_bf16(b[0], b[1]); w.w = pg8::cvt_pk_bf16(b[2], b[3]);
    return __builtin_bit_cast(bf16x8, w);
}
constexpr int XAP16 = 392, PLP16 = 264;
constexpr int L2_LA = 64 * XAP16 * 2, L2_UU = L2_LA + 64 * DLRU * 2, L2_END = L2_UU + 64 * DLRU * 2;
static_assert(L2_END <= 150016, "phase-2 LDS map (below the barrier's LDS words)");
template <int W> __device__ __forceinline__ void pool_rows(const float (&c0)[31], const float (&c1)[31], const float (&v0)[31], const float (&v1)[31], int tpos0, LAS bf16_t* dst) {
#pragma unroll
    for (int j = 0; j < 16; ++j) {
        const int idx = 15 + j; const int tp = tpos0 + j;
        float s0 = c0[idx], s1 = c1[idx];
        if (idx - W >= 0) { s0 -= c0[idx - W >= 0 ? idx - W : 0]; s1 -= c1[idx - W >= 0 ? idx - W : 0]; }
        const float rc = __builtin_amdgcn_rcpf((float)((tp + 1 < W) ? tp + 1 : W));
        *(LAS unsigned*)(dst + j * PLP16) = pg8::cvt_pk_bf16(s0 * rc - v0[idx], s1 * rc - v1[idx]);
    }
}
__device__ __forceinline__ void phase2_tile(Frame& F, int l, int u) {
    const int tid = F.tid, lane = F.lane, wave = F.wave;
    unsigned char* ws = F.ws;
    const bf16_t* Z = (const bf16_t*)(ws + WS_Z);
    const int row0 = u * 64, t0 = (u & 127) * 64;
    LAS bf16_t* XA = (LAS bf16_t*)F.lds;
    LAS bf16_t* LA = (LAS bf16_t*)(F.lds + L2_LA); LAS bf16_t* UU = (LAS bf16_t*)(F.lds + L2_UU);
    bf16_t* A16 = (bf16_t*)(ws + WS_A32); bf16_t* U16 = (bf16_t*)(ws + WS_U32);
    if (tid < 384) {
        const int p = tid % 192, half = tid / 192, c = 2 * p;
        const float* cw = kin(3) + (size_t)l * 4 * DLRU; const float* cb = kin(4) + (size_t)l * DLRU;
        const f32x2 w0 = *(const f32x2*)(cw + c), w1 = *(const f32x2*)(cw + DLRU + c), w2 = *(const f32x2*)(cw + 2 * DLRU + c), w3 = *(const f32x2*)(cw + 3 * DLRU + c), bb = *(const f32x2*)(cb + c);
        const int ts = t0 + 32 * half;
        const bf16_t* zp = Z + (size_t)(row0 + 32 * half) * ZW + Z_ZA + c;
        unsigned zr[35];
#pragma unroll
        for (int j = 0; j < 35; ++j) { zr[j] = 0u; if (j >= 3 || ts >= 3) zr[j] = *(const unsigned*)(zp + (ptrdiff_t)(j - 3) * ZW); }
#pragma unroll
        for (int j = 0; j < 32; ++j) {
            const f32x2 x0 = {bflo(zr[j]), bfhi(zr[j])}, x1 = {bflo(zr[j + 1]), bfhi(zr[j + 1])}, x2 = {bflo(zr[j + 2]), bfhi(zr[j + 2])}, x3 = {bflo(zr[j + 3]), bfhi(zr[j + 3])};
            const f32x2 y = bb + w0 * x0 + w1 * x1 + w2 * x2 + w3 * x3;
            *(LAS unsigned*)(XA + (32 * half + j) * XAP16 + c) = pg8::cvt_pk_bf16(y.x, y.y);
        }
    } else {
        const float* cosT = (const float*)(ws + WS_ROPE); const float* sinT = cosT + SEQ * 16;
        bf16_t* KR = (bf16_t*)((unsigned char*)F.out + OUT_KR);
        float ka[8], kb2[8], kc[8], ks[8];
#pragma unroll
        for (int q = 0; q < 8; ++q) { const int it = tid - 384 + 128 * q, tk = it >> 4, i = it & 15, row = row0 + tk, pos = t0 + tk;
            ka[q] = bf2f(Z[(size_t)row * ZW + Z_KR + i]); kb2[q] = bf2f(Z[(size_t)row * ZW + Z_KR + 16 + i]); kc[q] = cosT[pos * 16 + i]; ks[q] = sinT[pos * 16 + i]; }
#pragma unroll
        for (int q = 0; q < 8; ++q) { const int it = tid - 384 + 128 * q, tk = it >> 4, i = it & 15, row = row0 + tk;
            KR[(size_t)row * 32 + i] = (bf16_t)f2bf(ka[q] * kc[q] - kb2[q] * ks[q]); KR[(size_t)row * 32 + 16 + i] = (bf16_t)f2bf(ka[q] * ks[q] + kb2[q] * kc[q]); }
    }
    __syncthreads();
    {
        const int mt = wave & 3, hg = wave >> 2, fr = lane & 15, fq = lane >> 4;
        const bf16_t* Wr = (const bf16_t*)(ws + WS_SMALL) + (size_t)l * 6 * 4096; const bf16_t* Wi = (const bf16_t*)(ws + WS_SMALL + 196608) + (size_t)l * 6 * 4096;
        const float* br = kin(6) + l * DLRU; const float* bi = kin(8) + l * DLRU; const float* SP = (const float*)(ws + WS_SMALL + 524288) + l * DLRU;
        const LAS bf16_t* xrow = XA + (16 * mt + fr) * XAP16; const int lrow = (16 * mt + fr) * DLRU;
        const size_t grow = (size_t)(row0 + 16 * mt + fr) * DLRU;
#pragma unroll 1
        for (int hh = 0; hh < 3; ++hh) {
            const int h = 3 * hg + hh;
            const bf16x8 xb0 = *(const LAS bf16x8*)(xrow + 64 * h + 8 * fq), xb1 = *(const LAS bf16x8*)(xrow + 64 * h + 32 + 8 * fq);
            bf16x8 wfr[4][4]; f32x4 brq[4], biq[4], spq[4];
#pragma unroll
            for (int nt = 0; nt < 4; ++nt) {
                const bf16_t* wr_ = Wr + (size_t)h * 4096 + (16 * nt + fr) * 64 + 8 * fq; const bf16_t* wi_ = Wi + (size_t)h * 4096 + (16 * nt + fr) * 64 + 8 * fq;
                wfr[nt][0] = *(const bf16x8*)wr_; wfr[nt][1] = *(const bf16x8*)(wr_ + 32); wfr[nt][2] = *(const bf16x8*)wi_; wfr[nt][3] = *(const bf16x8*)(wi_ + 32);
                const int c = 64 * h + 16 * nt + 4 * fq;
                brq[nt] = *(const f32x4*)(br + c); biq[nt] = *(const f32x4*)(bi + c); spq[nt] = *(const f32x4*)(SP + c);
            }
#pragma unroll
            for (int nt = 0; nt < 4; ++nt) {
                const bf16x8 ar0 = wfr[nt][0], ar1 = wfr[nt][1], ai0 = wfr[nt][2], ai1 = wfr[nt][3];
                f32x4 accR = {0.f, 0.f, 0.f, 0.f}, accI = {0.f, 0.f, 0.f, 0.f};
                accR = __builtin_amdgcn_mfma_f32_16x16x32_bf16(ar0, xb0, accR, 0, 0, 0); accR = __builtin_amdgcn_mfma_f32_16x16x32_bf16(ar1, xb1, accR, 0, 0, 0);
                accI = __builtin_amdgcn_mfma_f32_16x16x32_bf16(ai0, xb0, accI, 0, 0, 0); accI = __builtin_amdgcn_mfma_f32_16x16x32_bf16(ai1, xb1, accI, 0, 0, 0);
                const int c = 64 * h + 16 * nt + 4 * fq;
                const u32x2 xw_ = *(const LAS u32x2*)(xrow + c);
                const f32x4 brv = brq[nt], biv = biq[nt], spv = spq[nt], xav = {bflo(xw_.x), bfhi(xw_.x), bflo(xw_.y), bfhi(xw_.y)};
                f32x4 lv, uv;
#pragma unroll
                for (int v = 0; v < 4; ++v) {
                    const float r = fast_sigmoid(accR[v] + brv[v]), ig = fast_sigmoid(accI[v] + biv[v]);
                    const float la = -8.0f * r * spv[v];
                    lv[v] = la; uv[v] = __builtin_amdgcn_sqrtf(neg_expm1(2.0f * la)) * (ig * xav[v]);
                }
                *(LAS u32x2*)(LA + lrow + c) = (u32x2){pg8::cvt_pk_bf16(lv[0], lv[1]), pg8::cvt_pk_bf16(lv[2], lv[3])};
                *(LAS u32x2*)(UU + lrow + c) = (u32x2){pg8::cvt_pk_bf16(uv[0], uv[1]), pg8::cvt_pk_bf16(uv[2], uv[3])};
            }
        }
    }
    __syncthreads();
    unsigned zpool[31];
    {
        const int p_ = tid & 127, tq_ = tid >> 7, c_ = 2 * p_, tp0_ = t0 + 16 * tq_;
#pragma unroll
        for (int i = 0; i < 31; ++i) { zpool[i] = 0u; if (tp0_ - 15 + i >= 0) zpool[i] = *(const unsigned*)(Z + (size_t)(row0 + 16 * tq_ - 15 + i) * ZW + Z_ZC + c_); }
    }
    if (tid < DLRU) {
        float ap = 1.0f, hh = 0.0f;
#pragma unroll 1
        for (int jb = 0; jb < 64; jb += 16) {
            unsigned short lq[16], uq16[16], pq[16], hq[16];
#pragma unroll
            for (int j = 0; j < 16; ++j) { lq[j] = LA[(jb + j) * DLRU + tid]; uq16[j] = UU[(jb + j) * DLRU + tid]; }
#pragma unroll
            for (int j = 0; j < 16; ++j) { const float a = __expf(bf2f(lq[j])); hh = a * hh + bf2f(uq16[j]); ap *= a; const unsigned w_ = pg8::cvt_pk_bf16(ap, hh); pq[j] = (unsigned short)(w_ & 0xffffu); hq[j] = (unsigned short)(w_ >> 16); }
#pragma unroll
            for (int j = 0; j < 16; ++j) { LA[(jb + j) * DLRU + tid] = pq[j]; UU[(jb + j) * DLRU + tid] = hq[j]; }
        }
        float* CA = (float*)(ws + WS_CHS); float* CH = CA + 256 * DLRU;
        CA[u * DLRU + tid] = ap; CH[u * DLRU + tid] = hh;
    }
    LAS bf16_t* PL = (LAS bf16_t*)F.lds;
    {
        const int p = tid & 127, tq = tid >> 7, c = 2 * p, g = c >> 6;
        const int tp0 = t0 + 16 * tq;
        float v0[31], v1[31], c0[31], c1[31];
#pragma unroll
        for (int i = 0; i < 31; ++i) {
            const unsigned a = zpool[i];
            v0[i] = bflo(a); v1[i] = bfhi(a);
            c0[i] = (i ? c0[i - 1] : 0.f) + v0[i]; c1[i] = (i ? c1[i - 1] : 0.f) + v1[i];
        }
        LAS bf16_t* dst = PL + (16 * tq) * PLP16 + c;
        if (g == 0) pool_rows<2>(c0, c1, v0, v1, tp0, dst); else if (g == 1) pool_rows<4>(c0, c1, v0, v1, tp0, dst); else if (g == 2) pool_rows<8>(c0, c1, v0, v1, tp0, dst); else pool_rows<16>(c0, c1, v0, v1, tp0, dst);
    }
    __syncthreads();
#pragma unroll
    for (int k = 0; k < 6; ++k) { const int idx = tid + NTHREADS * k;
        const u32x4 va = *(const LAS u32x4*)(LA + idx * 8), vu = *(const LAS u32x4*)(UU + idx * 8);
        *(u32x4*)(A16 + (size_t)row0 * DLRU + idx * 8) = va; *(u32x4*)(U16 + (size_t)row0 * DLRU + idx * 8) = vu; }
    {
        const int mt = wave & 3, gg = wave >> 2, fr = lane & 15, fq = lane >> 4;
        const bf16_t* Wp = (const bf16_t*)(ws + WS_SMALL + 393216) + (size_t)l * 4 * 4096; const float* psc = kin(15) + l * DPOOL;
        bf16_t* Y = (bf16_t*)(ws + WS_Y);
        const LAS bf16_t* prow = PL + (16 * mt + fr) * PLP16; const size_t row = (size_t)(row0 + 16 * mt + fr);
        u32x2 gcq[2][4]; f32x4 psq[2][4]; bf16x8 wpq[2][4][2];
#pragma unroll
        for (int q = 0; q < 2; ++q)
#pragma unroll
            for (int nt = 0; nt < 4; ++nt) { const int g = 2 * gg + q, c = 64 * g + 16 * nt + 4 * fq;
                gcq[q][nt] = *(const u32x2*)(Z + row * ZW + Z_GC + c); psq[q][nt] = *(const f32x4*)(psc + c);
                const bf16_t* wp_ = Wp + (size_t)g * 4096 + (16 * nt + fr) * 64 + 8 * fq; wpq[q][nt][0] = *(const bf16x8*)wp_; wpq[q][nt][1] = *(const bf16x8*)(wp_ + 32); }
#pragma unroll
        for (int q = 0; q < 2; ++q) {
            const int g = 2 * gg + q;
            const bf16x8 xb0 = *(const LAS bf16x8*)(prow + 64 * g + 8 * fq), xb1 = *(const LAS bf16x8*)(prow + 64 * g + 32 + 8 * fq);
#pragma unroll
            for (int nt = 0; nt < 4; ++nt) {
                const bf16x8 a0 = wpq[q][nt][0], a1 = wpq[q][nt][1];
                f32x4 acc = {0.f, 0.f, 0.f, 0.f};
                acc = __builtin_amdgcn_mfma_f32_16x16x32_bf16(a0, xb0, acc, 0, 0, 0); acc = __builtin_amdgcn_mfma_f32_16x16x32_bf16(a1, xb1, acc, 0, 0, 0);
                const int c = 64 * g + 16 * nt + 4 * fq;
                const f32x4 ps = psq[q][nt]; const u32x2 gw_ = gcq[q][nt];
                const float y0 = acc[0] * ps[0] * siluf_(bflo(gw_.x)), y1 = acc[1] * ps[1] * siluf_(bfhi(gw_.x)), y2 = acc[2] * ps[2] * siluf_(bflo(gw_.y)), y3 = acc[3] * ps[3] * siluf_(bfhi(gw_.y));
                *(u32x2*)(Y + row * DM + 768 + c) = (u32x2){pg8::cvt_pk_bf16(y0, y1), pg8::cvt_pk_bf16(y2, y3)};
            }
        }
    }
    __syncthreads();
}

__device__ __forceinline__ void lru_final_unit(Frame& F, int u) {
    const int tid = F.tid; unsigned char* ws = F.ws;
    LAS float* carry = (LAS float*)F.lds;
    if (tid < DLRU) {
        const float* CA = (const float*)(ws + WS_CHS); const float* CH = CA + 256 * DLRU;
        const int b0 = u & ~127;
        float hh = 0.f;
#pragma unroll 16
        for (int j = b0; j < u; ++j) hh = CA[j * DLRU + tid] * hh + CH[j * DLRU + tid];
        carry[tid] = hh;
    }
    __syncthreads();
    const bf16_t* PA = (const bf16_t*)(ws + WS_A32) + (size_t)u * 64 * DLRU; const bf16_t* HL = (const bf16_t*)(ws + WS_U32) + (size_t)u * 64 * DLRU;
    const bf16_t* zg = (const bf16_t*)(ws + WS_Z) + (size_t)u * 64 * ZW + Z_GA; bf16_t* Y = (bf16_t*)(ws + WS_Y) + (size_t)u * 64 * DM;
    {
        u32x4 pq[6], hq[6], gq[6];
#pragma unroll
        for (int k = 0; k < 6; ++k) { const int idx = tid + NTHREADS * k, row = idx / 48, c = 8 * (idx % 48);
            pq[k] = *(const u32x4*)(PA + (size_t)row * DLRU + c); hq[k] = *(const u32x4*)(HL + (size_t)row * DLRU + c); gq[k] = *(const u32x4*)(zg + (size_t)row * ZW + c); }
#pragma unroll
        for (int k = 0; k < 6; ++k) { const int idx = tid + NTHREADS * k, row = idx / 48, c = 8 * (idx % 48);
            const f32x4 cr0 = *(const LAS f32x4*)(carry + c), cr1 = *(const LAS f32x4*)(carry + c + 4);
            const f32x4 p0 = {bflo(pq[k].x), bfhi(pq[k].x), bflo(pq[k].y), bfhi(pq[k].y)}, p1 = {bflo(pq[k].z), bfhi(pq[k].z), bflo(pq[k].w), bfhi(pq[k].w)};
            const f32x4 h0 = (f32x4){bflo(hq[k].x), bfhi(hq[k].x), bflo(hq[k].y), bfhi(hq[k].y)} + p0 * cr0, h1 = (f32x4){bflo(hq[k].z), bfhi(hq[k].z), bflo(hq[k].w), bfhi(hq[k].w)} + p1 * cr1;
            const u32x4 g = gq[k];
            u32x4 w;
            w.x = pg8::cvt_pk_bf16(h0[0] * siluf_(bflo(g.x)), h0[1] * siluf_(bfhi(g.x))); w.y = pg8::cvt_pk_bf16(h0[2] * siluf_(bflo(g.y)), h0[3] * siluf_(bfhi(g.y)));
            w.z = pg8::cvt_pk_bf16(h1[0] * siluf_(bflo(g.z)), h1[1] * siluf_(bfhi(g.z))); w.w = pg8::cvt_pk_bf16(h1[2] * siluf_(bflo(g.w)), h1[3] * siluf_(bfhi(g.w)));
            *(u32x4*)(Y + (size_t)row * DM + c) = w; }
    }
    __syncthreads();
}

namespace att {
constexpr int KSLOT = 12288, VSLOT = 8192;
constexpr int L_K = 0, L_V = 3 * KSLOT, L_WS = L_V + 3 * VSLOT, L_OST = L_WS + NWAVES * 256, L_END = L_OST + NWAVES * 8192;
static_assert(L_END <= 131072, "attention LDS");
__device__ __forceinline__ int crow(int r, int hi) { return (r & 3) + 8 * (r >> 2) + 4 * hi; }
__device__ __forceinline__ void glds16(const void* gsrc, unsigned lds_dst) {
    unsigned keep;
    asm volatile("s_mov_b32 %0, m0\n\ts_mov_b32 m0, %2\n\ts_nop 0\n\tglobal_load_lds_dwordx4 %1, off\n\ts_mov_b32 m0, %0" : "=&s"(keep) : "v"(gsrc), "s"(lds_dst) : "memory");
}
__device__ __forceinline__ void glds16s(const void* sbase, unsigned voff, unsigned lds_dst) {
    unsigned keep;
    asm volatile("s_mov_b32 %0, m0\n\ts_mov_b32 m0, %3\n\ts_nop 0\n\tglobal_load_lds_dwordx4 %1, %2\n\ts_mov_b32 m0, %0" : "=&s"(keep) : "v"(voff), "s"(sbase), "s"(lds_dst) : "memory");
}
typedef short v4i16_t __attribute__((ext_vector_type(4)));
__device__ __forceinline__ s16x4 vtr(const LAS char* p) { return __builtin_bit_cast(s16x4, __builtin_amdgcn_ds_read_tr16_b64_v4i16((LAS v4i16_t*)p)); }
typedef float f32x2_t __attribute__((ext_vector_type(2))); typedef __bf16 bf16x2_t __attribute__((ext_vector_type(2)));
__device__ __forceinline__ unsigned cvtpk_s(float lo, float hi) { f32x2_t v = {lo, hi}; bf16x2_t b = __builtin_convertvector(v, bf16x2_t); return __builtin_bit_cast(unsigned, b); }
__device__ __forceinline__ float swapmax(float m) { auto rr = __builtin_amdgcn_permlane32_swap(__float_as_uint(m), __float_as_uint(m), false, false); return fmaxf(__uint_as_float(rr[0]), __uint_as_float(rr[1])); }
__device__ __forceinline__ float swapsum(float m) { auto rr = __builtin_amdgcn_permlane32_swap(__float_as_uint(m), __float_as_uint(m), false, false); return __uint_as_float(rr[0]) + __uint_as_float(rr[1]); }
#define ATT_WAIT_BAR() asm volatile("s_waitcnt vmcnt(0) lgkmcnt(0)\n\ts_barrier" ::: "memory")

__device__ __forceinline__ void attn_unit(Frame& F, int b, int h, int qb) {
    const int lane = F.lane, r32 = lane & 31, hi = lane >> 5, wid = F.wave;
    unsigned char* ws = F.ws;
    const bf16_t* Q = (const bf16_t*)((const unsigned char*)F.out + OUT_Q); const bf16_t* KV = (const bf16_t*)(ws + WS_KV); const bf16_t* KR = (const bf16_t*)((const unsigned char*)F.out + OUT_KR);
    const LAS char* shm = (const LAS char*)F.lds;
    const unsigned lds0 = (unsigned)(uintptr_t)F.lds;
    const long rowbase = (long)b * SEQ; const int q0 = qb * 256;
    const bf16_t* kbase = KV + rowbase * DKV + h * 128 + wid * 8;
    const bf16_t* krbase = KR + rowbase * 32 + (wid & 3) * 8;
    const bf16_t* vbase = KV + (rowbase + 16 * (wid & 3)) * DKV + h * 128 + 64 + (wid >> 2) * 32;
    const unsigned kroffv = (unsigned)lane * 64u, voffv = (unsigned)(lane >> 2) * (DKV * 2) + (unsigned)(lane & 3) * 16u;
    const unsigned kdst = (unsigned)__builtin_amdgcn_readfirstlane(lds0 + L_K + wid * 1024), krdst = kdst + 8 * 1024  , vdst = kdst + (L_V - L_K);
#define ATT_ISSUE_K(t, sl) do { unsigned ko_ = kroffv; asm volatile("" : "+v"(ko_));   glds16s(kbase + (long)(t) * 64 * DKV, ko_ * 24u, kdst + (sl) * KSLOT); if (wid < 4) glds16s(krbase + (long)(t) * 64 * 32, kroffv, krdst + (sl) * KSLOT); } while (0)
#define ATT_ISSUE_V(t, sl) do { glds16s(vbase + (long)(t) * 64 * DKV, voffv, vdst + (sl) * VSLOT); } while (0)
#define ATT_QK(P0, P1, sl) do { const LAS char* kb_ = kfb + (sl) * KSLOT; P0 = f32x16{}; P1 = f32x16{}; \
        _Pragma("unroll") for (int d0 = 0; d0 < 6; ++d0) { \
            const bf16x8 k0_ = *(const LAS bf16x8*)(kb_ + d0 * 2048), k1_ = *(const LAS bf16x8*)(kb_ + d0 * 2048 + 512); \
            P0 = __builtin_amdgcn_mfma_f32_32x32x16_bf16(k0_, qr[d0], P0, 0, 0, 0); \
            P1 = __builtin_amdgcn_mfma_f32_32x32x16_bf16(k1_, qr[d0], P1, 0, 0, 0); } } while (0)
#define MX3(a, b, c) __builtin_fmaxf(__builtin_fmaxf((a), (b)), (c))
#define ATT_THR 8.0f
#define ATT_QKN(P0, P1, sl) do { const LAS char* kb_ = kfb + (sl) * KSLOT; \
        _Pragma("unroll") for (int d0 = 0; d0 < 6; ++d0) { \
            const bf16x8 k0_ = *(const LAS bf16x8*)(kb_ + d0 * 2048), k1_ = *(const LAS bf16x8*)(kb_ + d0 * 2048 + 512); \
            if (d0 == 0) { P0 = __builtin_amdgcn_mfma_f32_32x32x16_bf16(k0_, qr[0], negm, 0, 0, 0); P1 = __builtin_amdgcn_mfma_f32_32x32x16_bf16(k1_, qr[0], negm, 0, 0, 0); } \
            else { P0 = __builtin_amdgcn_mfma_f32_32x32x16_bf16(k0_, qr[d0], P0, 0, 0, 0); P1 = __builtin_amdgcn_mfma_f32_32x32x16_bf16(k1_, qr[d0], P1, 0, 0, 0); } } } while (0)
#define ATT_VF(d0, ks) ({ const s16x4 lo_ = vtr(vb + (d0) * 4096 + (ks) * 1024), hi_ = vtr(vb + (d0) * 4096 + (ks) * 1024 + 512); (bf16x8){lo_[0], lo_[1], lo_[2], lo_[3], hi_[0], hi_[1], hi_[2], hi_[3]}; })
#define ATT_STEP(C0, C1, N0, N1, tt) do { \
        ATT_WAIT_BAR(); \
        const int sl = (tt) & 1; \
        if ((tt) + 2 < NT) ATT_ISSUE_K((tt) + 2, sl); \
        if ((tt) + 1 < NT) ATT_ISSUE_V((tt) + 1, sl ^ 1); \
        if ((tt) <= tmax) { \
            if ((tt) == tmax) { const int kbase = 64 * (tt); \
                _Pragma("unroll") for (int r = 0; r < 16; ++r) { const int kv = kbase + crow(r, hi); if (kv > qabs) C0[r] = -INFINITY; if (kv + 32 > qabs) C1[r] = -INFINITY; } } \
            float ra = MX3(C0[0], C0[1], C1[0]), rb = MX3(C0[2], C0[3], C1[1]); ra = MX3(ra, C1[2], C1[3]); \
            _Pragma("unroll") for (int r = 4; r < 16; r += 4) { ra = MX3(ra, C0[r], C0[r + 1]); rb = MX3(rb, C0[r + 2], C0[r + 3]); ra = MX3(ra, C1[r], C1[r + 1]); rb = MX3(rb, C1[r + 2], C1[r + 3]); } \
            const float rm = swapmax(fmaxf(ra, rb)); \
            if ((tt) == 0 || __any(rm > ATT_THR)) {                                     \
                const float dl = ((tt) == 0) ? rm : fmaxf(rm, 0.f); \
                mref += dl; \
                _Pragma("unroll") for (int r = 0; r < 16; ++r) { C0[r] -= dl; C1[r] -= dl; } \
                _Pragma("unroll") for (int r = 0; r < 16; ++r) negm[r] = -mref; \
                asm volatile("" : "+v"(negm)); \
                if ((tt) != 0) { const float f = __builtin_amdgcn_exp2f(-dl); lrun *= f; \
                    if (hi == 0) wsf[r32] = f; \
                    LDS_WAIT(); \
                    _Pragma("unroll") for (int g4 = 0; g4 < 4; ++g4) { const f32x4 fv = *(const LAS f32x4*)(wsf + 8 * g4 + 4 * hi); \
                        _Pragma("unroll") for (int j = 0; j < 4; ++j) { o0[4 * g4 + j] *= fv[j]; o1[4 * g4 + j] *= fv[j]; } } \
                    LDS_WAIT(); } \
            } \
            ATT_QKN(N0, N1, sl ^ 1);                                                    \
            _Pragma("unroll") for (int r = 0; r < 16; ++r) { C0[r] = __builtin_amdgcn_exp2f(C0[r]); C1[r] = __builtin_amdgcn_exp2f(C1[r]); } \
            float sa = C0[0];                                                           \
            _Pragma("unroll") for (int r = 1; r < 16; ++r) sa += C0[r]; \
            _Pragma("unroll") for (int r = 0; r < 16; ++r) sa += C1[r]; \
            lrun += sa; \
            const u32x4 pw0 = (u32x4){cvtpk_s(C0[0], C0[1]), cvtpk_s(C0[2], C0[3]), cvtpk_s(C0[4], C0[5]), cvtpk_s(C0[6], C0[7])}; \
            const u32x4 pw1 = (u32x4){cvtpk_s(C0[8], C0[9]), cvtpk_s(C0[10], C0[11]), cvtpk_s(C0[12], C0[13]), cvtpk_s(C0[14], C0[15])}; \
            const u32x4 pw2 = (u32x4){cvtpk_s(C1[0], C1[1]), cvtpk_s(C1[2], C1[3]), cvtpk_s(C1[4], C1[5]), cvtpk_s(C1[6], C1[7])}; \
            const u32x4 pw3 = (u32x4){cvtpk_s(C1[8], C1[9]), cvtpk_s(C1[10], C1[11]), cvtpk_s(C1[12], C1[13]), cvtpk_s(C1[14], C1[15])}; \
            const LAS char* vb = vfb + sl * VSLOT; \
            o0 = __builtin_amdgcn_mfma_f32_32x32x16_bf16(__builtin_bit_cast(bf16x8, pw0), ATT_VF(0, 0), o0, 0, 0, 0); \
            o1 = __builtin_amdgcn_mfma_f32_32x32x16_bf16(__builtin_bit_cast(bf16x8, pw0), ATT_VF(1, 0), o1, 0, 0, 0); \
            o0 = __builtin_amdgcn_mfma_f32_32x32x16_bf16(__builtin_bit_cast(bf16x8, pw1), ATT_VF(0, 1), o0, 0, 0, 0); \
            o1 = __builtin_amdgcn_mfma_f32_32x32x16_bf16(__builtin_bit_cast(bf16x8, pw1), ATT_VF(1, 1), o1, 0, 0, 0); \
            o0 = __builtin_amdgcn_mfma_f32_32x32x16_bf16(__builtin_bit_cast(bf16x8, pw2), ATT_VF(0, 2), o0, 0, 0, 0); \
            o1 = __builtin_amdgcn_mfma_f32_32x32x16_bf16(__builtin_bit_cast(bf16x8, pw2), ATT_VF(1, 2), o1, 0, 0, 0); \
            o0 = __builtin_amdgcn_mfma_f32_32x32x16_bf16(__builtin_bit_cast(bf16x8, pw3), ATT_VF(0, 3), o0, 0, 0, 0); \
            o1 = __builtin_amdgcn_mfma_f32_32x32x16_bf16(__builtin_bit_cast(bf16x8, pw3), ATT_VF(1, 3), o1, 0, 0, 0); \
        } } while (0)
    const int NT = 4 * qb + 4, tmax = 4 * qb + (wid >> 1);
    ATT_ISSUE_K(0, 0); ATT_ISSUE_V(0, 0); ATT_ISSUE_K(1, 1);
    bf16x8 qr[6];
    { const bf16_t* qp = Q + (rowbase + q0 + wid * 32 + r32) * DQ + h * 96 + hi * 8;
#pragma unroll
      for (int d0 = 0; d0 < 6; ++d0) qr[d0] = *(const bf16x8*)(qp + d0 * 16); }
    float mref = 0.f, lrun = 0.f;
    f32x16 o0 = {}, o1 = {};
    f32x16 negm = {}; asm volatile("" : "+v"(negm));
    LAS float* wsf = (LAS float*)(F.lds + L_WS) + wid * 64;
    const int qabs = q0 + wid * 32 + r32;
    const LAS char* kfb = shm + L_K + hi * 1024 + r32 * 16;
    const LAS char* vfb = shm + L_V + ((lane >> 4) & 1) * 32 + (lane & 3) * 8 + (4 * hi + ((lane & 15) >> 2)) * 64;
    f32x16 pa0, pa1, pb0, pb1;
    if (wid >= 4) __builtin_amdgcn_s_setprio(1);
    ATT_WAIT_BAR();
    ATT_QKN(pa0, pa1, 0);
#pragma unroll 1
    for (int t = 0; t < NT; t += 2) {
        ATT_STEP(pa0, pa1, pb0, pb1, t);
        ATT_STEP(pb0, pb1, pa0, pa1, t + 1);
    }
    __builtin_amdgcn_s_setprio(0);
#undef ATT_STEP
#undef ATT_VF
#undef ATT_QKN
#undef ATT_THR
#undef MX3
    {
        const bf16_t* Z = (const bf16_t*)((const unsigned char*)kin(19) + WS_Z); bf16_t* Y = (bf16_t*)((unsigned char*)kin(19) + WS_Y);
        int lane_e = lane; asm volatile("" : "+v"(lane_e));
        const float lt = swapsum(lrun);
        if (hi == 0) wsf[r32] = 1.0f / lt;
        LDS_WAIT();
        LAS float* stg = (LAS float*)(F.lds + L_OST) + wid * 2048;
#pragma unroll
        for (int g4 = 0; g4 < 4; ++g4) { const f32x4 f = *(const LAS f32x4*)(wsf + 8 * g4 + 4 * hi);
#pragma unroll
            for (int j = 0; j < 4; ++j) { const int r = 4 * g4 + j, orow = crow(r, hi); stg[orow * 64 + r32] = o0[r] * f[j]; stg[orow * 64 + 32 + r32] = o1[r] * f[j]; } }
        LDS_WAIT();
        const size_t grow0 = (size_t)(rowbase + q0 + wid * 32);
        u32x4 gbq[4];
#pragma unroll
        for (int i = 0; i < 4; ++i) { const int row = i * 8 + (lane_e >> 3), ch = lane_e & 7; gbq[i] = *(const u32x4*)(Z + (grow0 + row) * ZW + Z_GB + 64 * h + 8 * ch); }
#pragma unroll
        for (int i = 0; i < 4; ++i) {
            const int row = i * 8 + (lane_e >> 3), ch = lane_e & 7;
            const f32x4 ov0 = *(const LAS f32x4*)(stg + row * 64 + ch * 8), ov1 = *(const LAS f32x4*)(stg + row * 64 + ch * 8 + 4);
            const u32x4 g = gbq[i];
            u32x4 w;
            w.x = pg8::cvt_pk_bf16(ov0[0] * siluf_(bflo(g.x)), ov0[1] * siluf_(bfhi(g.x))); w.y = pg8::cvt_pk_bf16(ov0[2] * siluf_(bflo(g.y)), ov0[3] * siluf_(bfhi(g.y)));
            w.z = pg8::cvt_pk_bf16(ov1[0] * siluf_(bflo(g.z)), ov1[1] * siluf_(bfhi(g.z))); w.w = pg8::cvt_pk_bf16(ov1[2] * siluf_(bflo(g.w)), ov1[3] * siluf_(bfhi(g.w)));
            *(u32x4*)(Y + (grow0 + row) * DM + 384 + 64 * h + 8 * ch) = w;
        }
        LDS_WAIT();
    }
#undef ATT_ISSUE_K
#undef ATT_ISSUE_V
}
}

__device__ __forceinline__ void phase_final(Frame& F) {
    const int gw = F.bid * NWAVES + F.wave, NGW = F.G * NWAVES, lane = F.lane;
    const ssum_t* ssx = (const ssum_t*)(F.ws + WS_ACC + OFF_SSX) + 4 * M; const float* g = kin(17);
    const bf16_t* XB = (const bf16_t*)(F.ws + WS_XB);
#pragma unroll 4
    for (int m = gw; m < M; m += NGW) {
        const u32x2* xr = (const u32x2*)(XB + (size_t)m * DM) + lane; f32x4* orow = (f32x4*)(F.out + (size_t)m * DM) + lane; const f32x4* gr = (const f32x4*)g + lane;
        const float rs = rsqrtf(ldfx(ssx + m) * (1.0f / 1024.0f) + EPS);
#pragma unroll
        for (int j = 0; j < 4; ++j) { const u32x2 w = xr[64 * j]; const f32x4 v = {bflo(w.x), bfhi(w.x), bflo(w.y), bfhi(w.y)}; __builtin_nontemporal_store(v * rs * gr[64 * j], &orow[64 * j]);   }
    }
}

#define XB_TMO      128
#define XB_XCNT(j)  (256  + 64 * (j))
#define XB_XSUB(j)  (1280 + 64 * (j))
#define XB_XGEN(j)  (2304 + 64 * (j))
#define XB_TOP      3328
#define XB_TOPGEN   3392
#define XCD_BAR_WORDS 3456
#define XB_SPIN_CAP (1u << 18)

__device__ __forceinline__ unsigned xb_ld(unsigned* p)              { return __hip_atomic_load(p, __ATOMIC_RELAXED, __HIP_MEMORY_SCOPE_AGENT); }
__device__ __forceinline__ unsigned xb_add(unsigned* p, unsigned v) { return __hip_atomic_fetch_add(p, v, __ATOMIC_RELAXED, __HIP_MEMORY_SCOPE_AGENT); }
__device__ __forceinline__ unsigned xb_xcc_id() { return (unsigned)__builtin_amdgcn_s_getreg((3 << 11) | 20) & 0xFu; }
#define XB_SPIN(cond, bar) do { unsigned _sp = 0; while (cond) { __builtin_amdgcn_s_sleep(1); \
    if ((++_sp & 255u) == 0u) { if (xb_ld(&(bar)[XB_TMO])) break; if (_sp > XB_SPIN_CAP) { atomicAdd(&(bar)[XB_TMO], 1u); break; } } } } while (0)

struct XcdBarrier {
    unsigned* bar; unsigned x;
    volatile LAS unsigned* st;
};

__device__ __forceinline__ XcdBarrier xcd_barrier_post(unsigned* bar, volatile LAS unsigned* st) {
    XcdBarrier b; b.bar = bar; b.x = xb_xcc_id(); b.st = st;
    if (threadIdx.x == 0) (void)xb_add(&bar[XB_XCNT(b.x)], 1u);
    return b;
}
__device__ __forceinline__ void xcd_barrier_complete(unsigned* bar, unsigned x, unsigned& nloc, unsigned& nx) {
    const unsigned G = gridDim.x * gridDim.y * gridDim.z;
    unsigned sum, cnt, mine, sp = 0u;
    for (;;) {
        sum = 0u; cnt = 0u; mine = 0u;
#pragma unroll
        for (unsigned j = 0; j < 16; ++j) { const unsigned c = xb_ld(&bar[XB_XCNT(j)]); sum += c; cnt += (c > 0u) ? 1u : 0u; mine = (j == x) ? c : mine; }
        if (sum == G) break;
        __builtin_amdgcn_s_sleep(1);
        if ((++sp & 255u) == 0u) { if (xb_ld(&bar[XB_TMO])) break; if (sp > XB_SPIN_CAP) { atomicAdd(&bar[XB_TMO], 1u); break; } }
    }
    nloc = mine > 0u ? mine : 1u; nx = cnt > 0u ? cnt : 1u;
}

__device__ __forceinline__ void xcd_barrier(const XcdBarrier& b) {
    asm volatile("s_waitcnt vmcnt(0)" ::: "memory");
    __syncthreads();
    if (threadIdx.x == 0) {
        unsigned* bar = b.bar;
        __builtin_amdgcn_s_waitcnt(0);
        unsigned nloc = b.st[0], nx = b.st[1];
        if (nloc == 0u) { xcd_barrier_complete(bar, b.x, nloc, nx); b.st[0] = nloc; b.st[1] = nx; }
        const unsigned old = xb_add(&bar[XB_XSUB(b.x)], 1u);
        const unsigned gen = old / nloc;
        if (old + 1u == (gen + 1u) * nloc) {
            __builtin_amdgcn_fence(__ATOMIC_RELEASE, "agent");
            asm volatile("s_waitcnt vmcnt(0)" ::: "memory");
            const unsigned og = xb_add(&bar[XB_TOP], 1u);
            const unsigned tg = og / nx;
            if (og + 1u == (tg + 1u) * nx) xb_add(&bar[XB_TOPGEN], 1u);
            else XB_SPIN(xb_ld(&bar[XB_TOPGEN]) == tg, bar);
            __builtin_amdgcn_fence(__ATOMIC_ACQUIRE, "agent");
            xb_add(&bar[XB_XGEN(b.x)], 1u);
            asm volatile("s_waitcnt vmcnt(0)" ::: "memory");
        } else {
            XB_SPIN(xb_ld(&bar[XB_XGEN(b.x)]) == gen, bar);
            __builtin_amdgcn_fence(__ATOMIC_ACQUIRE, "agent");
            asm volatile("s_waitcnt vmcnt(0)" ::: "memory");
        }
    }
    __syncthreads();
}

constexpr size_t OFF_BAR = 900 * 1024;
constexpr int LDS_BARST = 150016;
#define MK_FRAME() \
    Frame F; F.lds = (LAS unsigned char*)lds; \
    { int t_ = threadIdx.x; asm volatile("" : "+v"(t_)); F.tid = t_; } \
    F.lane = F.tid & 63; F.wave = __builtin_amdgcn_readfirstlane(F.tid >> 6); \
    F.bid = blockIdx.x; F.G = gridDim.x; F.out = (float*)kin(18); F.ws = (unsigned char*)kin(19); \
    unsigned char* ws = F.ws; (void)ws; \
    ssum_t* ssx = (ssum_t*)(ws + WS_ACC + OFF_SSX); ssum_t* ssq = (ssum_t*)(ws + WS_ACC + OFF_SSQ); ssum_t* sskv = (ssum_t*)(ws + WS_ACC + OFF_SSKV); (void)ssx; (void)ssq; (void)sskv; \
    const float* cosT = (const float*)(ws + WS_ROPE); const float* sinT = cosT + SEQ * 16; (void)cosT; (void)sinT;
#define MK_IN(k) (ph_lo <= (k) && (k) < ph_hi)
#define MK_SEAM(k) do { if ((k) + 1 < ph_hi) { if ((k) == 0 && ph_hi > 18) cg::this_grid().sync();   else { XcdBarrier xb_; xb_.bar = (unsigned*)(kin(19)) + OFF_BAR / 4; xb_.x = xb_xcc_id(); xb_.st = (volatile LAS unsigned*)((LAS unsigned char*)lds + LDS_BARST); xcd_barrier(xb_); } } } while (0)

template <int l> __device__ __forceinline__ void layer_phases(unsigned char* lds, int ph_lo, int ph_hi) {
    if (MK_IN(1 + 4 * l)) {
        MK_FRAME();
#if !defined(NO_GEMM) && !defined(NO_G1)
        pg8::Gemm g{(const pg8::bf16_t*)(ws + WS_XB), (const pg8::bf16_t*)(ws + WS_WIN) + (size_t)l * ZW * 1024, M, ZW, 1024, 1024, 1024};
        pg8::StaticOrder S; S.init(M, ZW, F.G, F.bid);
        EpiZ E{(bf16_t*)(ws + WS_Z), ssx + l * M, ssq + l * M, sskv + l * M};
        pg8::gemm_phase<EpiZ, pg8::StaticOrder, PG8_ALIGN, PG8_SP2>(F.lds, g, S, E);
#endif
        if (F.G == 256 && l + 1 < NL && F.bid >= 128) convert_layer_weights(F, l + 1, (F.bid - 128) * NWAVES + F.wave, 128 * NWAVES);
        MK_SEAM(1 + 4 * l);
    }
    if (MK_IN(2 + 4 * l)) for (int rep2_ = 0; rep2_ < P2_REPEAT; ++rep2_) {
        {
            MK_FRAME();
#if !defined(NO_GEMM) && !defined(NO_G2)
            pg8::Gemm g{(const pg8::bf16_t*)(ws + WS_Z) + Z_CQ, (const pg8::bf16_t*)(ws + WS_WUQ) + (size_t)l * 768 * 384, M, 768, 384, ZW, 384};
            pg8::StaticOrder S; S.init(M, 768, F.G, F.bid);
            EpiQ E{(bf16_t*)((unsigned char*)F.out + OUT_Q), ssq + l * M, cosT, sinT};
            pg8::gemm_phase<EpiQ, pg8::StaticOrder, PG8_ALIGN, PG8_SP2>(F.lds, g, S, E);
#endif
        }
        {
            MK_FRAME();
#if !defined(NO_GEMM) && !defined(NO_G3)
            pg8::Gemm g{(const pg8::bf16_t*)(ws + WS_Z) + Z_CKV, (const pg8::bf16_t*)(ws + WS_WUKV) + (size_t)l * 768 * 256, M, 768, 256, ZW, 256};
            pg8::StaticOrder S; S.init(M, 768, F.G, (F.bid + F.G / 2) % F.G);
            EpiKV E{(bf16_t*)(ws + WS_KV), sskv + l * M};
            pg8::gemm_phase<EpiKV, pg8::StaticOrder, PG8_ALIGN, PG8_SP2>(F.lds, g, S, E);
#endif
        }
        __syncthreads();
        {
            MK_FRAME();
#if !defined(NO_P2)
            for (int u = F.bid; u < 256; u += F.G) phase2_tile(F, l, u);
#endif
        }
        MK_SEAM(2 + 4 * l);
    }
    if (MK_IN(3 + 4 * l)) {
        MK_FRAME();
#ifndef ATT_REPEAT
#define ATT_REPEAT 1
#endif
        int i1 = F.bid;
        if (F.G == 256) { const int v = (F.bid & 7) * 32 + (F.bid >> 3); i1 = (v < 252) ? (v % 21) * 12 + v / 21 : v; }
        for (int rep = 0; rep < ATT_REPEAT; ++rep)
        for (int r = 0;; ++r) {
            int i;
            if (F.G == 256) { if (r >= 2 || (r == 1 && i1 < 128)) break; i = r ? 511 - i1 : i1; }
            else { if (r * F.G >= 384) break; i = (r & 1) ? r * F.G + (F.G - 1 - F.bid) : r * F.G + F.bid; }
#if !defined(NO_ATT)
            if (i < 384) att::attn_unit(F, (i % 12) / 6, (i % 12) % 6, 31 - i / 12);
#endif
        }
        __syncthreads();
        { const int hg = F.G / 2;
          if (i1 >= F.G - hg) for (int u = F.G - 1 - i1; u < 256; u += hg) lru_final_unit(F, u); }
        MK_SEAM(3 + 4 * l);
    }
    if (MK_IN(4 + 4 * l)) {
        MK_FRAME();
#if !defined(NO_GEMM) && !defined(NO_G4)
        pg8::Gemm g{(const pg8::bf16_t*)(ws + WS_Y), (const pg8::bf16_t*)(ws + WS_WOUT) + (size_t)l * 1024 * 1024, M, 1024, 1024, 1024, 1024};
        pg8::StaticOrder S; S.init(M, 1024, F.G, F.bid);
        EpiOut E{(bf16_t*)(ws + WS_XB), ssx + (l + 1) * M};
        pg8::gemm_phase<EpiOut, pg8::StaticOrder, PG8_ALIGN, PG8_SP2>(F.lds, g, S, E);
#endif
        MK_SEAM(4 + 4 * l);
    }
}

__global__ void __launch_bounds__(NTHREADS, 2) mk_fwd(Args args) {
    extern __shared__ __attribute__((aligned(16))) unsigned char lds[];
    const int ph_lo = *(__attribute__((address_space(4))) const int*)((__attribute__((address_space(4))) const char*)__builtin_amdgcn_kernarg_segment_ptr() + 160);
    const int ph_hi = *(__attribute__((address_space(4))) const int*)((__attribute__((address_space(4))) const char*)__builtin_amdgcn_kernarg_segment_ptr() + 164);
    if (threadIdx.x < 2) ((LAS unsigned*)((LAS unsigned char*)lds + LDS_BARST))[threadIdx.x] = 0u;
    __syncthreads();
    (void)xcd_barrier_post((unsigned*)(kin(19)) + OFF_BAR / 4, (volatile LAS unsigned*)((LAS unsigned char*)lds + LDS_BARST));
    if (MK_IN(0)) {
        MK_FRAME();
#if !defined(NO_PRO)
        phase_prologue(F);
#endif
        MK_SEAM(0);
    }
    layer_phases<0>(lds, ph_lo, ph_hi);
    layer_phases<1>(lds, ph_lo, ph_hi);
    layer_phases<2>(lds, ph_lo, ph_hi);
    layer_phases<3>(lds, ph_lo, ph_hi);
    if (MK_IN(17)) {
        MK_FRAME();
        phase_final(F);
    }
}

extern "C" void kernel_launch(void* const* d_in, const int* in_sizes, int n_in, void* d_out, int out_size, void* d_ws, size_t ws_size, hipStream_t stream) {
    static int grid = 0;
    if (grid == 0) {
        if (n_in != 18 || in_sizes[0] != M * DM || out_size != M * DM || ws_size < WS_END) { fprintf(stderr, "kernel_launch: unexpected shapes (n_in %d, in0 %d, out %d, ws %zu)\n", n_in, n_in > 0 ? in_sizes[0] : -1, out_size, ws_size); grid = -1; return; }
        int dev = 0, cus = 0, per_cu = 0;
        hipGetDevice(&dev); hipDeviceGetAttribute(&cus, hipDeviceAttributeMultiprocessorCount, dev);
        if (hipFuncSetAttribute((const void*)mk_fwd, hipFuncAttributeMaxDynamicSharedMemorySize, LDS_BYTES) != hipSuccess) { fprintf(stderr, "kernel_launch: hipFuncSetAttribute failed\n"); grid = -1; return; }
        if (hipOccupancyMaxActiveBlocksPerMultiprocessor(&per_cu, (const void*)mk_fwd, NTHREADS, LDS_BYTES) != hipSuccess || per_cu < 1) { fprintf(stderr, "kernel_launch: occupancy query says %d\n", per_cu); per_cu = 1; }
        (void)hipGetLastError();
        grid = cus;
        if (grid > 256) grid = 256;
    }
    if (grid < 0) return;
    hipMemsetAsync((char*)d_ws + WS_CTL, 0, CTL_ZERO_BYTES, stream);
    hipMemsetAsync((char*)d_ws + WS_ACC, 0, ACC_BYTES, stream);
    Args a{};
    for (int i = 0; i < 18; ++i) a.in[i] = (const float*)d_in[i];
    a.out = (float*)d_out; a.ws = (unsigned char*)d_ws;
#if MK_ONE_LAUNCH
    a.ph_lo = 0; a.ph_hi = 18;
    void* kargs[] = {&a};
    hipError_t e = hipLaunchCooperativeKernel((const void*)mk_fwd, dim3(grid), dim3(NTHREADS), kargs, LDS_BYTES, stream);
    if (e != hipSuccess) fprintf(stderr, "cooperative launch failed: %s (grid %d)\n", hipGetErrorString(e), grid);
#else
    for (int ph = 0; ph < 18; ++ph) {
        a.ph_lo = ph; a.ph_hi = ph + 1;
        hipLaunchKernelGGL(mk_fwd, dim3(grid), dim3(NTHREADS), LDS_BYTES, stream, a);
    }
#endif
}
```

```cpp
#include <hip/hip_runtime.h>
#include <hip/hip_cooperative_groups.h>
#include <cstdio>
#include <cstdint>
#include <cmath>
namespace cg = cooperative_groups;
namespace pg8 {
#define PG8_LAS __attribute__((address_space(3)))
typedef unsigned short bf16_t;
typedef short bf16x8 __attribute__((ext_vector_type(8)));
typedef float f32x4 __attribute__((ext_vector_type(4)));
typedef unsigned u32x4 __attribute__((ext_vector_type(4)));
constexpr int BM = 256, BK = 64, HALF = 128, HTB = HALF * BK * 2  , STAGE_BYTES = 8 * HTB, NXCD = 8, WGM = 8;

__host__ __device__ __forceinline__ int lds_byte(int r, int c) { const int st = (r >> 4) * 2 + (c >> 5), rr = r & 15, cc = c & 31, ob = rr * 64 + cc * 2; return st * 1024 + (ob ^ (((ob >> 9) & 1) << 5)); }
__host__ __device__ __forceinline__ void stage_rc(int b, int& R, int& C) { const int st = b / 1024, sb = b % 1024, swz = sb ^ (((sb >> 9) & 1) << 5); R = (st >> 1) * 16 + swz / 64; C = (st & 1) * 32 + (swz % 64) / 2; }
__host__ __device__ __forceinline__ int perm32(int rho) { const int n = rho >> 4, i = rho & 15; return 8 * (i >> 2) + 4 * n + (i & 3); }

struct Unit { int pm, pn; };
struct Gemm { const bf16_t* A; const bf16_t* Bt; int M, N, K, lda, ldb; };

struct StaticOrder {
    int nM, nN, nwg, G, c;
    __host__ __device__ void init(int M, int N, int G_, int c_) { nM = M / BM; nN = N / BM; nwg = nM * nN; G = G_; c = c_; }
    __host__ __device__ bool next(int i, Unit& u) const {
        const long L = (long)i * G + c; if (L >= nwg) return false;
        int wgid = (int)L; { const int q = nwg / NXCD, r = nwg % NXCD, xcd = wgid % NXCD, off = wgid / NXCD; wgid = (xcd < r ? xcd * (q + 1) : r * (q + 1) + (xcd - r) * q) + off; }
        const int nig = WGM * nN, gid = wgid / nig, fm = gid * WGM, gsz = (nM - fm) < WGM ? (nM - fm) : WGM;
        u.pm = fm + ((wgid % nig) % gsz); u.pn = (wgid % nig) / gsz; return true;
    }
    __device__ __forceinline__ void a_ready(const Unit&) const {}
    __device__ __forceinline__ void done(const Unit&) const {}
};

__device__ __forceinline__ unsigned cvt_pk_bf16(float lo, float hi) { unsigned r; asm volatile("v_cvt_pk_bf16_f32 %0, %1, %2" : "=v"(r) : "v"(lo), "v"(hi)); return r; }
typedef float f32x2 __attribute__((ext_vector_type(2)));
template <class Epi, class Sched, bool ALIGN_EPI, bool SP2>
__device__ __forceinline__ void gemm_phase(PG8_LAS unsigned char* lds, const Gemm g, const Sched& S, const Epi& E) {
    int tid_ = threadIdx.x; asm volatile("" : "+v"(tid_));
    const int tid = tid_, wid = __builtin_amdgcn_readfirstlane(tid >> 6), lane = tid & 63, wr = wid >> 2, wc = wid & 3, fr = lane & 15, fq = lane >> 4;
    const int K = g.K; int nt = K / BK; asm volatile("" : "+s"(nt));
    unsigned voffA[2], voffB[2];
#pragma unroll
    for (int i = 0; i < 2; ++i) { int R, C; stage_rc(tid * 16 + i * 8192, R, C); const int Rb = Epi::PERM ? ((R & ~31) + perm32(R & 31)) : R;
        voffA[i] = (unsigned)(R * g.lda + C) * 2u; voffB[i] = (unsigned)(Rb * g.ldb + C) * 2u; }
    const size_t kstep = (size_t)(BK * 2);
    const size_t hstepA = (size_t)HALF * g.lda * 2, hstepB = (size_t)HALF * g.ldb * 2;
    const size_t tstepA = 2 * hstepA, tstepB = 2 * hstepB;
    const unsigned ldsw = (unsigned)wid * 1024u;
    const int aoff = lds_byte(wr * 64 + fr, fq * 8), boff = lds_byte(wc * 32 + fr, fq * 8);
#define PG8_SA(b, h) (((b) * 2 + (h)) * HTB)
#define PG8_SB(b, h) ((4 + (b) * 2 + (h)) * HTB)
#define PG8_STAGE(bufoff, gbase, voff) do { _Pragma("unroll") for (int _i = 0; _i < 2; ++_i) \
        __builtin_amdgcn_global_load_lds((const unsigned*)((const char*)(gbase) + (voff)[_i]), (PG8_LAS unsigned*)(lds + (bufoff) + ldsw + _i * 8192), 16, 0, 0); } while (0)
#define PG8_LDA(dst, b, h) do { _Pragma("unroll") for (int m = 0; m < 4; ++m) _Pragma("unroll") for (int k = 0; k < 2; ++k) dst[m][k] = *(const PG8_LAS bf16x8*)(lds + PG8_SA(b, h) + aoff + m * 2048 + k * 1024); } while (0)
#define PG8_LDB(dst, b, h) do { _Pragma("unroll") for (int n = 0; n < 2; ++n) _Pragma("unroll") for (int k = 0; k < 2; ++k) dst[n][k] = *(const PG8_LAS bf16x8*)(lds + PG8_SB(b, h) + boff + n * 2048 + k * 1024); } while (0)
#define PG8_MMA(ai, bj, At, Bt) do { __builtin_amdgcn_s_setprio(1); _Pragma("unroll") for (int m = 0; m < 4; ++m) _Pragma("unroll") for (int n = 0; n < 2; ++n) _Pragma("unroll") for (int k = 0; k < 2; ++k) \
        acc[ai][bj][m][n] = __builtin_amdgcn_mfma_f32_16x16x32_bf16(Bt[n][k], At[m][k], acc[ai][bj][m][n], 0, 0, 0); __builtin_amdgcn_s_setprio(0); } while (0)
#define PG8_WAIT_V(n) asm volatile("s_waitcnt vmcnt(" #n ")" ::: "memory")
#define PG8_WAIT_L(n) asm volatile("s_waitcnt lgkmcnt(" #n ")" ::: "memory")
#define PG8_BAR __builtin_amdgcn_s_barrier()
#define PG8_SCHED __builtin_amdgcn_sched_barrier(0)
    Unit cur, nxt; int ui = 0;
    if (!S.next(0, cur)) return;
    f32x4 acc[2][2][4][2];
#pragma unroll
    for (int a = 0; a < 2; ++a)
#pragma unroll
        for (int b = 0; b < 2; ++b)
#pragma unroll
            for (int m = 0; m < 4; ++m)
#pragma unroll
                for (int n = 0; n < 2; ++n) acc[a][b][m][n] = (f32x4){0.f, 0.f, 0.f, 0.f};
    bf16x8 At[4][2], B0[2][2], B1[2][2];
    const char* cA = (const char*)g.A + (size_t)cur.pm * tstepA; const char* cB = (const char*)g.Bt + (size_t)cur.pn * tstepB;
    S.a_ready(cur);
    if constexpr (SP2) {
        PG8_STAGE(PG8_SB(0, 0), cB, voffB); PG8_STAGE(PG8_SB(0, 1), cB + hstepB, voffB); PG8_STAGE(PG8_SA(0, 0), cA, voffA); PG8_STAGE(PG8_SA(0, 1), cA + hstepA, voffA);
        if (wr == 1) PG8_BAR;
        PG8_WAIT_V(2); PG8_BAR;
        PG8_STAGE(PG8_SB(1, 0), cB + kstep, voffB); PG8_STAGE(PG8_SA(1, 0), cA + kstep, voffA); PG8_STAGE(PG8_SB(1, 1), cB + hstepB + kstep, voffB);
        PG8_WAIT_V(6); PG8_BAR;
    } else {
        PG8_STAGE(PG8_SB(0, 0), cB, voffB); PG8_STAGE(PG8_SA(0, 0), cA, voffA); PG8_STAGE(PG8_SB(0, 1), cB + hstepB, voffB); PG8_STAGE(PG8_SA(0, 1), cA + hstepA, voffA);
        if (wr == 1) PG8_BAR;
        PG8_WAIT_V(4); PG8_BAR;
        PG8_STAGE(PG8_SB(1, 0), cB + kstep, voffB); PG8_STAGE(PG8_SA(1, 0), cA + kstep, voffA); PG8_STAGE(PG8_SB(1, 1), cB + hstepB + kstep, voffB);
        PG8_WAIT_V(6); PG8_BAR;
    }
    for (;;) {
        const bool has_next = S.next(ui + 1, nxt);
        const char* nA = has_next ? (const char*)g.A + (size_t)nxt.pm * tstepA : cA; const char* nB = has_next ? (const char*)g.Bt + (size_t)nxt.pn * tstepB : cB;
        for (int t = 0; t < nt; t += 2) {
            const bool last = (t == nt - 2);
            const char* a1 = cA + (size_t)(t + 1) * kstep;
            const char* a2 = last ? nA : cA + (size_t)(t + 2) * kstep; const char* b2 = last ? nB : cB + (size_t)(t + 2) * kstep;
            const char* a3 = a2 + kstep; const char* b3 = b2 + kstep;
            if (last && has_next) S.a_ready(nxt);
            if constexpr (SP2) {
            PG8_LDB(B0, 0, 0); PG8_LDB(B1, 0, 1); PG8_SCHED; PG8_LDA(At, 0, 0); PG8_STAGE(PG8_SA(1, 1), a1 + hstepA, voffA);
            PG8_WAIT_V(8); PG8_WAIT_L(0); PG8_BAR; PG8_MMA(0, 0, At, B0); PG8_MMA(0, 1, At, B1); PG8_BAR; PG8_SCHED;
            PG8_LDA(At, 0, 1); PG8_STAGE(PG8_SB(0, 0), b2, voffB); PG8_STAGE(PG8_SB(0, 1), b2 + hstepB, voffB); PG8_STAGE(PG8_SA(0, 0), a2, voffA);
            PG8_WAIT_V(8); PG8_WAIT_L(0); PG8_BAR; PG8_MMA(1, 0, At, B0); PG8_MMA(1, 1, At, B1); PG8_BAR; PG8_SCHED;
            PG8_LDB(B0, 1, 0); PG8_LDB(B1, 1, 1); PG8_SCHED; PG8_LDA(At, 1, 0); PG8_STAGE(PG8_SA(0, 1), a2 + hstepA, voffA);
            PG8_WAIT_V(8); PG8_WAIT_L(0); PG8_BAR; PG8_MMA(0, 0, At, B0); PG8_MMA(0, 1, At, B1); PG8_BAR; PG8_SCHED;
            PG8_LDA(At, 1, 1); PG8_STAGE(PG8_SB(1, 0), b3, voffB); PG8_STAGE(PG8_SB(1, 1), b3 + hstepB, voffB); PG8_STAGE(PG8_SA(1, 0), a3, voffA);
            PG8_WAIT_V(8); PG8_WAIT_L(0); PG8_BAR; PG8_MMA(1, 0, At, B0); PG8_MMA(1, 1, At, B1); PG8_BAR; PG8_SCHED;
            } else {
            PG8_LDB(B0, 0, 0); PG8_SCHED; PG8_LDA(At, 0, 0); PG8_STAGE(PG8_SA(1, 1), a1 + hstepA, voffA);
            PG8_WAIT_L(8); PG8_BAR; PG8_WAIT_L(0); PG8_MMA(0, 0, At, B0); PG8_BAR; PG8_SCHED;
            PG8_LDB(B1, 0, 1); PG8_STAGE(PG8_SB(0, 0), b2, voffB);
            PG8_BAR; PG8_WAIT_L(0); PG8_MMA(0, 1, At, B1); PG8_BAR;
            PG8_LDA(At, 0, 1); PG8_STAGE(PG8_SA(0, 0), a2, voffA);
            PG8_BAR; PG8_WAIT_L(0); PG8_MMA(1, 0, At, B0); PG8_BAR; PG8_SCHED;
            PG8_STAGE(PG8_SB(0, 1), b2 + hstepB, voffB);
            PG8_WAIT_V(6); PG8_BAR; PG8_MMA(1, 1, At, B1); PG8_BAR;
            PG8_LDB(B0, 1, 0); PG8_SCHED; PG8_LDA(At, 1, 0); PG8_STAGE(PG8_SA(0, 1), a2 + hstepA, voffA);
            PG8_WAIT_L(8); PG8_BAR; PG8_WAIT_L(0); PG8_MMA(0, 0, At, B0); PG8_BAR; PG8_SCHED;
            PG8_LDB(B1, 1, 1); PG8_STAGE(PG8_SB(1, 0), b3, voffB);
            PG8_BAR; PG8_WAIT_L(0); PG8_MMA(0, 1, At, B1); PG8_BAR;
            PG8_LDA(At, 1, 1); PG8_STAGE(PG8_SA(1, 0), a3, voffA);
            PG8_BAR; PG8_WAIT_L(0); PG8_MMA(1, 0, At, B0); PG8_BAR; PG8_SCHED;
            PG8_STAGE(PG8_SB(1, 1), b3 + hstepB, voffB);
            PG8_WAIT_V(6); PG8_BAR; PG8_MMA(1, 1, At, B1); PG8_BAR;
            }
        }
        if constexpr (ALIGN_EPI) { if (wr == 0) PG8_BAR; }
        if constexpr (!Epi::AFTER_DRAIN) { E(acc, cur, wr, wc, fr, fq); S.done(cur); }
        if (!has_next) break;
#pragma unroll
        for (int a = 0; a < 2; ++a)
#pragma unroll
            for (int b = 0; b < 2; ++b)
#pragma unroll
                for (int m = 0; m < 4; ++m)
#pragma unroll
                    for (int n = 0; n < 2; ++n) acc[a][b][m][n] = (f32x4){0.f, 0.f, 0.f, 0.f};
        cur = nxt; cA = nA; cB = nB; ++ui;
        if constexpr (ALIGN_EPI) { if (wr == 1) PG8_BAR; }
    }
    PG8_WAIT_V(0);
    if constexpr (!ALIGN_EPI) { if (wr == 0) PG8_BAR; }
    PG8_BAR;
    if constexpr (Epi::AFTER_DRAIN) { E.fused(acc, cur, wr, wc, fr, fq, lds, wid, lane); S.done(cur); }
#undef PG8_SA
#undef PG8_SB
#undef PG8_STAGE
#undef PG8_LDA
#undef PG8_LDB
#undef PG8_MMA
#undef PG8_WAIT_V
#undef PG8_WAIT_L
#undef PG8_BAR
#undef PG8_SCHED
}
}

#ifndef PG8_SP2
#define PG8_SP2 true
#endif
#ifndef PG8_ALIGN
#define PG8_ALIGN true
#endif
#ifndef P2_REPEAT
#define P2_REPEAT 1
#endif
#ifndef MK_ONE_LAUNCH
#define MK_ONE_LAUNCH 1
#endif

#define LAS __attribute__((address_space(3)))
typedef unsigned short bf16_t;
typedef short bf16x8 __attribute__((ext_vector_type(8)));
typedef short s16x4 __attribute__((ext_vector_type(4)));
typedef float f32x4 __attribute__((ext_vector_type(4)));
typedef float f32x2 __attribute__((ext_vector_type(2)));
typedef float f32x16 __attribute__((ext_vector_type(16)));
typedef unsigned u32x4 __attribute__((ext_vector_type(4)));
typedef unsigned u32x2 __attribute__((ext_vector_type(2)));

constexpr int NB = 2, SEQ = 8192, M = NB * SEQ, DM = 1024, NL = 4;
constexpr int ZW = 2560, DQ = 576, DKV = 768, DLRU = 384, DPOOL = 256;
constexpr int Z_ZA = 0, Z_GA = 384, Z_CQ = 768, Z_CKV = 1152, Z_KR = 1408, Z_GB = 1440, Z_ZC = 1824, Z_GC = 2080, D_IN = 2336;
constexpr float EPS = 1e-6f;
constexpr float QSCALE = 0.10206207261596577f * 1.4426950408889634f;
constexpr int NWAVES = 8, NTHREADS = 512;
constexpr int LDS_BYTES = 155648;

constexpr size_t MiB = 1u << 20;
constexpr size_t WS_CTL = 0, CTL_ZERO_BYTES = 1 * MiB;
typedef unsigned long long ssum_t;
constexpr size_t WS_ACC = 254 * MiB;
constexpr size_t OFF_SSX = 0, OFF_SSQ = (size_t)5 * 16384 * 8, OFF_SSKV = (size_t)9 * 16384 * 8, ACC_BYTES = (size_t)13 * 16384 * 8;
constexpr size_t WS_ROPE = 1 * MiB;
constexpr size_t WS_CHS = 2 * MiB;
constexpr size_t WS_SMALL = 3 * MiB;
constexpr size_t WS_WIN = 4 * MiB, WS_WOUT = 24 * MiB, WS_WUQ = 32 * MiB, WS_WUKV = 35 * MiB;
constexpr size_t WS_XB = 38 * MiB;
constexpr size_t OUT_Q = 0, OUT_KR = 20 * MiB;
constexpr size_t WS_Z = 70 * MiB, WS_KV = 150 * MiB, WS_A32 = 174 * MiB, WS_U32 = 198 * MiB, WS_Y = 222 * MiB, WS_END = 256 * MiB;

struct Args { const float* in[18]; float* out; unsigned char* ws; int ph_lo, ph_hi; };

struct Frame {
    LAS unsigned char* lds;
    int tid, lane, wave, bid, G;
    float* out; unsigned char* ws;
};
typedef __attribute__((address_space(1))) const float* gfp_t;
__device__ __forceinline__ const float* kin(int i) {
    __attribute__((address_space(4))) const char* k = (__attribute__((address_space(4))) const char*)__builtin_amdgcn_kernarg_segment_ptr();
    asm volatile("" : "+s"(k));
    gfp_t p_ = *(__attribute__((address_space(4))) const gfp_t*)(k + 8 * i);
    return (const float*)p_; }

__device__ __forceinline__ unsigned f2bf(float f) { unsigned u = __builtin_bit_cast(unsigned, f); return (u + 0x7fffu + ((u >> 16) & 1u)) >> 16; }
__device__ __forceinline__ unsigned pk2(float lo, float hi) { return f2bf(lo) | (f2bf(hi) << 16); }
__device__ __forceinline__ float bf2f(unsigned short b) { return __builtin_bit_cast(float, (unsigned)b << 16); }
__device__ __forceinline__ float bflo(unsigned w) { return __builtin_bit_cast(float, w << 16); }
__device__ __forceinline__ float bfhi(unsigned w) { return __builtin_bit_cast(float, w & 0xffff0000u); }
__device__ __forceinline__ float sigmoidf_(float x) { return 1.0f / (1.0f + __expf(-x)); }
__device__ __forceinline__ float siluf_(float x) { return x * __builtin_amdgcn_rcpf(1.0f + __expf(-x)); }
__device__ __forceinline__ float wave_sum(float v) {
#pragma unroll
    for (int o = 1; o < 64; o <<= 1) v += __shfl_xor(v, o);
    return v;
}
__device__ __forceinline__ void atomic_addf(ssum_t* p, float v) { (void)__hip_atomic_fetch_add(p, (ssum_t)(v * 16777216.0f), __ATOMIC_RELAXED, __HIP_MEMORY_SCOPE_AGENT); }
__device__ __forceinline__ float ldfx(const ssum_t* p) { return (float)(*p) * (1.0f / 16777216.0f); }
#define LDS_WAIT() asm volatile("s_waitcnt lgkmcnt(0)" ::: "memory")
__device__ __forceinline__ float fast_sigmoid(float x) { return __builtin_amdgcn_rcpf(1.0f + __expf(-x)); }
__device__ __forceinline__ float neg_expm1(float x) {
    const float ser = -x * (1.0f + x * (0.5f + x * (0.16666667f + x * (0.041666668f + x * 0.0083333338f))));
    const float dir = 1.0f - __expf(x);
    return (x > -0.25f) ? ser : dir;
}

struct EpiZ {
    static constexpr bool PERM = true, AFTER_DRAIN = false;
    bf16_t* Zb; const ssum_t* ssx; ssum_t* ssq; ssum_t* sskv;
    __device__ __forceinline__ void operator()(const pg8::f32x4 (&acc)[2][2][4][2], const pg8::Unit& u, int wr, int wc, int fr, int fq) const {
        const int row0 = u.pm * 256 + wr * 64 + fr, col0 = u.pn * 256 + wc * 32 + 8 * fq;
#pragma unroll
        for (int ai = 0; ai < 2; ++ai)
#pragma unroll
            for (int m = 0; m < 4; ++m) {
                const int row = row0 + ai * 128 + m * 16;
                const float rs = rsqrtf(ldfx(ssx + row) * (1.0f / 1024.0f) + EPS);
#pragma unroll
                for (int bj = 0; bj < 2; ++bj) {
                    const f32x4 v0 = acc[ai][bj][m][0] * rs, v1 = acc[ai][bj][m][1] * rs;
                    u32x4 w; w.x = pg8::cvt_pk_bf16(v0[0], v0[1]); w.y = pg8::cvt_pk_bf16(v0[2], v0[3]); w.z = pg8::cvt_pk_bf16(v1[0], v1[1]); w.w = pg8::cvt_pk_bf16(v1[2], v1[3]);
                    if (u.pn * 256 + bj * 128 + wc * 32 < D_IN) *(u32x4*)(Zb + (size_t)row * ZW + col0 + bj * 128) = w;
                    const int ht = u.pn * 2 + bj;
                    if (ht >= 6 && ht <= 10) {
                        float s = (v0[0] * v0[0] + v0[1] * v0[1]) + (v0[2] * v0[2] + v0[3] * v0[3]) + (v1[0] * v1[0] + v1[1] * v1[1]) + (v1[2] * v1[2] + v1[3] * v1[3]);
                        s += __shfl_xor(s, 16); s += __shfl_xor(s, 32);
                        if (fq == 0) atomic_addf((ht <= 8 ? ssq : sskv) + row, s);
                    }
                }
                asm volatile("" ::: "memory");
            }
    }
};
struct EpiQ {
    static constexpr bool PERM = true, AFTER_DRAIN = false;
    bf16_t* Qb; const ssum_t* ssq; const float* cosT; const float* sinT;
    __device__ __forceinline__ void operator()(const pg8::f32x4 (&acc)[2][2][4][2], const pg8::Unit& u, int wr, int wc, int fr, int fq) const {
        const int row0 = u.pm * 256 + wr * 64 + fr;
#pragma unroll
        for (int bj = 0; bj < 2; ++bj) {
            const int cg0 = u.pn * 256 + bj * 128 + wc * 32;
            if (cg0 >= DQ) continue;
            const bool rope = ((cg0 >> 5) % 3) == 2;
#pragma unroll
            for (int ai = 0; ai < 2; ++ai)
#pragma unroll
                for (int m = 0; m < 4; ++m) {
                    const int row = row0 + ai * 128 + m * 16;
                    const float rs = rsqrtf(ldfx(ssq + row) * (1.0f / 384.0f) + EPS) * QSCALE;
                    f32x4 v0 = acc[ai][bj][m][0] * rs, v1 = acc[ai][bj][m][1] * rs;
                    if (rope) {
                        const int pos = row & (SEQ - 1);
                        const f32x4 c0 = *(const f32x4*)(cosT + pos * 16 + 8 * (fq & 1)), c1 = *(const f32x4*)(cosT + pos * 16 + 8 * (fq & 1) + 4);
                        const f32x4 s0 = *(const f32x4*)(sinT + pos * 16 + 8 * (fq & 1)), s1 = *(const f32x4*)(sinT + pos * 16 + 8 * (fq & 1) + 4);
                        const float sg = (fq < 2) ? -1.0f : 1.0f;
                        f32x4 p0, p1;
#pragma unroll
                        for (int j = 0; j < 4; ++j) { p0[j] = __shfl_xor(v0[j], 32); p1[j] = __shfl_xor(v1[j], 32); }
                        v0 = v0 * c0 + (p0 * s0) * sg; v1 = v1 * c1 + (p1 * s1) * sg;
                    }
                    u32x4 w; w.x = pg8::cvt_pk_bf16(v0[0], v0[1]); w.y = pg8::cvt_pk_bf16(v0[2], v0[3]); w.z = pg8::cvt_pk_bf16(v1[0], v1[1]); w.w = pg8::cvt_pk_bf16(v1[2], v1[3]);
                    *(u32x4*)(Qb + (size_t)row * DQ + cg0 + 8 * fq) = w;
                    asm volatile("" ::: "memory");
                }
        }
    }
};
struct EpiKV {
    static constexpr bool PERM = true, AFTER_DRAIN = false;
    bf16_t* KVb; const ssum_t* sskv;
    __device__ __forceinline__ void operator()(const pg8::f32x4 (&acc)[2][2][4][2], const pg8::Unit& u, int wr, int wc, int fr, int fq) const {
        const int row0 = u.pm * 256 + wr * 64 + fr, col0 = u.pn * 256 + wc * 32 + 8 * fq;
#pragma unroll
        for (int ai = 0; ai < 2; ++ai)
#pragma unroll
            for (int m = 0; m < 4; ++m) {
                const int row = row0 + ai * 128 + m * 16;
                const float rs = rsqrtf(ldfx(sskv + row) * (1.0f / 256.0f) + EPS);
#pragma unroll
                for (int bj = 0; bj < 2; ++bj) {
                    const f32x4 v0 = acc[ai][bj][m][0] * rs, v1 = acc[ai][bj][m][1] * rs;
                    u32x4 w; w.x = pg8::cvt_pk_bf16(v0[0], v0[1]); w.y = pg8::cvt_pk_bf16(v0[2], v0[3]); w.z = pg8::cvt_pk_bf16(v1[0], v1[1]); w.w = pg8::cvt_pk_bf16(v1[2], v1[3]);
                    *(u32x4*)(KVb + (size_t)row * DKV + col0 + bj * 128) = w;
                }
                asm volatile("" ::: "memory");
            }
    }
};
struct EpiOut {
    static constexpr bool PERM = true, AFTER_DRAIN = false;
    bf16_t* XB; ssum_t* ssn;
    __device__ __forceinline__ void operator()(const pg8::f32x4 (&acc)[2][2][4][2], const pg8::Unit& u, int wr, int wc, int fr, int fq) const {
        const int row0 = u.pm * 256 + wr * 64 + fr, col0 = u.pn * 256 + wc * 32 + 8 * fq;
#pragma unroll
        for (int ai = 0; ai < 2; ++ai)
#pragma unroll
            for (int m = 0; m < 4; ++m) {
                const int row = row0 + ai * 128 + m * 16;
                float s = 0.f;
#pragma unroll
                for (int bj = 0; bj < 2; ++bj) {
                    const size_t off = (size_t)row * DM + col0 + bj * 128;
                    const u32x4 xw = *(const u32x4*)(XB + off);
                    const f32x4 v0 = (f32x4){bflo(xw.x), bfhi(xw.x), bflo(xw.y), bfhi(xw.y)} + acc[ai][bj][m][0], v1 = (f32x4){bflo(xw.z), bfhi(xw.z), bflo(xw.w), bfhi(xw.w)} + acc[ai][bj][m][1];
                    u32x4 w; w.x = pg8::cvt_pk_bf16(v0[0], v0[1]); w.y = pg8::cvt_pk_bf16(v0[2], v0[3]); w.z = pg8::cvt_pk_bf16(v1[0], v1[1]); w.w = pg8::cvt_pk_bf16(v1[2], v1[3]);
                    *(u32x4*)(XB + off) = w;
                    s += (v0[0] * v0[0] + v0[1] * v0[1]) + (v0[2] * v0[2] + v0[3] * v0[3]) + (v1[0] * v1[0] + v1[1] * v1[1]) + (v1[2] * v1[2] + v1[3] * v1[3]);
                }
                s += __shfl_xor(s, 16); s += __shfl_xor(s, 32);
                if (fq == 0) atomic_addf(ssn + row, s);
                asm volatile("" ::: "memory");
            }
    }
};

struct EpiAll {
    static constexpr bool PERM = true, AFTER_DRAIN = false;
    int mode; void* a; void* b; void* c; void* d;
    __device__ __forceinline__ void operator()(const pg8::f32x4 (&acc)[2][2][4][2], const pg8::Unit& u, int wr, int wc, int fr, int fq) const {
#ifdef ONLY_MODE
        if (mode != ONLY_MODE) return;
#endif
        if (mode == 0) { EpiZ E{(bf16_t*)a, (const ssum_t*)b, (ssum_t*)c, (ssum_t*)d}; E(acc, u, wr, wc, fr, fq); }
        else if (mode == 1) { EpiQ E{(bf16_t*)a, (const ssum_t*)b, (const float*)c, (const float*)d}; E(acc, u, wr, wc, fr, fq); }
        else if (mode == 2) { EpiKV E{(bf16_t*)a, (const ssum_t*)b}; E(acc, u, wr, wc, fr, fq); }
        else { EpiOut E{(bf16_t*)c, (ssum_t*)d}; E(acc, u, wr, wc, fr, fq); }
    }
};

__device__ __forceinline__ void p0_transpose_item(const float* W, int N, const float* g, bf16_t* WT, int ldt, LAS float* scr, int item, int lane) {
    const int nblk = N / 32, kb = item / nblk, nb = item % nblk, k0 = 64 * kb, n0 = 32 * nb;
#pragma unroll 8
    for (int i = 0; i < 32; ++i) { const int kk = 2 * i + (lane >> 5); float v = __builtin_nontemporal_load(&W[(size_t)(k0 + kk) * N + n0 + (lane & 31)]); if (g) v *= g[k0 + kk]; scr[kk * 33 + (lane & 31)] = v; }
    LDS_WAIT(); asm volatile("" ::: "memory");
    const int c = lane & 7;
#pragma unroll
    for (int j = 0; j < 4; ++j) { const int n = (lane >> 3) + 8 * j; const LAS float* s = scr + (8 * c) * 33 + n;
        u32x4 o; o.x = pk2(s[0 * 33], s[1 * 33]); o.y = pk2(s[2 * 33], s[3 * 33]); o.z = pk2(s[4 * 33], s[5 * 33]); o.w = pk2(s[6 * 33], s[7 * 33]);
        *(u32x4*)(WT + (size_t)(n0 + n) * ldt + k0 + 8 * c) = o; }
    LDS_WAIT(); asm volatile("" ::: "memory");
}
__device__ __forceinline__ void convert_layer_weights(Frame& F, int l, int gw, int NGW) {
    LAS float* scr = (LAS float*)(F.lds + F.wave * 16384);
    const int lane = F.lane;
    unsigned char* ws = F.ws;
    constexpr int I_IN = 16 * 73, I_OUT = 16 * 32, I_UQ = 6 * 18, I_UKV = 4 * 24, I_G = 12, I_P = 8;
    constexpr int I_L = I_IN + I_OUT + I_UQ + I_UKV + 2 * I_G + I_P;
    for (int it = gw; it < I_L; it += NGW) {
        int r = it;
        if (r < I_IN) { p0_transpose_item(kin(2) + (size_t)l * 1024 * D_IN, D_IN, kin(1) + l * 1024, (bf16_t*)(ws + WS_WIN) + (size_t)l * ZW * 1024, 1024, scr, r, lane); continue; } r -= I_IN;
        if (r < I_OUT) { p0_transpose_item(kin(16) + (size_t)l * 1024 * 1024, 1024, nullptr, (bf16_t*)(ws + WS_WOUT) + (size_t)l * 1024 * 1024, 1024, scr, r, lane); continue; } r -= I_OUT;
        if (r < I_UQ) { p0_transpose_item(kin(11) + (size_t)l * 384 * DQ, DQ, kin(10) + l * 384, (bf16_t*)(ws + WS_WUQ) + (size_t)l * 768 * 384, 384, scr, r, lane); continue; } r -= I_UQ;
        if (r < I_UKV) { p0_transpose_item(kin(13) + (size_t)l * 256 * DKV, DKV, kin(12) + l * 256, (bf16_t*)(ws + WS_WUKV) + (size_t)l * 768 * 256, 256, scr, r, lane); continue; } r -= I_UKV;
        if (r < I_G) { const int h = r >> 1; p0_transpose_item(kin(5) + (size_t)(l * 6 + h) * 4096, 64, nullptr, (bf16_t*)(ws + WS_SMALL) + (size_t)(l * 6 + h) * 4096, 64, scr, r & 1, lane); continue; } r -= I_G;
        if (r < I_G) { const int h = r >> 1; p0_transpose_item(kin(7) + (size_t)(l * 6 + h) * 4096, 64, nullptr, (bf16_t*)(ws + WS_SMALL + 196608) + (size_t)(l * 6 + h) * 4096, 64, scr, r & 1, lane); continue; } r -= I_G;
        { const int gq = r >> 1; p0_transpose_item(kin(14) + (size_t)(l * 4 + gq) * 4096, 64, nullptr, (bf16_t*)(ws + WS_SMALL + 393216) + (size_t)(l * 4 + gq) * 4096, 64, scr, r & 1, lane); }
    }
}
__device__ __forceinline__ void phase_prologue(Frame& F) {
    const int gw = F.bid * NWAVES + F.wave, NGW = F.G * NWAVES, lane = F.lane;
    unsigned char* ws = F.ws;
    convert_layer_weights(F, 0, gw, NGW);
    if (F.G != 256) { for (int l = 1; l < NL; ++l) convert_layer_weights(F, l, gw, NGW); }
    {
        const int gt = F.bid * NTHREADS + F.tid, NGT = F.G * NTHREADS;
        constexpr int ZIN = 224 * 1024 * 2 / 16, ZUQ = 192 * 384 * 2 / 16;
        for (int i = gt; i < NL * (ZIN + ZUQ); i += NGT) {
            const int l = i / (ZIN + ZUQ), r = i % (ZIN + ZUQ);
            u32x4* p = (r < ZIN) ? (u32x4*)(ws + WS_WIN + ((size_t)l * ZW + D_IN) * 1024 * 2) + r : (u32x4*)(ws + WS_WUQ + ((size_t)l * 768 + DQ) * 384 * 2) + (r - ZIN);
            *p = (u32x4){0u, 0u, 0u, 0u};
        }
        float* SP = (float*)(ws + WS_SMALL + 524288);
        for (int i = gt; i < NL * DLRU; i += NGT) SP[i] = log1pf(expf(-kin(9)[i]));
        float* cosT = (float*)(ws + WS_ROPE); float* sinT = cosT + SEQ * 16;
        for (int i = gt; i < SEQ * 16; i += NGT) {
            const int pos = i >> 4, fi = i & 15, j = fi & 3, k = fi >> 2;
            double inv = (j == 0) ? 1.0 : (j == 1) ? 0.56234132519034908 : (j == 2) ? 0.31622776601683794 : 0.17782794100389228;
            inv *= (k == 0) ? 1.0 : (k == 1) ? 0.1 : (k == 2) ? 0.01 : 0.001;
            const double ang = (double)pos * inv;
            const double n = __builtin_rint(ang * 0.15915494309189535);
            double rr = __builtin_fma(-n, 6.283185307179586, ang); rr = __builtin_fma(-n, 2.4492935982947064e-16, rr);
            const double r2 = rr * rr; double tc = 1.0, sc = 1.0, tsn = rr, ss = rr;
#pragma unroll 1
            for (int q = 1; q <= 15; ++q) { tc *= -r2 / (double)((2 * q - 1) * (2 * q)); sc += tc; tsn *= -r2 / (double)((2 * q) * (2 * q + 1)); ss += tsn; }
            cosT[i] = (float)sc; sinT[i] = (float)ss;
        }
    }
    {
        const float* x = kin(0); bf16_t* XB = (bf16_t*)(ws + WS_XB); ssum_t* ssx = (ssum_t*)(ws + WS_ACC + OFF_SSX);
#pragma unroll 4
        for (int m = gw; m < M; m += NGW) {
            const f32x4* xr = (const f32x4*)(x + (size_t)m * DM) + lane; u32x2* o = (u32x2*)(XB + (size_t)m * DM) + lane;
            float s = 0.f;
#pragma unroll
            for (int j = 0; j < 4; ++j) { const f32x4 v = __builtin_nontemporal_load(&xr[64 * j]);   s += (v.x * v.x + v.y * v.y) + (v.z * v.z + v.w * v.w); o[64 * j] = (u32x2){pk2(v.x, v.y), pk2(v.z, v.w)}; }
            s = wave_sum(s);
            if (lane == 0) ssx[m] = (ssum_t)(s * 16777216.0f);
        }
    }
}

__device__ __forceinline__ bf16x8 ld_x_frag(const LAS float* p) {
    const f32x4 a = *(const LAS f32x4*)p, b = *(const LAS f32x4*)(p + 4);
    u32x4 w; w.x = pg8::cvt_pk_bf16(a[0], a[1]); w.y = pg8::cvt_pk_bf16(a[2], a[3]); w.z = pg8::cvt_pk_bf16(b[0], b[1]); w.w = pg8::cvt_pk_bf16(b[2], b[3]);
    return __builtin_bit_cast(bf16x8, w);
}
constexpr int XAP16 = 392, PLP16 = 264;
constexpr int L2_LA = 64 * XAP16 * 2, L2_UU = L2_LA + 64 * DLRU * 2, L2_END = L2_UU + 64 * DLRU * 2;
static_assert(L2_END <= 150016, "phase-2 LDS map (below the barrier's LDS words)");
template <int W> __device__ __forceinline__ void pool_rows(const float (&c0)[31], const float (&c1)[31], const float (&v0)[31], const float (&v1)[31], int tpos0, LAS bf16_t* dst) {
#pragma unroll
    for (int j = 0; j < 16; ++j) {
        const int idx = 15 + j; const int tp = tpos0 + j;
        float s0 = c0[idx], s1 = c1[idx];
        if (idx - W >= 0) { s0 -= c0[idx - W >= 0 ? idx - W : 0]; s1 -= c1[idx - W >= 0 ? idx - W : 0]; }
        const float rc = __builtin_amdgcn_rcpf((float)((tp + 1 < W) ? tp + 1 : W));
        *(LAS unsigned*)(dst + j * PLP16) = pg8::cvt_pk_bf16(s0 * rc - v0[idx], s1 * rc - v1[idx]);
    }
}
__device__ __forceinline__ void phase2_tile(Frame& F, int l, int u) {
    const int tid = F.tid, lane = F.lane, wave = F.wave;
    unsigned char* ws = F.ws;
    const bf16_t* Z = (const bf16_t*)(ws + WS_Z);
    const int row0 = u * 64, t0 = (u & 127) * 64;
    LAS bf16_t* XA = (LAS bf16_t*)F.lds;
    LAS bf16_t* LA = (LAS bf16_t*)(F.lds + L2_LA); LAS bf16_t* UU = (LAS bf16_t*)(F.lds + L2_UU);
    bf16_t* A16 = (bf16_t*)(ws + WS_A32); bf16_t* U16 = (bf16_t*)(ws + WS_U32);
    if (tid < 384) {
        const int p = tid % 192, half = tid / 192, c = 2 * p;
        const float* cw = kin(3) + (size_t)l * 4 * DLRU; const float* cb = kin(4) + (size_t)l * DLRU;
        const f32x2 w0 = *(const f32x2*)(cw + c), w1 = *(const f32x2*)(cw + DLRU + c), w2 = *(const f32x2*)(cw + 2 * DLRU + c), w3 = *(const f32x2*)(cw + 3 * DLRU + c), bb = *(const f32x2*)(cb + c);
        const int ts = t0 + 32 * half;
        const bf16_t* zp = Z + (size_t)(row0 + 32 * half) * ZW + Z_ZA + c;
        unsigned zr[35];
#pragma unroll
        for (int j = 0; j < 35; ++j) { zr[j] = 0u; if (j >= 3 || ts >= 3) zr[j] = *(const unsigned*)(zp + (ptrdiff_t)(j - 3) * ZW); }
#pragma unroll
        for (int j = 0; j < 32; ++j) {
            const f32x2 x0 = {bflo(zr[j]), bfhi(zr[j])}, x1 = {bflo(zr[j + 1]), bfhi(zr[j + 1])}, x2 = {bflo(zr[j + 2]), bfhi(zr[j + 2])}, x3 = {bflo(zr[j + 3]), bfhi(zr[j + 3])};
            const f32x2 y = bb + w0 * x0 + w1 * x1 + w2 * x2 + w3 * x3;
            *(LAS unsigned*)(XA + (32 * half + j) * XAP16 + c) = pg8::cvt_pk_bf16(y.x, y.y);
        }
    } else {
        const float* cosT = (const float*)(ws + WS_ROPE); const float* sinT = cosT + SEQ * 16;
        bf16_t* KR = (bf16_t*)((unsigned char*)F.out + OUT_KR);
        float ka[8], kb2[8], kc[8], ks[8];
#pragma unroll
        for (int q = 0; q < 8; ++q) { const int it = tid - 384 + 128 * q, tk = it >> 4, i = it & 15, row = row0 + tk, pos = t0 + tk;
            ka[q] = bf2f(Z[(size_t)row * ZW + Z_KR + i]); kb2[q] = bf2f(Z[(size_t)row * ZW + Z_KR + 16 + i]); kc[q] = cosT[pos * 16 + i]; ks[q] = sinT[pos * 16 + i]; }
#pragma unroll
        for (int q = 0; q < 8; ++q) { const int it = tid - 384 + 128 * q, tk = it >> 4, i = it & 15, row = row0 + tk;
            KR[(size_t)row * 32 + i] = (bf16_t)f2bf(ka[q] * kc[q] - kb2[q] * ks[q]); KR[(size_t)row * 32 + 16 + i] = (bf16_t)f2bf(ka[q] * ks[q] + kb2[q] * kc[q]); }
    }
    __syncthreads();
    {
        const int mt = wave & 3, hg = wave >> 2, fr = lane & 15, fq = lane >> 4;
        const bf16_t* Wr = (const bf16_t*)(ws + WS_SMALL) + (size_t)l * 6 * 4096; const bf16_t* Wi = (const bf16_t*)(ws + WS_SMALL + 196608) + (size_t)l * 6 * 4096;
        const float* br = kin(6) + l * DLRU; const float* bi = kin(8) + l * DLRU; const float* SP = (const float*)(ws + WS_SMALL + 524288) + l * DLRU;
        const LAS bf16_t* xrow = XA + (16 * mt + fr) * XAP16; const int lrow = (16 * mt + fr) * DLRU;
        const size_t grow = (size_t)(row0 + 16 * mt + fr) * DLRU;
#pragma unroll 1
        for (int hh = 0; hh < 3; ++hh) {
            const int h = 3 * hg + hh;
            const bf16x8 xb0 = *(const LAS bf16x8*)(xrow + 64 * h + 8 * fq), xb1 = *(const LAS bf16x8*)(xrow + 64 * h + 32 + 8 * fq);
            bf16x8 wfr[4][4]; f32x4 brq[4], biq[4], spq[4];
#pragma unroll
            for (int nt = 0; nt < 4; ++nt) {
                const bf16_t* wr_ = Wr + (size_t)h * 4096 + (16 * nt + fr) * 64 + 8 * fq; const bf16_t* wi_ = Wi + (size_t)h * 4096 + (16 * nt + fr) * 64 + 8 * fq;
                wfr[nt][0] = *(const bf16x8*)wr_; wfr[nt][1] = *(const bf16x8*)(wr_ + 32); wfr[nt][2] = *(const bf16x8*)wi_; wfr[nt][3] = *(const bf16x8*)(wi_ + 32);
                const int c = 64 * h + 16 * nt + 4 * fq;
                brq[nt] = *(const f32x4*)(br + c); biq[nt] = *(const f32x4*)(bi + c); spq[nt] = *(const f32x4*)(SP + c);
            }
#pragma unroll
            for (int nt = 0; nt < 4; ++nt) {
                const bf16x8 ar0 = wfr[nt][0], ar1 = wfr[nt][1], ai0 = wfr[nt][2], ai1 = wfr[nt][3];
                f32x4 accR = {0.f, 0.f, 0.f, 0.f}, accI = {0.f, 0.f, 0.f, 0.f};
                accR = __builtin_amdgcn_mfma_f32_16x16x32_bf16(ar0, xb0, accR, 0, 0, 0); accR = __builtin_amdgcn_mfma_f32_16x16x32_bf16(ar1, xb1, accR, 0, 0, 0);
                accI = __builtin_amdgcn_mfma_f32_16x16x32_bf16(ai0, xb0, accI, 0, 0, 0); accI = __builtin_amdgcn_mfma_f32_16x16x32_bf16(ai1, xb1, accI, 0, 0, 0);
                const int c = 64 * h + 16 * nt + 4 * fq;
                const u32x2 xw_ = *(const LAS u32x2*)(xrow + c);
                const f32x4 brv = brq[nt], biv = biq[nt], spv = spq[nt], xav = {bflo(xw_.x), bfhi(xw_.x), bflo(xw_.y), bfhi(xw_.y)};
                f32x4 lv, uv;
#pragma unroll
                for (int v = 0; v < 4; ++v) {
                    const float r = fast_sigmoid(accR[v] + brv[v]), ig = fast_sigmoid(accI[v] + biv[v]);
                    const float la = -8.0f * r * spv[v];
                    lv[v] = la; uv[v] = __builtin_amdgcn_sqrtf(neg_expm1(2.0f * la)) * (ig * xav[v]);
                }
                *(LAS u32x2*)(LA + lrow + c) = (u32x2){pg8::cvt_pk_bf16(lv[0], lv[1]), pg8::cvt_pk_bf16(lv[2], lv[3])};
                *(LAS u32x2*)(UU + lrow + c) = (u32x2){pg8::cvt_pk_bf16(uv[0], uv[1]), pg8::cvt_pk_bf16(uv[2], uv[3])};
            }
        }
    }
    __syncthreads();
    unsigned zpool[31];
    {
        const int p_ = tid & 127, tq_ = tid >> 7, c_ = 2 * p_, tp0_ = t0 + 16 * tq_;
#pragma unroll
        for (int i = 0; i < 31; ++i) { zpool[i] = 0u; if (tp0_ - 15 + i >= 0) zpool[i] = *(const unsigned*)(Z + (size_t)(row0 + 16 * tq_ - 15 + i) * ZW + Z_ZC + c_); }
    }
    if (tid < DLRU) {
        float ap = 1.0f, hh = 0.0f;
#pragma unroll 1
        for (int jb = 0; jb < 64; jb += 16) {
            unsigned short lq[16], uq16[16], pq[16], hq[16];
#pragma unroll
            for (int j = 0; j < 16; ++j) { lq[j] = LA[(jb + j) * DLRU + tid]; uq16[j] = UU[(jb + j) * DLRU + tid]; }
#pragma unroll
            for (int j = 0; j < 16; ++j) { const float a = __expf(bf2f(lq[j])); hh = a * hh + bf2f(uq16[j]); ap *= a; const unsigned w_ = pg8::cvt_pk_bf16(ap, hh); pq[j] = (unsigned short)(w_ & 0xffffu); hq[j] = (unsigned short)(w_ >> 16); }
#pragma unroll
            for (int j = 0; j < 16; ++j) { LA[(jb + j) * DLRU + tid] = pq[j]; UU[(jb + j) * DLRU + tid] = hq[j]; }
        }
        float* CA = (float*)(ws + WS_CHS); float* CH = CA + 256 * DLRU;
        CA[u * DLRU + tid] = ap; CH[u * DLRU + tid] = hh;
    }
    LAS bf16_t* PL = (LAS bf16_t*)F.lds;
    {
        const int p = tid & 127, tq = tid >> 7, c = 2 * p, g = c >> 6;
        const int tp0 = t0 + 16 * tq;
        float v0[31], v1[31], c0[31], c1[31];
#pragma unroll
        for (int i = 0; i < 31; ++i) {
            const unsigned a = zpool[i];
            v0[i] = bflo(a); v1[i] = bfhi(a);
            c0[i] = (i ? c0[i - 1] : 0.f) + v0[i]; c1[i] = (i ? c1[i - 1] : 0.f) + v1[i];
        }
        LAS bf16_t* dst = PL + (16 * tq) * PLP16 + c;
        if (g == 0) pool_rows<2>(c0, c1, v0, v1, tp0, dst); else if (g == 1) pool_rows<4>(c0, c1, v0, v1, tp0, dst); else if (g == 2) pool_rows<8>(c0, c1, v0, v1, tp0, dst); else pool_rows<16>(c0, c1, v0, v1, tp0, dst);
    }
    __syncthreads();
#pragma unroll
    for (int k = 0; k < 6; ++k) { const int idx = tid + NTHREADS * k;
        const u32x4 va = *(const LAS u32x4*)(LA + idx * 8), vu = *(const LAS u32x4*)(UU + idx * 8);
        *(u32x4*)(A16 + (size_t)row0 * DLRU + idx * 8) = va; *(u32x4*)(U16 + (size_t)row0 * DLRU + idx * 8) = vu; }
    {
        const int mt = wave & 3, gg = wave >> 2, fr = lane & 15, fq = lane >> 4;
        const bf16_t* Wp = (const bf16_t*)(ws + WS_SMALL + 393216) + (size_t)l * 4 * 4096; const float* psc = kin(15) + l * DPOOL;
        bf16_t* Y = (bf16_t*)(ws + WS_Y);
        const LAS bf16_t* prow = PL + (16 * mt + fr) * PLP16; const size_t row = (size_t)(row0 + 16 * mt + fr);
        u32x2 gcq[2][4]; f32x4 psq[2][4]; bf16x8 wpq[2][4][2];
#pragma unroll
        for (int q = 0; q < 2; ++q)
#pragma unroll
            for (int nt = 0; nt < 4; ++nt) { const int g = 2 * gg + q, c = 64 * g + 16 * nt + 4 * fq;
                gcq[q][nt] = *(const u32x2*)(Z + row * ZW + Z_GC + c); psq[q][nt] = *(const f32x4*)(psc + c);
                const bf16_t* wp_ = Wp + (size_t)g * 4096 + (16 * nt + fr) * 64 + 8 * fq; wpq[q][nt][0] = *(const bf16x8*)wp_; wpq[q][nt][1] = *(const bf16x8*)(wp_ + 32); }
#pragma unroll
        for (int q = 0; q < 2; ++q) {
            const int g = 2 * gg + q;
            const bf16x8 xb0 = *(const LAS bf16x8*)(prow + 64 * g + 8 * fq), xb1 = *(const LAS bf16x8*)(prow + 64 * g + 32 + 8 * fq);
#pragma unroll
            for (int nt = 0; nt < 4; ++nt) {
                const bf16x8 a0 = wpq[q][nt][0], a1 = wpq[q][nt][1];
                f32x4 acc = {0.f, 0.f, 0.f, 0.f};
                acc = __builtin_amdgcn_mfma_f32_16x16x32_bf16(a0, xb0, acc, 0, 0, 0); acc = __builtin_amdgcn_mfma_f32_16x16x32_bf16(a1, xb1, acc, 0, 0, 0);
                const int c = 64 * g + 16 * nt + 4 * fq;
                const f32x4 ps = psq[q][nt]; const u32x2 gw_ = gcq[q][nt];
                const float y0 = acc[0] * ps[0] * siluf_(bflo(gw_.x)), y1 = acc[1] * ps[1] * siluf_(bfhi(gw_.x)), y2 = acc[2] * ps[2] * siluf_(bflo(gw_.y)), y3 = acc[3] * ps[3] * siluf_(bfhi(gw_.y));
                *(u32x2*)(Y + row * DM + 768 + c) = (u32x2){pg8::cvt_pk_bf16(y0, y1), pg8::cvt_pk_bf16(y2, y3)};
            }
        }
    }
    __syncthreads();
}

__device__ __forceinline__ void lru_final_unit(Frame& F, int u) {
    const int tid = F.tid; unsigned char* ws = F.ws;
    LAS float* carry = (LAS float*)F.lds;
    if (tid < DLRU) {
        const float* CA = (const float*)(ws + WS_CHS); const float* CH = CA + 256 * DLRU;
        const int b0 = u & ~127;
        float hh = 0.f;
#pragma unroll 16
        for (int j = b0; j < u; ++j) hh = CA[j * DLRU + tid] * hh + CH[j * DLRU + tid];
        carry[tid] = hh;
    }
    __syncthreads();
    const bf16_t* PA = (const bf16_t*)(ws + WS_A32) + (size_t)u * 64 * DLRU; const bf16_t* HL = (const bf16_t*)(ws + WS_U32) + (size_t)u * 64 * DLRU;
    const bf16_t* zg = (const bf16_t*)(ws + WS_Z) + (size_t)u * 64 * ZW + Z_GA; bf16_t* Y = (bf16_t*)(ws + WS_Y) + (size_t)u * 64 * DM;
    {
        u32x4 pq[6], hq[6], gq[6];
#pragma unroll
        for (int k = 0; k < 6; ++k) { const int idx = tid + NTHREADS * k, row = idx / 48, c = 8 * (idx % 48);
            pq[k] = *(const u32x4*)(PA + (size_t)row * DLRU + c); hq[k] = *(const u32x4*)(HL + (size_t)row * DLRU + c); gq[k] = __builtin_nontemporal_load((const u32x4*)(zg + (size_t)row * ZW + c)); }
#pragma unroll
        for (int k = 0; k < 6; ++k) { const int idx = tid + NTHREADS * k, row = idx / 48, c = 8 * (idx % 48);
            const f32x4 cr0 = *(const LAS f32x4*)(carry + c), cr1 = *(const LAS f32x4*)(carry + c + 4);
            const f32x4 p0 = {bflo(pq[k].x), bfhi(pq[k].x), bflo(pq[k].y), bfhi(pq[k].y)}, p1 = {bflo(pq[k].z), bfhi(pq[k].z), bflo(pq[k].w), bfhi(pq[k].w)};
            const f32x4 h0 = (f32x4){bflo(hq[k].x), bfhi(hq[k].x), bflo(hq[k].y), bfhi(hq[k].y)} + p0 * cr0, h1 = (f32x4){bflo(hq[k].z), bfhi(hq[k].z), bflo(hq[k].w), bfhi(hq[k].w)} + p1 * cr1;
            const u32x4 g = gq[k];
            u32x4 w;
            w.x = pg8::cvt_pk_bf16(h0[0] * siluf_(bflo(g.x)), h0[1] * siluf_(bfhi(g.x))); w.y = pg8::cvt_pk_bf16(h0[2] * siluf_(bflo(g.y)), h0[3] * siluf_(bfhi(g.y)));
            w.z = pg8::cvt_pk_bf16(h1[0] * siluf_(bflo(g.z)), h1[1] * siluf_(bfhi(g.z))); w.w = pg8::cvt_pk_bf16(h1[2] * siluf_(bflo(g.w)), h1[3] * siluf_(bfhi(g.w)));
            *(u32x4*)(Y + (size_t)row * DM + c) = w; }
    }
    __syncthreads();
}

namespace att {
constexpr int KSLOT = 12288, VSLOT = 8192;
constexpr int L_K = 0, L_V = 3 * KSLOT, L_WS = L_V + 3 * VSLOT, L_OST = L_WS + NWAVES * 256, L_END = L_OST + NWAVES * 8192;
static_assert(L_END <= 131072, "attention LDS");
__device__ __forceinline__ int crow(int r, int hi) { return (r & 3) + 8 * (r >> 2) + 4 * hi; }
__device__ __forceinline__ void glds16(const void* gsrc, unsigned lds_dst) {
    unsigned keep;
    asm volatile("s_mov_b32 %0, m0\n\ts_mov_b32 m0, %2\n\ts_nop 0\n\tglobal_load_lds_dwordx4 %1, off\n\ts_mov_b32 m0, %0" : "=&s"(keep) : "v"(gsrc), "s"(lds_dst) : "memory");
}
__device__ __forceinline__ void glds16s(const void* sbase, unsigned voff, unsigned lds_dst) {
    unsigned keep;
    asm volatile("s_mov_b32 %0, m0\n\ts_mov_b32 m0, %3\n\ts_nop 0\n\tglobal_load_lds_dwordx4 %1, %2\n\ts_mov_b32 m0, %0" : "=&s"(keep) : "v"(voff), "s"(sbase), "s"(lds_dst) : "memory");
}
typedef short v4i16_t __attribute__((ext_vector_type(4)));
__device__ __forceinline__ s16x4 vtr(const LAS char* p) { return __builtin_bit_cast(s16x4, __builtin_amdgcn_ds_read_tr16_b64_v4i16((LAS v4i16_t*)p)); }
typedef float f32x2_t __attribute__((ext_vector_type(2))); typedef __bf16 bf16x2_t __attribute__((ext_vector_type(2)));
__device__ __forceinline__ unsigned cvtpk_s(float lo, float hi) { f32x2_t v = {lo, hi}; bf16x2_t b = __builtin_convertvector(v, bf16x2_t); return __builtin_bit_cast(unsigned, b); }
__device__ __forceinline__ float swapmax(float m) { auto rr = __builtin_amdgcn_permlane32_swap(__float_as_uint(m), __float_as_uint(m), false, false); return fmaxf(__uint_as_float(rr[0]), __uint_as_float(rr[1])); }
__device__ __forceinline__ float swapsum(float m) { auto rr = __builtin_amdgcn_permlane32_swap(__float_as_uint(m), __float_as_uint(m), false, false); return __uint_as_float(rr[0]) + __uint_as_float(rr[1]); }
#define ATT_WAIT_BAR() asm volatile("s_waitcnt vmcnt(0) lgkmcnt(0)\n\ts_barrier" ::: "memory")

__device__ __forceinline__ void attn_unit(Frame& F, int b, int h, int qb) {
    const int lane = F.lane, r32 = lane & 31, hi = lane >> 5, wid = F.wave;
    unsigned char* ws = F.ws;
    const bf16_t* Q = (const bf16_t*)((const unsigned char*)F.out + OUT_Q); const bf16_t* KV = (const bf16_t*)(ws + WS_KV); const bf16_t* KR = (const bf16_t*)((const unsigned char*)F.out + OUT_KR);
    const LAS char* shm = (const LAS char*)F.lds;
    const unsigned lds0 = (unsigned)(uintptr_t)F.lds;
    const long rowbase = (long)b * SEQ; const int q0 = qb * 256;
    const bf16_t* kbase = KV + rowbase * DKV + h * 128 + wid * 8;
    const bf16_t* krbase = KR + rowbase * 32 + (wid & 3) * 8;
    const bf16_t* vbase = KV + (rowbase + 16 * (wid & 3)) * DKV + h * 128 + 64 + (wid >> 2) * 32;
    const unsigned kroffv = (unsigned)lane * 64u, voffv = (unsigned)(lane >> 2) * (DKV * 2) + (unsigned)(lane & 3) * 16u;
    const unsigned kdst = (unsigned)__builtin_amdgcn_readfirstlane(lds0 + L_K + wid * 1024), krdst = kdst + 8 * 1024  , vdst = kdst + (L_V - L_K);
#define ATT_ISSUE_K(t, sl) do { unsigned ko_ = kroffv; asm volatile("" : "+v"(ko_));   glds16s(kbase + (long)(t) * 64 * DKV, ko_ * 24u, kdst + (sl) * KSLOT); if (wid < 4) glds16s(krbase + (long)(t) * 64 * 32, kroffv, krdst + (sl) * KSLOT); } while (0)
#define ATT_ISSUE_V(t, sl) do { glds16s(vbase + (long)(t) * 64 * DKV, voffv, vdst + (sl) * VSLOT); } while (0)
#define ATT_QK(P0, P1, sl) do { const LAS char* kb_ = kfb + (sl) * KSLOT; P0 = f32x16{}; P1 = f32x16{}; \
        _Pragma("unroll") for (int d0 = 0; d0 < 6; ++d0) { \
            const bf16x8 k0_ = *(const LAS bf16x8*)(kb_ + d0 * 2048), k1_ = *(const LAS bf16x8*)(kb_ + d0 * 2048 + 512); \
            P0 = __builtin_amdgcn_mfma_f32_32x32x16_bf16(k0_, qr[d0], P0, 0, 0, 0); \
            P1 = __builtin_amdgcn_mfma_f32_32x32x16_bf16(k1_, qr[d0], P1, 0, 0, 0); } } while (0)
#define MX3(a, b, c) __builtin_fmaxf(__builtin_fmaxf((a), (b)), (c))
#define ATT_THR 8.0f
#define ATT_QKN(P0, P1, sl) do { const LAS char* kb_ = kfb + (sl) * KSLOT; \
        _Pragma("unroll") for (int d0 = 0; d0 < 6; ++d0) { \
            const bf16x8 k0_ = *(const LAS bf16x8*)(kb_ + d0 * 2048), k1_ = *(const LAS bf16x8*)(kb_ + d0 * 2048 + 512); \
            if (d0 == 0) { P0 = __builtin_amdgcn_mfma_f32_32x32x16_bf16(k0_, qr[0], negm, 0, 0, 0); P1 = __builtin_amdgcn_mfma_f32_32x32x16_bf16(k1_, qr[0], negm, 0, 0, 0); } \
            else { P0 = __builtin_amdgcn_mfma_f32_32x32x16_bf16(k0_, qr[d0], P0, 0, 0, 0); P1 = __builtin_amdgcn_mfma_f32_32x32x16_bf16(k1_, qr[d0], P1, 0, 0, 0); } } } while (0)
#define ATT_VF(d0, ks) ({ const s16x4 lo_ = vtr(vb + (d0) * 4096 + (ks) * 1024), hi_ = vtr(vb + (d0) * 4096 + (ks) * 1024 + 512); (bf16x8){lo_[0], lo_[1], lo_[2], lo_[3], hi_[0], hi_[1], hi_[2], hi_[3]}; })
#define ATT_STEP(C0, C1, N0, N1, tt) do { \
        ATT_WAIT_BAR(); \
        const int sl = (tt) & 1; \
        if ((tt) + 2 < NT) ATT_ISSUE_K((tt) + 2, sl); \
        if ((tt) + 1 < NT) ATT_ISSUE_V((tt) + 1, sl ^ 1); \
        if ((tt) <= tmax) { \
            if ((tt) == tmax) { const int kbase = 64 * (tt); \
                _Pragma("unroll") for (int r = 0; r < 16; ++r) { const int kv = kbase + crow(r, hi); if (kv > qabs) C0[r] = -INFINITY; if (kv + 32 > qabs) C1[r] = -INFINITY; } } \
            float ra = MX3(C0[0], C0[1], C1[0]), rb = MX3(C0[2], C0[3], C1[1]); ra = MX3(ra, C1[2], C1[3]); \
            _Pragma("unroll") for (int r = 4; r < 16; r += 4) { ra = MX3(ra, C0[r], C0[r + 1]); rb = MX3(rb, C0[r + 2], C0[r + 3]); ra = MX3(ra, C1[r], C1[r + 1]); rb = MX3(rb, C1[r + 2], C1[r + 3]); } \
            const float rm = swapmax(fmaxf(ra, rb)); \
            if ((tt) == 0 || __any(rm > ATT_THR)) {                                     \
                const float dl = ((tt) == 0) ? rm : fmaxf(rm, 0.f); \
                mref += dl; \
                _Pragma("unroll") for (int r = 0; r < 16; ++r) { C0[r] -= dl; C1[r] -= dl; } \
                _Pragma("unroll") for (int r = 0; r < 16; ++r) negm[r] = -mref; \
                asm volatile("" : "+v"(negm)); \
                if ((tt) != 0) { const float f = __builtin_amdgcn_exp2f(-dl); lrun *= f; \
                    if (hi == 0) wsf[r32] = f; \
                    LDS_WAIT(); \
                    _Pragma("unroll") for (int g4 = 0; g4 < 4; ++g4) { const f32x4 fv = *(const LAS f32x4*)(wsf + 8 * g4 + 4 * hi); \
                        _Pragma("unroll") for (int j = 0; j < 4; ++j) { o0[4 * g4 + j] *= fv[j]; o1[4 * g4 + j] *= fv[j]; } } \
                    LDS_WAIT(); } \
            } \
            ATT_QKN(N0, N1, sl ^ 1);                                                    \
            _Pragma("unroll") for (int r = 0; r < 16; ++r) { C0[r] = __builtin_amdgcn_exp2f(C0[r]); C1[r] = __builtin_amdgcn_exp2f(C1[r]); } \
            float sa = C0[0];                                                           \
            _Pragma("unroll") for (int r = 1; r < 16; ++r) sa += C0[r]; \
            _Pragma("unroll") for (int r = 0; r < 16; ++r) sa += C1[r]; \
            lrun += sa; \
            const u32x4 pw0 = (u32x4){cvtpk_s(C0[0], C0[1]), cvtpk_s(C0[2], C0[3]), cvtpk_s(C0[4], C0[5]), cvtpk_s(C0[6], C0[7])}; \
            const u32x4 pw1 = (u32x4){cvtpk_s(C0[8], C0[9]), cvtpk_s(C0[10], C0[11]), cvtpk_s(C0[12], C0[13]), cvtpk_s(C0[14], C0[15])}; \
            const u32x4 pw2 = (u32x4){cvtpk_s(C1[0], C1[1]), cvtpk_s(C1[2], C1[3]), cvtpk_s(C1[4], C1[5]), cvtpk_s(C1[6], C1[7])}; \
            const u32x4 pw3 = (u32x4){cvtpk_s(C1[8], C1[9]), cvtpk_s(C1[10], C1[11]), cvtpk_s(C1[12], C1[13]), cvtpk_s(C1[14], C1[15])}; \
            const LAS char* vb = vfb + sl * VSLOT; \
            o0 = __builtin_amdgcn_mfma_f32_32x32x16_bf16(__builtin_bit_cast(bf16x8, pw0), ATT_VF(0, 0), o0, 0, 0, 0); \
            o1 = __builtin_amdgcn_mfma_f32_32x32x16_bf16(__builtin_bit_cast(bf16x8, pw0), ATT_VF(1, 0), o1, 0, 0, 0); \
            o0 = __builtin_amdgcn_mfma_f32_32x32x16_bf16(__builtin_bit_cast(bf16x8, pw1), ATT_VF(0, 1), o0, 0, 0, 0); \
            o1 = __builtin_amdgcn_mfma_f32_32x32x16_bf16(__builtin_bit_cast(bf16x8, pw1), ATT_VF(1, 1), o1, 0, 0, 0); \
            o0 = __builtin_amdgcn_mfma_f32_32x32x16_bf16(__builtin_bit_cast(bf16x8, pw2), ATT_VF(0, 2), o0, 0, 0, 0); \
            o1 = __builtin_amdgcn_mfma_f32_32x32x16_bf16(__builtin_bit_cast(bf16x8, pw2), ATT_VF(1, 2), o1, 0, 0, 0); \
            o0 = __builtin_amdgcn_mfma_f32_32x32x16_bf16(__builtin_bit_cast(bf16x8, pw3), ATT_VF(0, 3), o0, 0, 0, 0); \
            o1 = __builtin_amdgcn_mfma_f32_32x32x16_bf16(__builtin_bit_cast(bf16x8, pw3), ATT_VF(1, 3), o1, 0, 0, 0); \
        } } while (0)
    const int NT = 4 * qb + 4, tmax = 4 * qb + (wid >> 1);
    ATT_ISSUE_K(0, 0); ATT_ISSUE_V(0, 0); ATT_ISSUE_K(1, 1);
    bf16x8 qr[6];
    { const bf16_t* qp = Q + (rowbase + q0 + wid * 32 + r32) * DQ + h * 96 + hi * 8;
#pragma unroll
      for (int d0 = 0; d0 < 6; ++d0) qr[d0] = *(const bf16x8*)(qp + d0 * 16); }
    float mref = 0.f, lrun = 0.f;
    f32x16 o0 = {}, o1 = {};
    f32x16 negm = {}; asm volatile("" : "+v"(negm));
    LAS float* wsf = (LAS float*)(F.lds + L_WS) + wid * 64;
    const int qabs = q0 + wid * 32 + r32;
    const LAS char* kfb = shm + L_K + hi * 1024 + r32 * 16;
    const LAS char* vfb = shm + L_V + ((lane >> 4) & 1) * 32 + (lane & 3) * 8 + (4 * hi + ((lane & 15) >> 2)) * 64;
    f32x16 pa0, pa1, pb0, pb1;
    if (wid >= 4) __builtin_amdgcn_s_setprio(1);
    ATT_WAIT_BAR();
    ATT_QKN(pa0, pa1, 0);
#pragma unroll 1
    for (int t = 0; t < NT; t += 2) {
        ATT_STEP(pa0, pa1, pb0, pb1, t);
        ATT_STEP(pb0, pb1, pa0, pa1, t + 1);
    }
    __builtin_amdgcn_s_setprio(0);
#undef ATT_STEP
#undef ATT_VF
#undef ATT_QKN
#undef ATT_THR
#undef MX3
    {
        const bf16_t* Z = (const bf16_t*)((const unsigned char*)kin(19) + WS_Z); bf16_t* Y = (bf16_t*)((unsigned char*)kin(19) + WS_Y);
        int lane_e = lane; asm volatile("" : "+v"(lane_e));
        const float lt = swapsum(lrun);
        if (hi == 0) wsf[r32] = 1.0f / lt;
        LDS_WAIT();
        LAS float* stg = (LAS float*)(F.lds + L_OST) + wid * 2048;
#pragma unroll
        for (int g4 = 0; g4 < 4; ++g4) { const f32x4 f = *(const LAS f32x4*)(wsf + 8 * g4 + 4 * hi);
#pragma unroll
            for (int j = 0; j < 4; ++j) { const int r = 4 * g4 + j, orow = crow(r, hi); stg[orow * 64 + r32] = o0[r] * f[j]; stg[orow * 64 + 32 + r32] = o1[r] * f[j]; } }
        LDS_WAIT();
        const size_t grow0 = (size_t)(rowbase + q0 + wid * 32);
        u32x4 gbq[4];
#pragma unroll
        for (int i = 0; i < 4; ++i) { const int row = i * 8 + (lane_e >> 3), ch = lane_e & 7; gbq[i] = __builtin_nontemporal_load((const u32x4*)(Z + (grow0 + row) * ZW + Z_GB + 64 * h + 8 * ch)); }
#pragma unroll
        for (int i = 0; i < 4; ++i) {
            const int row = i * 8 + (lane_e >> 3), ch = lane_e & 7;
            const f32x4 ov0 = *(const LAS f32x4*)(stg + row * 64 + ch * 8), ov1 = *(const LAS f32x4*)(stg + row * 64 + ch * 8 + 4);
            const u32x4 g = gbq[i];
            u32x4 w;
            w.x = pg8::cvt_pk_bf16(ov0[0] * siluf_(bflo(g.x)), ov0[1] * siluf_(bfhi(g.x))); w.y = pg8::cvt_pk_bf16(ov0[2] * siluf_(bflo(g.y)), ov0[3] * siluf_(bfhi(g.y)));
            w.z = pg8::cvt_pk_bf16(ov1[0] * siluf_(bflo(g.z)), ov1[1] * siluf_(bfhi(g.z))); w.w = pg8::cvt_pk_bf16(ov1[2] * siluf_(bflo(g.w)), ov1[3] * siluf_(bfhi(g.w)));
            *(u32x4*)(Y + (grow0 + row) * DM + 384 + 64 * h + 8 * ch) = w;
        }
        LDS_WAIT();
    }
#undef ATT_ISSUE_K
#undef ATT_ISSUE_V
}
}

__device__ __forceinline__ void phase_final(Frame& F) {
    const int gw = F.bid * NWAVES + F.wave, NGW = F.G * NWAVES, lane = F.lane;
    const ssum_t* ssx = (const ssum_t*)(F.ws + WS_ACC + OFF_SSX) + 4 * M; const float* g = kin(17);
    const bf16_t* XB = (const bf16_t*)(F.ws + WS_XB);
#pragma unroll 4
    for (int m = gw; m < M; m += NGW) {
        const u32x2* xr = (const u32x2*)(XB + (size_t)m * DM) + lane; f32x4* orow = (f32x4*)(F.out + (size_t)m * DM) + lane; const f32x4* gr = (const f32x4*)g + lane;
        const float rs = rsqrtf(ldfx(ssx + m) * (1.0f / 1024.0f) + EPS);
#pragma unroll
        for (int j = 0; j < 4; ++j) { const u32x2 w = __builtin_nontemporal_load(&xr[64 * j]); const f32x4 v = {bflo(w.x), bfhi(w.x), bflo(w.y), bfhi(w.y)}; __builtin_nontemporal_store(v * rs * gr[64 * j], &orow[64 * j]);   }
    }
}

#define XB_TMO      128
#define XB_XCNT(j)  (256  + 64 * (j))
#define XB_XSUB(j)  (1280 + 64 * (j))
#define XB_XGEN(j)  (2304 + 64 * (j))
#define XB_TOP      3328
#define XB_TOPGEN   3392
#define XCD_BAR_WORDS 3456
#define XB_SPIN_CAP (1u << 18)

__device__ __forceinline__ unsigned xb_ld(unsigned* p)              { return __hip_atomic_load(p, __ATOMIC_RELAXED, __HIP_MEMORY_SCOPE_AGENT); }
__device__ __forceinline__ unsigned xb_add(unsigned* p, unsigned v) { return __hip_atomic_fetch_add(p, v, __ATOMIC_RELAXED, __HIP_MEMORY_SCOPE_AGENT); }
__device__ __forceinline__ unsigned xb_xcc_id() { return (unsigned)__builtin_amdgcn_s_getreg((3 << 11) | 20) & 0xFu; }
#define XB_SPIN(cond, bar) do { unsigned _sp = 0; while (cond) { __builtin_amdgcn_s_sleep(1); \
    if ((++_sp & 255u) == 0u) { if (xb_ld(&(bar)[XB_TMO])) break; if (_sp > XB_SPIN_CAP) { atomicAdd(&(bar)[XB_TMO], 1u); break; } } } } while (0)

struct XcdBarrier {
    unsigned* bar; unsigned x;
    volatile LAS unsigned* st;
};

__device__ __forceinline__ XcdBarrier xcd_barrier_post(unsigned* bar, volatile LAS unsigned* st) {
    XcdBarrier b; b.bar = bar; b.x = xb_xcc_id(); b.st = st;
    if (threadIdx.x == 0) (void)xb_add(&bar[XB_XCNT(b.x)], 1u);
    return b;
}
__device__ __forceinline__ void xcd_barrier_complete(unsigned* bar, unsigned x, unsigned& nloc, unsigned& nx) {
    const unsigned G = gridDim.x * gridDim.y * gridDim.z;
    unsigned sum, cnt, mine, sp = 0u;
    for (;;) {
        sum = 0u; cnt = 0u; mine = 0u;
#pragma unroll
        for (unsigned j = 0; j < 16; ++j) { const unsigned c = xb_ld(&bar[XB_XCNT(j)]); sum += c; cnt += (c > 0u) ? 1u : 0u; mine = (j == x) ? c : mine; }
        if (sum == G) break;
        __builtin_amdgcn_s_sleep(1);
        if ((++sp & 255u) == 0u) { if (xb_ld(&bar[XB_TMO])) break; if (sp > XB_SPIN_CAP) { atomicAdd(&bar[XB_TMO], 1u); break; } }
    }
    nloc = mine > 0u ? mine : 1u; nx = cnt > 0u ? cnt : 1u;
}

__device__ __forceinline__ void xcd_barrier(const XcdBarrier& b) {
    asm volatile("s_waitcnt vmcnt(0)" ::: "memory");
    __syncthreads();
    if (threadIdx.x == 0) {
        unsigned* bar = b.bar;
        __builtin_amdgcn_s_waitcnt(0);
        unsigned nloc = b.st[0], nx = b.st[1];
        if (nloc == 0u) { xcd_barrier_complete(bar, b.x, nloc, nx); b.st[0] = nloc; b.st[1] = nx; }
        const unsigned old = xb_add(&bar[XB_XSUB(b.x)], 1u);
        const unsigned gen = old / nloc;
        if (old + 1u == (gen + 1u) * nloc) {
            __builtin_amdgcn_fence(__ATOMIC_RELEASE, "agent");
            asm volatile("s_waitcnt vmcnt(0)" ::: "memory");
            const unsigned og = xb_add(&bar[XB_TOP], 1u);
            const unsigned tg = og / nx;
            if (og + 1u == (tg + 1u) * nx) xb_add(&bar[XB_TOPGEN], 1u);
            else XB_SPIN(xb_ld(&bar[XB_TOPGEN]) == tg, bar);
            __builtin_amdgcn_fence(__ATOMIC_ACQUIRE, "agent");
            xb_add(&bar[XB_XGEN(b.x)], 1u);
            asm volatile("s_waitcnt vmcnt(0)" ::: "memory");
        } else {
            XB_SPIN(xb_ld(&bar[XB_XGEN(b.x)]) == gen, bar);
            __builtin_amdgcn_fence(__ATOMIC_ACQUIRE, "agent");
            asm volatile("s_waitcnt vmcnt(0)" ::: "memory");
        }
    }
    __syncthreads();
}

constexpr size_t OFF_BAR = 900 * 1024;
constexpr int LDS_BARST = 150016;
#define MK_FRAME() \
    Frame F; F.lds = (LAS unsigned char*)lds; \
    { int t_ = threadIdx.x; asm volatile("" : "+v"(t_)); F.tid = t_; } \
    F.lane = F.tid & 63; F.wave = __builtin_amdgcn_readfirstlane(F.tid >> 6); \
    F.bid = blockIdx.x; F.G = gridDim.x; F.out = (float*)kin(18); F.ws = (unsigned char*)kin(19); \
    unsigned char* ws = F.ws; (void)ws; \
    ssum_t* ssx = (ssum_t*)(ws + WS_ACC + OFF_SSX); ssum_t* ssq = (ssum_t*)(ws + WS_ACC + OFF_SSQ); ssum_t* sskv = (ssum_t*)(ws + WS_ACC + OFF_SSKV); (void)ssx; (void)ssq; (void)sskv; \
    const float* cosT = (const float*)(ws + WS_ROPE); const float* sinT = cosT + SEQ * 16; (void)cosT; (void)sinT;
#define MK_IN(k) (ph_lo <= (k) && (k) < ph_hi)
#define MK_SEAM(k) do { if ((k) + 1 < ph_hi) { if ((k) == 0 && ph_hi > 18) cg::this_grid().sync();   else { XcdBarrier xb_; xb_.bar = (unsigned*)(kin(19)) + OFF_BAR / 4; xb_.x = xb_xcc_id(); xb_.st = (volatile LAS unsigned*)((LAS unsigned char*)lds + LDS_BARST); xcd_barrier(xb_); } } } while (0)

template <int l> __device__ __forceinline__ void layer_phases(unsigned char* lds, int ph_lo, int ph_hi) {
    if (MK_IN(1 + 4 * l)) {
        MK_FRAME();
#if !defined(NO_GEMM) && !defined(NO_G1)
        pg8::Gemm g{(const pg8::bf16_t*)(ws + WS_XB), (const pg8::bf16_t*)(ws + WS_WIN) + (size_t)l * ZW * 1024, M, ZW, 1024, 1024, 1024};
        pg8::StaticOrder S; S.init(M, ZW, F.G, F.bid);
        EpiZ E{(bf16_t*)(ws + WS_Z), ssx + l * M, ssq + l * M, sskv + l * M};
        pg8::gemm_phase<EpiZ, pg8::StaticOrder, PG8_ALIGN, PG8_SP2>(F.lds, g, S, E);
#endif
        if (F.G == 256 && l + 1 < NL && F.bid >= 128) convert_layer_weights(F, l + 1, (F.bid - 128) * NWAVES + F.wave, 128 * NWAVES);
        MK_SEAM(1 + 4 * l);
    }
    if (MK_IN(2 + 4 * l)) for (int rep2_ = 0; rep2_ < P2_REPEAT; ++rep2_) {
        {
            MK_FRAME();
#if !defined(NO_GEMM) && !defined(NO_G2)
            pg8::Gemm g{(const pg8::bf16_t*)(ws + WS_Z) + Z_CQ, (const pg8::bf16_t*)(ws + WS_WUQ) + (size_t)l * 768 * 384, M, 768, 384, ZW, 384};
            pg8::StaticOrder S; S.init(M, 768, F.G, F.bid);
            EpiQ E{(bf16_t*)((unsigned char*)F.out + OUT_Q), ssq + l * M, cosT, sinT};
            pg8::gemm_phase<EpiQ, pg8::StaticOrder, PG8_ALIGN, PG8_SP2>(F.lds, g, S, E);
#endif
        }
        {
            MK_FRAME();
#if !defined(NO_GEMM) && !defined(NO_G3)
            pg8::Gemm g{(const pg8::bf16_t*)(ws + WS_Z) + Z_CKV, (const pg8::bf16_t*)(ws + WS_WUKV) + (size_t)l * 768 * 256, M, 768, 256, ZW, 256};
            pg8::StaticOrder S; S.init(M, 768, F.G, (F.bid + F.G / 2) % F.G);
            EpiKV E{(bf16_t*)(ws + WS_KV), sskv + l * M};
            pg8::gemm_phase<EpiKV, pg8::StaticOrder, PG8_ALIGN, PG8_SP2>(F.lds, g, S, E);
#endif
        }
        __syncthreads();
        {
            MK_FRAME();
#if !defined(NO_P2)
            for (int u = F.bid; u < 256; u += F.G) phase2_tile(F, l, u);
#endif
        }
        MK_SEAM(2 + 4 * l);
    }
    if (MK_IN(3 + 4 * l)) {
        MK_FRAME();
#ifndef ATT_REPEAT
#define ATT_REPEAT 1
#endif
        int i1 = F.bid;
        if (F.G == 256) { const int v = (F.bid & 7) * 32 + (F.bid >> 3); i1 = (v < 252) ? (v % 21) * 12 + v / 21 : v; }
        for (int rep = 0; rep < ATT_REPEAT; ++rep)
        for (int r = 0;; ++r) {
            int i;
            if (F.G == 256) { if (r >= 2 || (r == 1 && i1 < 128)) break; i = r ? 511 - i1 : i1; }
            else { if (r * F.G >= 384) break; i = (r & 1) ? r * F.G + (F.G - 1 - F.bid) : r * F.G + F.bid; }
#if !defined(NO_ATT)
            if (i < 384) att::attn_unit(F, (i % 12) / 6, (i % 12) % 6, 31 - i / 12);
#endif
        }
        __syncthreads();
        { const int hg = F.G / 2;
          if (i1 >= F.G - hg) for (int u = F.G - 1 - i1; u < 256; u += hg) lru_final_unit(F, u); }
        MK_SEAM(3 + 4 * l);
    }
    if (MK_IN(4 + 4 * l)) {
        MK_FRAME();
#if !defined(NO_GEMM) && !defined(NO_G4)
        pg8::Gemm g{(const pg8::bf16_t*)(ws + WS_Y), (const pg8::bf16_t*)(ws + WS_WOUT) + (size_t)l * 1024 * 1024, M, 1024, 1024, 1024, 1024};
        pg8::StaticOrder S; S.init(M, 1024, F.G, F.bid);
        EpiOut E{(bf16_t*)(ws + WS_XB), ssx + (l + 1) * M};
        pg8::gemm_phase<EpiOut, pg8::StaticOrder, PG8_ALIGN, PG8_SP2>(F.lds, g, S, E);
#endif
        MK_SEAM(4 + 4 * l);
    }
}

__global__ void __launch_bounds__(NTHREADS, 2) mk_fwd(Args args) {
    extern __shared__ __attribute__((aligned(16))) unsigned char lds[];
    const int ph_lo = *(__attribute__((address_space(4))) const int*)((__attribute__((address_space(4))) const char*)__builtin_amdgcn_kernarg_segment_ptr() + 160);
    const int ph_hi = *(__attribute__((address_space(4))) const int*)((__attribute__((address_space(4))) const char*)__builtin_amdgcn_kernarg_segment_ptr() + 164);
    if (threadIdx.x < 2) ((LAS unsigned*)((LAS unsigned char*)lds + LDS_BARST))[threadIdx.x] = 0u;
    __syncthreads();
    (void)xcd_barrier_post((unsigned*)(kin(19)) + OFF_BAR / 4, (volatile LAS unsigned*)((LAS unsigned char*)lds + LDS_BARST));
    if (MK_IN(0)) {
        MK_FRAME();
#if !defined(NO_PRO)
        phase_prologue(F);
#endif
        MK_SEAM(0);
    }
    layer_phases<0>(lds, ph_lo, ph_hi);
    layer_phases<1>(lds, ph_lo, ph_hi);
    layer_phases<2>(lds, ph_lo, ph_hi);
    layer_phases<3>(lds, ph_lo, ph_hi);
    if (MK_IN(17)) {
        MK_FRAME();
        phase_final(F);
    }
}

extern "C" void kernel_launch(void* const* d_in, const int* in_sizes, int n_in, void* d_out, int out_size, void* d_ws, size_t ws_size, hipStream_t stream) {
    static int grid = 0;
    if (grid == 0) {
        if (n_in != 18 || in_sizes[0] != M * DM || out_size != M * DM || ws_size < WS_END) { fprintf(stderr, "kernel_launch: unexpected shapes (n_in %d, in0 %d, out %d, ws %zu)\n", n_in, n_in > 0 ? in_sizes[0] : -1, out_size, ws_size); grid = -1; return; }
        int dev = 0, cus = 0, per_cu = 0;
        hipGetDevice(&dev); hipDeviceGetAttribute(&cus, hipDeviceAttributeMultiprocessorCount, dev);
        if (hipFuncSetAttribute((const void*)mk_fwd, hipFuncAttributeMaxDynamicSharedMemorySize, LDS_BYTES) != hipSuccess) { fprintf(stderr, "kernel_launch: hipFuncSetAttribute failed\n"); grid = -1; return; }
        if (hipOccupancyMaxActiveBlocksPerMultiprocessor(&per_cu, (const void*)mk_fwd, NTHREADS, LDS_BYTES) != hipSuccess || per_cu < 1) { fprintf(stderr, "kernel_launch: occupancy query says %d\n", per_cu); per_cu = 1; }
        (void)hipGetLastError();
        grid = cus;
        if (grid > 256) grid = 256;
    }
    if (grid < 0) return;
    hipMemsetAsync((char*)d_ws + WS_CTL, 0, CTL_ZERO_BYTES, stream);
    hipMemsetAsync((char*)d_ws + WS_ACC, 0, ACC_BYTES, stream);
    Args a{};
    for (int i = 0; i < 18; ++i) a.in[i] = (const float*)d_in[i];
    a.out = (float*)d_out; a.ws = (unsigned char*)d_ws;
#if MK_ONE_LAUNCH
    a.ph_lo = 0; a.ph_hi = 18;
    void* kargs[] = {&a};
    hipError_t e = hipLaunchCooperativeKernel((const void*)mk_fwd, dim3(grid), dim3(NTHREADS), kargs, LDS_BYTES, stream);
    if (e != hipSuccess) fprintf(stderr, "cooperative launch failed: %s (grid %d)\n", hipGetErrorString(e), grid);
#else
    for (int ph = 0; ph < 18; ++ph) {
        a.ph_lo = ph; a.ph_hi = ph + 1;
        hipLaunchKernelGGL(mk_fwd, dim3(grid), dim3(NTHREADS), LDS_BYTES, stream, a);
    }
#endif
}
```

```cpp
#include <hip/hip_runtime.h>
#include <hip/hip_cooperative_groups.h>
#include <cstdio>
#include <cstdint>
#include <cmath>
namespace cg = cooperative_groups;
namespace pg8 {
#define PG8_LAS __attribute__((address_space(3)))
typedef unsigned short bf16_t;
typedef short bf16x8 __attribute__((ext_vector_type(8)));
typedef float f32x4 __attribute__((ext_vector_type(4)));
typedef unsigned u32x4 __attribute__((ext_vector_type(4)));
constexpr int BM = 256, BK = 64, HALF = 128, HTB = HALF * BK * 2  , STAGE_BYTES = 8 * HTB, NXCD = 8, WGM = 8;

__host__ __device__ __forceinline__ int lds_byte(int r, int c) { const int st = (r >> 4) * 2 + (c >> 5), rr = r & 15, cc = c & 31, ob = rr * 64 + cc * 2; return st * 1024 + (ob ^ (((ob >> 9) & 1) << 5)); }
__host__ __device__ __forceinline__ void stage_rc(int b, int& R, int& C) { const int st = b / 1024, sb = b % 1024, swz = sb ^ (((sb >> 9) & 1) << 5); R = (st >> 1) * 16 + swz / 64; C = (st & 1) * 32 + (swz % 64) / 2; }
__host__ __device__ __forceinline__ int perm32(int rho) { const int n = rho >> 4, i = rho & 15; return 8 * (i >> 2) + 4 * n + (i & 3); }

struct Unit { int pm, pn; };
struct Gemm { const bf16_t* A; const bf16_t* Bt; int M, N, K, lda, ldb; };

struct StaticOrder {
    int nM, nN, nwg, G, c;
    __host__ __device__ void init(int M, int N, int G_, int c_) { nM = M / BM; nN = N / BM; nwg = nM * nN; G = G_; c = c_; }
    __host__ __device__ bool next(int i, Unit& u) const {
        const long L = (long)i * G + c; if (L >= nwg) return false;
        int wgid = (int)L; { const int q = nwg / NXCD, r = nwg % NXCD, xcd = wgid % NXCD, off = wgid / NXCD; wgid = (xcd < r ? xcd * (q + 1) : r * (q + 1) + (xcd - r) * q) + off; }
        const int nig = WGM * nN, gid = wgid / nig, fm = gid * WGM, gsz = (nM - fm) < WGM ? (nM - fm) : WGM;
        u.pm = fm + ((wgid % nig) % gsz); u.pn = (wgid % nig) / gsz; return true;
    }
    __device__ __forceinline__ void a_ready(const Unit&) const {}
    __device__ __forceinline__ void done(const Unit&) const {}
};

__device__ __forceinline__ unsigned cvt_pk_bf16(float lo, float hi) { unsigned r; asm volatile("v_cvt_pk_bf16_f32 %0, %1, %2" : "=v"(r) : "v"(lo), "v"(hi)); return r; }
typedef float f32x2 __attribute__((ext_vector_type(2)));
template <class Epi, class Sched, bool ALIGN_EPI, bool SP2>
__device__ __forceinline__ void gemm_phase(PG8_LAS unsigned char* lds, const Gemm g, const Sched& S, const Epi& E) {
    int tid_ = threadIdx.x; asm volatile("" : "+v"(tid_));
    const int tid = tid_, wid = __builtin_amdgcn_readfirstlane(tid >> 6), lane = tid & 63, wr = wid >> 2, wc = wid & 3, fr = lane & 15, fq = lane >> 4;
    const int K = g.K; int nt = K / BK; asm volatile("" : "+s"(nt));
    unsigned voffA[2], voffB[2];
#pragma unroll
    for (int i = 0; i < 2; ++i) { int R, C; stage_rc(tid * 16 + i * 8192, R, C); const int Rb = Epi::PERM ? ((R & ~31) + perm32(R & 31)) : R;
        voffA[i] = (unsigned)(R * g.lda + C) * 2u; voffB[i] = (unsigned)(Rb * g.ldb + C) * 2u; }
    const size_t kstep = (size_t)(BK * 2);
    const size_t hstepA = (size_t)HALF * g.lda * 2, hstepB = (size_t)HALF * g.ldb * 2;
    const size_t tstepA = 2 * hstepA, tstepB = 2 * hstepB;
    const unsigned ldsw = (unsigned)wid * 1024u;
    const int aoff = lds_byte(wr * 64 + fr, fq * 8), boff = lds_byte(wc * 32 + fr, fq * 8);
#define PG8_SA(b, h) (((b) * 2 + (h)) * HTB)
#define PG8_SB(b, h) ((4 + (b) * 2 + (h)) * HTB)
#define PG8_STAGE(bufoff, gbase, voff) do { _Pragma("unroll") for (int _i = 0; _i < 2; ++_i) \
        __builtin_amdgcn_global_load_lds((const unsigned*)((const char*)(gbase) + (voff)[_i]), (PG8_LAS unsigned*)(lds + (bufoff) + ldsw + _i * 8192), 16, 0, 0); } while (0)
#define PG8_LDA(dst, b, h) do { _Pragma("unroll") for (int m = 0; m < 4; ++m) _Pragma("unroll") for (int k = 0; k < 2; ++k) dst[m][k] = *(const PG8_LAS bf16x8*)(lds + PG8_SA(b, h) + aoff + m * 2048 + k * 1024); } while (0)
#define PG8_LDB(dst, b, h) do { _Pragma("unroll") for (int n = 0; n < 2; ++n) _Pragma("unroll") for (int k = 0; k < 2; ++k) dst[n][k] = *(const PG8_LAS bf16x8*)(lds + PG8_SB(b, h) + boff + n * 2048 + k * 1024); } while (0)
#define PG8_MMA(ai, bj, At, Bt) do { __builtin_amdgcn_s_setprio(1); _Pragma("unroll") for (int m = 0; m < 4; ++m) _Pragma("unroll") for (int n = 0; n < 2; ++n) _Pragma("unroll") for (int k = 0; k < 2; ++k) \
        acc[ai][bj][m][n] = __builtin_amdgcn_mfma_f32_16x16x32_bf16(Bt[n][k], At[m][k], acc[ai][bj][m][n], 0, 0, 0); __builtin_amdgcn_s_setprio(0); } while (0)
#define PG8_WAIT_V(n) asm volatile("s_waitcnt vmcnt(" #n ")" ::: "memory")
#define PG8_WAIT_L(n) asm volatile("s_waitcnt lgkmcnt(" #n ")" ::: "memory")
#define PG8_BAR __builtin_amdgcn_s_barrier()
#define PG8_SCHED __builtin_amdgcn_sched_barrier(0)
    Unit cur, nxt; int ui = 0;
    if (!S.next(0, cur)) return;
    f32x4 acc[2][2][4][2];
#pragma unroll
    for (int a = 0; a < 2; ++a)
#pragma unroll
        for (int b = 0; b < 2; ++b)
#pragma unroll
            for (int m = 0; m < 4; ++m)
#pragma unroll
                for (int n = 0; n < 2; ++n) acc[a][b][m][n] = (f32x4){0.f, 0.f, 0.f, 0.f};
    bf16x8 At[4][2], B0[2][2], B1[2][2];
    const char* cA = (const char*)g.A + (size_t)cur.pm * tstepA; const char* cB = (const char*)g.Bt + (size_t)cur.pn * tstepB;
    S.a_ready(cur);
    if constexpr (SP2) {
        PG8_STAGE(PG8_SB(0, 0), cB, voffB); PG8_STAGE(PG8_SB(0, 1), cB + hstepB, voffB); PG8_STAGE(PG8_SA(0, 0), cA, voffA); PG8_STAGE(PG8_SA(0, 1), cA + hstepA, voffA);
        if (wr == 1) PG8_BAR;
        PG8_WAIT_V(2); PG8_BAR;
        PG8_STAGE(PG8_SB(1, 0), cB + kstep, voffB); PG8_STAGE(PG8_SA(1, 0), cA + kstep, voffA); PG8_STAGE(PG8_SB(1, 1), cB + hstepB + kstep, voffB);
        PG8_WAIT_V(6); PG8_BAR;
    } else {
        PG8_STAGE(PG8_SB(0, 0), cB, voffB); PG8_STAGE(PG8_SA(0, 0), cA, voffA); PG8_STAGE(PG8_SB(0, 1), cB + hstepB, voffB); PG8_STAGE(PG8_SA(0, 1), cA + hstepA, voffA);
        if (wr == 1) PG8_BAR;
        PG8_WAIT_V(4); PG8_BAR;
        PG8_STAGE(PG8_SB(1, 0), cB + kstep, voffB); PG8_STAGE(PG8_SA(1, 0), cA + kstep, voffA); PG8_STAGE(PG8_SB(1, 1), cB + hstepB + kstep, voffB);
        PG8_WAIT_V(6); PG8_BAR;
    }
    for (;;) {
        const bool has_next = S.next(ui + 1, nxt);
        const char* nA = has_next ? (const char*)g.A + (size_t)nxt.pm * tstepA : cA; const char* nB = has_next ? (const char*)g.Bt + (size_t)nxt.pn * tstepB : cB;
        for (int t = 0; t < nt; t += 2) {
            const bool last = (t == nt - 2);
            const char* a1 = cA + (size_t)(t + 1) * kstep;
            const char* a2 = last ? nA : cA + (size_t)(t + 2) * kstep; const char* b2 = last ? nB : cB + (size_t)(t + 2) * kstep;
            const char* a3 = a2 + kstep; const char* b3 = b2 + kstep;
            if (last && has_next) S.a_ready(nxt);
            if constexpr (SP2) {
            PG8_LDB(B0, 0, 0); PG8_LDB(B1, 0, 1); PG8_SCHED; PG8_LDA(At, 0, 0); PG8_STAGE(PG8_SA(1, 1), a1 + hstepA, voffA);
            PG8_WAIT_V(8); PG8_WAIT_L(0); PG8_BAR; PG8_MMA(0, 0, At, B0); PG8_MMA(0, 1, At, B1); PG8_BAR; PG8_SCHED;
            PG8_LDA(At, 0, 1); PG8_STAGE(PG8_SB(0, 0), b2, voffB); PG8_STAGE(PG8_SB(0, 1), b2 + hstepB, voffB); PG8_STAGE(PG8_SA(0, 0), a2, voffA);
            PG8_WAIT_V(8); PG8_WAIT_L(0); PG8_BAR; PG8_MMA(1, 0, At, B0); PG8_MMA(1, 1, At, B1); PG8_BAR; PG8_SCHED;
            PG8_LDB(B0, 1, 0); PG8_LDB(B1, 1, 1); PG8_SCHED; PG8_LDA(At, 1, 0); PG8_STAGE(PG8_SA(0, 1), a2 + hstepA, voffA);
            PG8_WAIT_V(8); PG8_WAIT_L(0); PG8_BAR; PG8_MMA(0, 0, At, B0); PG8_MMA(0, 1, At, B1); PG8_BAR; PG8_SCHED;
            PG8_LDA(At, 1, 1); PG8_STAGE(PG8_SB(1, 0), b3, voffB); PG8_STAGE(PG8_SB(1, 1), b3 + hstepB, voffB); PG8_STAGE(PG8_SA(1, 0), a3, voffA);
            PG8_WAIT_V(8); PG8_WAIT_L(0); PG8_BAR; PG8_MMA(1, 0, At, B0); PG8_MMA(1, 1, At, B1); PG8_BAR; PG8_SCHED;
            } else {
            PG8_LDB(B0, 0, 0); PG8_SCHED; PG8_LDA(At, 0, 0); PG8_STAGE(PG8_SA(1, 1), a1 + hstepA, voffA);
            PG8_WAIT_L(8); PG8_BAR; PG8_WAIT_L(0); PG8_MMA(0, 0, At, B0); PG8_BAR; PG8_SCHED;
            PG8_LDB(B1, 0, 1); PG8_STAGE(PG8_SB(0, 0), b2, voffB);
            PG8_BAR; PG8_WAIT_L(0); PG8_MMA(0, 1, At, B1); PG8_BAR;
            PG8_LDA(At, 0, 1); PG8_STAGE(PG8_SA(0, 0), a2, voffA);
            PG8_BAR; PG8_WAIT_L(0); PG8_MMA(1, 0, At, B0); PG8_BAR; PG8_SCHED;
            PG8_STAGE(PG8_SB(0, 1), b2 + hstepB, voffB);
            PG8_WAIT_V(6); PG8_BAR; PG8_MMA(1, 1, At, B1); PG8_BAR;
            PG8_LDB(B0, 1, 0); PG8_SCHED; PG8_LDA(At, 1, 0); PG8_STAGE(PG8_SA(0, 1), a2 + hstepA, voffA);
            PG8_WAIT_L(8); PG8_BAR; PG8_WAIT_L(0); PG8_MMA(0, 0, At, B0); PG8_BAR; PG8_SCHED;
            PG8_LDB(B1, 1, 1); PG8_STAGE(PG8_SB(1, 0), b3, voffB);
            PG8_BAR; PG8_WAIT_L(0); PG8_MMA(0, 1, At, B1); PG8_BAR;
            PG8_LDA(At, 1, 1); PG8_STAGE(PG8_SA(1, 0), a3, voffA);
            PG8_BAR; PG8_WAIT_L(0); PG8_MMA(1, 0, At, B0); PG8_BAR; PG8_SCHED;
            PG8_STAGE(PG8_SB(1, 1), b3 + hstepB, voffB);
            PG8_WAIT_V(6); PG8_BAR; PG8_MMA(1, 1, At, B1); PG8_BAR;
            }
        }
        if constexpr (ALIGN_EPI) { if (wr == 0) PG8_BAR; }
        if constexpr (!Epi::AFTER_DRAIN) { E(acc, cur, wr, wc, fr, fq); S.done(cur); }
        if (!has_next) break;
#pragma unroll
        for (int a = 0; a < 2; ++a)
#pragma unroll
            for (int b = 0; b < 2; ++b)
#pragma unroll
                for (int m = 0; m < 4; ++m)
#pragma unroll
                    for (int n = 0; n < 2; ++n) acc[a][b][m][n] = (f32x4){0.f, 0.f, 0.f, 0.f};
        cur = nxt; cA = nA; cB = nB; ++ui;
        if constexpr (ALIGN_EPI) { if (wr == 1) PG8_BAR; }
    }
    PG8_WAIT_V(0);
    if constexpr (!ALIGN_EPI) { if (wr == 0) PG8_BAR; }
    PG8_BAR;
    if constexpr (Epi::AFTER_DRAIN) { E.fused(acc, cur, wr, wc, fr, fq, lds, wid, lane); S.done(cur); }
#undef PG8_SA
#undef PG8_SB
#undef PG8_STAGE
#undef PG8_LDA
#undef PG8_LDB
#undef PG8_MMA
#undef PG8_WAIT_V
#undef PG8_WAIT_L
#undef PG8_BAR
#undef PG8_SCHED
}
}

#ifndef PG8_SP2
#define PG8_SP2 true
#endif
#ifndef PG8_ALIGN
#define PG8_ALIGN true
#endif
#ifndef P2_REPEAT
#define P2_REPEAT 1
#endif
#ifndef MK_ONE_LAUNCH
#define MK_ONE_LAUNCH 1
#endif

#define LAS __attribute__((address_space(3)))
typedef unsigned short bf16_t;
typedef short bf16x8 __attribute__((ext_vector_type(8)));
typedef short s16x4 __attribute__((ext_vector_type(4)));
typedef float f32x4 __attribute__((ext_vector_type(4)));
typedef float f32x2 __attribute__((ext_vector_type(2)));
typedef float f32x16 __attribute__((ext_vector_type(16)));
typedef unsigned u32x4 __attribute__((ext_vector_type(4)));
typedef unsigned u32x2 __attribute__((ext_vector_type(2)));

constexpr int NB = 2, SEQ = 8192, M = NB * SEQ, DM = 1024, NL = 4;
constexpr int ZW = 2560, DQ = 576, DKV = 768, DLRU = 384, DPOOL = 256;
constexpr int Z_ZA = 0, Z_GA = 384, Z_CQ = 768, Z_CKV = 1152, Z_KR = 1408, Z_GB = 1440, Z_ZC = 1824, Z_GC = 2080, D_IN = 2336;
constexpr float EPS = 1e-6f;
constexpr float QSCALE = 0.10206207261596577f * 1.4426950408889634f;
constexpr int NWAVES = 8, NTHREADS = 512;
constexpr int LDS_BYTES = 155648;

constexpr size_t MiB = 1u << 20;
constexpr size_t WS_CTL = 0, CTL_ZERO_BYTES = 1 * MiB;
typedef unsigned long long ssum_t;
constexpr size_t WS_ACC = 254 * MiB;
constexpr size_t OFF_SSX = 0, OFF_SSQ = (size_t)5 * 16384 * 8, OFF_SSKV = (size_t)9 * 16384 * 8, ACC_BYTES = (size_t)13 * 16384 * 8;
constexpr size_t WS_ROPE = 1 * MiB;
constexpr size_t WS_CHS = 2 * MiB;
constexpr size_t WS_SMALL = 3 * MiB;
constexpr size_t WS_WIN = 4 * MiB, WS_WOUT = 24 * MiB, WS_WUQ = 32 * MiB, WS_WUKV = 35 * MiB;
constexpr size_t WS_XB = 38 * MiB;
constexpr size_t OUT_Q = 0, OUT_KR = 20 * MiB;
constexpr size_t WS_Z = 70 * MiB, WS_KV = 150 * MiB, WS_A32 = 174 * MiB, WS_U32 = 198 * MiB, WS_Y = 222 * MiB, WS_END = 256 * MiB;

struct Args { const float* in[18]; float* out; unsigned char* ws; int ph_lo, ph_hi; };

struct Frame {
    LAS unsigned char* lds;
    int tid, lane, wave, bid, G;
    float* out; unsigned char* ws;
};
typedef __attribute__((address_space(1))) const float* gfp_t;
__device__ __forceinline__ const float* kin(int i) {
    __attribute__((address_space(4))) const char* k = (__attribute__((address_space(4))) const char*)__builtin_amdgcn_kernarg_segment_ptr();
    asm volatile("" : "+s"(k));
    gfp_t p_ = *(__attribute__((address_space(4))) const gfp_t*)(k + 8 * i);
    return (const float*)p_; }

__device__ __forceinline__ unsigned f2bf(float f) { unsigned u = __builtin_bit_cast(unsigned, f); return (u + 0x7fffu + ((u >> 16) & 1u)) >> 16; }
__device__ __forceinline__ unsigned pk2(float lo, float hi) { return f2bf(lo) | (f2bf(hi) << 16); }
__device__ __forceinline__ float bf2f(unsigned short b) { return __builtin_bit_cast(float, (unsigned)b << 16); }
__device__ __forceinline__ float bflo(unsigned w) { return __builtin_bit_cast(float, w << 16); }
__device__ __forceinline__ float bfhi(unsigned w) { return __builtin_bit_cast(float, w & 0xffff0000u); }
__device__ __forceinline__ float sigmoidf_(float x) { return 1.0f / (1.0f + __expf(-x)); }
__device__ __forceinline__ float siluf_(float x) { return x * __builtin_amdgcn_rcpf(1.0f + __expf(-x)); }
__device__ __forceinline__ float wave_sum(float v) {
#pragma unroll
    for (int o = 1; o < 64; o <<= 1) v += __shfl_xor(v, o);
    return v;
}
__device__ __forceinline__ void atomic_addf(ssum_t* p, float v) { (void)__hip_atomic_fetch_add(p, (ssum_t)(v * 16777216.0f), __ATOMIC_RELAXED, __HIP_MEMORY_SCOPE_AGENT); }
__device__ __forceinline__ float ldfx(const ssum_t* p) { return (float)(*p) * (1.0f / 16777216.0f); }
#define LDS_WAIT() asm volatile("s_waitcnt lgkmcnt(0)" ::: "memory")
__device__ __forceinline__ float fast_sigmoid(float x) { return __builtin_amdgcn_rcpf(1.0f + __expf(-x)); }
__device__ __forceinline__ float neg_expm1(float x) {
    const float ser = -x * (1.0f + x * (0.5f + x * (0.16666667f + x * (0.041666668f + x * 0.0083333338f))));
    const float dir = 1.0f - __expf(x);
    return (x > -0.25f) ? ser : dir;
}

struct EpiZ {
    static constexpr bool PERM = true, AFTER_DRAIN = false;
    bf16_t* Zb; const ssum_t* ssx; ssum_t* ssq; ssum_t* sskv;
    __device__ __forceinline__ void operator()(const pg8::f32x4 (&acc)[2][2][4][2], const pg8::Unit& u, int wr, int wc, int fr, int fq) const {
        const int row0 = u.pm * 256 + wr * 64 + fr, col0 = u.pn * 256 + wc * 32 + 8 * fq;
#pragma unroll
        for (int ai = 0; ai < 2; ++ai)
#pragma unroll
            for (int m = 0; m < 4; ++m) {
                const int row = row0 + ai * 128 + m * 16;
                const float rs = rsqrtf(ldfx(ssx + row) * (1.0f / 1024.0f) + EPS);
#pragma unroll
                for (int bj = 0; bj < 2; ++bj) {
                    const f32x4 v0 = acc[ai][bj][m][0] * rs, v1 = acc[ai][bj][m][1] * rs;
                    u32x4 w; w.x = pg8::cvt_pk_bf16(v0[0], v0[1]); w.y = pg8::cvt_pk_bf16(v0[2], v0[3]); w.z = pg8::cvt_pk_bf16(v1[0], v1[1]); w.w = pg8::cvt_pk_bf16(v1[2], v1[3]);
                    if (u.pn * 256 + bj * 128 + wc * 32 < D_IN) *(u32x4*)(Zb + (size_t)row * ZW + col0 + bj * 128) = w;
                    const int ht = u.pn * 2 + bj;
                    if (ht >= 6 && ht <= 10) {
                        float s = (v0[0] * v0[0] + v0[1] * v0[1]) + (v0[2] * v0[2] + v0[3] * v0[3]) + (v1[0] * v1[0] + v1[1] * v1[1]) + (v1[2] * v1[2] + v1[3] * v1[3]);
                        s += __shfl_xor(s, 16); s += __shfl_xor(s, 32);
                        if (fq == 0) atomic_addf((ht <= 8 ? ssq : sskv) + row, s);
                    }
                }
                asm volatile("" ::: "memory");
            }
    }
};
struct EpiQ {
    static constexpr bool PERM = true, AFTER_DRAIN = false;
    bf16_t* Qb; const ssum_t* ssq; const float* cosT; const float* sinT;
    __device__ __forceinline__ void operator()(const pg8::f32x4 (&acc)[2][2][4][2], const pg8::Unit& u, int wr, int wc, int fr, int fq) const {
        const int row0 = u.pm * 256 + wr * 64 + fr;
#pragma unroll
        for (int bj = 0; bj < 2; ++bj) {
            const int cg0 = u.pn * 256 + bj * 128 + wc * 32;
            if (cg0 >= DQ) continue;
            const bool rope = ((cg0 >> 5) % 3) == 2;
#pragma unroll
            for (int ai = 0; ai < 2; ++ai)
#pragma unroll
                for (int m = 0; m < 4; ++m) {
                    const int row = row0 + ai * 128 + m * 16;
                    const float rs = rsqrtf(ldfx(ssq + row) * (1.0f / 384.0f) + EPS) * QSCALE;
                    f32x4 v0 = acc[ai][bj][m][0] * rs, v1 = acc[ai][bj][m][1] * rs;
                    if (rope) {
                        const int pos = row & (SEQ - 1);
                        const f32x4 c0 = *(const f32x4*)(cosT + pos * 16 + 8 * (fq & 1)), c1 = *(const f32x4*)(cosT + pos * 16 + 8 * (fq & 1) + 4);
                        const f32x4 s0 = *(const f32x4*)(sinT + pos * 16 + 8 * (fq & 1)), s1 = *(const f32x4*)(sinT + pos * 16 + 8 * (fq & 1) + 4);
                        const float sg = (fq < 2) ? -1.0f : 1.0f;
                        f32x4 p0, p1;
#pragma unroll
                        for (int j = 0; j < 4; ++j) { p0[j] = __shfl_xor(v0[j], 32); p1[j] = __shfl_xor(v1[j], 32); }
                        v0 = v0 * c0 + (p0 * s0) * sg; v1 = v1 * c1 + (p1 * s1) * sg;
                    }
                    u32x4 w; w.x = pg8::cvt_pk_bf16(v0[0], v0[1]); w.y = pg8::cvt_pk_bf16(v0[2], v0[3]); w.z = pg8::cvt_pk_bf16(v1[0], v1[1]); w.w = pg8::cvt_pk_bf16(v1[2], v1[3]);
                    *(u32x4*)(Qb + (size_t)row * DQ + cg0 + 8 * fq) = w;
                    asm volatile("" ::: "memory");
                }
        }
    }
};
struct EpiKV {
    static constexpr bool PERM = true, AFTER_DRAIN = false;
    bf16_t* KVb; const ssum_t* sskv;
    __device__ __forceinline__ void operator()(const pg8::f32x4 (&acc)[2][2][4][2], const pg8::Unit& u, int wr, int wc, int fr, int fq) const {
        const int row0 = u.pm * 256 + wr * 64 + fr, col0 = u.pn * 256 + wc * 32 + 8 * fq;
#pragma unroll
        for (int ai = 0; ai < 2; ++ai)
#pragma unroll
            for (int m = 0; m < 4; ++m) {
                const int row = row0 + ai * 128 + m * 16;
                const float rs = rsqrtf(ldfx(sskv + row) * (1.0f / 256.0f) + EPS);
#pragma unroll
                for (int bj = 0; bj < 2; ++bj) {
                    const f32x4 v0 = acc[ai][bj][m][0] * rs, v1 = acc[ai][bj][m][1] * rs;
                    u32x4 w; w.x = pg8::cvt_pk_bf16(v0[0], v0[1]); w.y = pg8::cvt_pk_bf16(v0[2], v0[3]); w.z = pg8::cvt_pk_bf16(v1[0], v1[1]); w.w = pg8::cvt_pk_bf16(v1[2], v1[3]);
                    *(u32x4*)(KVb + (size_t)row * DKV + col0 + bj * 128) = w;
                }
                asm volatile("" ::: "memory");
            }
    }
};
struct EpiOut {
    static constexpr bool PERM = true, AFTER_DRAIN = false;
    bf16_t* XB; ssum_t* ssn;
    __device__ __forceinline__ void operator()(const pg8::f32x4 (&acc)[2][2][4][2], const pg8::Unit& u, int wr, int wc, int fr, int fq) const {
        const int row0 = u.pm * 256 + wr * 64 + fr, col0 = u.pn * 256 + wc * 32 + 8 * fq;
#pragma unroll
        for (int ai = 0; ai < 2; ++ai)
#pragma unroll
            for (int m = 0; m < 4; ++m) {
                const int row = row0 + ai * 128 + m * 16;
                float s = 0.f;
#pragma unroll
                for (int bj = 0; bj < 2; ++bj) {
                    const size_t off = (size_t)row * DM + col0 + bj * 128;
                    const u32x4 xw = *(const u32x4*)(XB + off);
                    const f32x4 v0 = (f32x4){bflo(xw.x), bfhi(xw.x), bflo(xw.y), bfhi(xw.y)} + acc[ai][bj][m][0], v1 = (f32x4){bflo(xw.z), bfhi(xw.z), bflo(xw.w), bfhi(xw.w)} + acc[ai][bj][m][1];
                    u32x4 w; w.x = pg8::cvt_pk_bf16(v0[0], v0[1]); w.y = pg8::cvt_pk_bf16(v0[2], v0[3]); w.z = pg8::cvt_pk_bf16(v1[0], v1[1]); w.w = pg8::cvt_pk_bf16(v1[2], v1[3]);
                    *(u32x4*)(XB + off) = w;
                    s += (v0[0] * v0[0] + v0[1] * v0[1]) + (v0[2] * v0[2] + v0[3] * v0[3]) + (v1[0] * v1[0] + v1[1] * v1[1]) + (v1[2] * v1[2] + v1[3] * v1[3]);
                }
                s += __shfl_xor(s, 16); s += __shfl_xor(s, 32);
                if (fq == 0) atomic_addf(ssn + row, s);
                asm volatile("" ::: "memory");
            }
    }
};

struct EpiAll {
    static constexpr bool PERM = true, AFTER_DRAIN = false;
    int mode; void* a; void* b; void* c; void* d;
    __device__ __forceinline__ void operator()(const pg8::f32x4 (&acc)[2][2][4][2], const pg8::Unit& u, int wr, int wc, int fr, int fq) const {
#ifdef ONLY_MODE
        if (mode != ONLY_MODE) return;
#endif
        if (mode == 0) { EpiZ E{(bf16_t*)a, (const ssum_t*)b, (ssum_t*)c, (ssum_t*)d}; E(acc, u, wr, wc, fr, fq); }
        else if (mode == 1) { EpiQ E{(bf16_t*)a, (const ssum_t*)b, (const float*)c, (const float*)d}; E(acc, u, wr, wc, fr, fq); }
        else if (mode == 2) { EpiKV E{(bf16_t*)a, (const ssum_t*)b}; E(acc, u, wr, wc, fr, fq); }
        else { EpiOut E{(bf16_t*)c, (ssum_t*)d}; E(acc, u, wr, wc, fr, fq); }
    }
};

__device__ __forceinline__ void p0_transpose_item(const float* W, int N, const float* g, bf16_t* WT, int ldt, LAS float* scr, int item, int lane) {
    const int nblk = N / 32, kb = item / nblk, nb = item % nblk, k0 = 64 * kb, n0 = 32 * nb;
#pragma unroll 8
    for (int i = 0; i < 32; ++i) { const int kk = 2 * i + (lane >> 5); float v = __builtin_nontemporal_load(&W[(size_t)(k0 + kk) * N + n0 + (lane & 31)]); if (g) v *= g[k0 + kk]; scr[kk * 33 + (lane & 31)] = v; }
    LDS_WAIT(); asm volatile("" ::: "memory");
    const int c = lane & 7;
#pragma unroll
    for (int j = 0; j < 4; ++j) { const int n = (lane >> 3) + 8 * j; const LAS float* s = scr + (8 * c) * 33 + n;
        u32x4 o; o.x = pk2(s[0 * 33], s[1 * 33]); o.y = pk2(s[2 * 33], s[3 * 33]); o.z = pk2(s[4 * 33], s[5 * 33]); o.w = pk2(s[6 * 33], s[7 * 33]);
        *(u32x4*)(WT + (size_t)(n0 + n) * ldt + k0 + 8 * c) = o; }
    LDS_WAIT(); asm volatile("" ::: "memory");
}
__device__ __forceinline__ void convert_layer_weights(Frame& F, int l, int gw, int NGW) {
    LAS float* scr = (LAS float*)(F.lds + F.wave * 16384);
    const int lane = F.lane;
    unsigned char* ws = F.ws;
    constexpr int I_IN = 16 * 73, I_OUT = 16 * 32, I_UQ = 6 * 18, I_UKV = 4 * 24, I_G = 12, I_P = 8;
    constexpr int I_L = I_IN + I_OUT + I_UQ + I_UKV + 2 * I_G + I_P;
    for (int it = gw; it < I_L; it += NGW) {
        int r = it;
        if (r < I_IN) { p0_transpose_item(kin(2) + (size_t)l * 1024 * D_IN, D_IN, kin(1) + l * 1024, (bf16_t*)(ws + WS_WIN) + (size_t)l * ZW * 1024, 1024, scr, r, lane); continue; } r -= I_IN;
        if (r < I_OUT) { p0_transpose_item(kin(16) + (size_t)l * 1024 * 1024, 1024, nullptr, (bf16_t*)(ws + WS_WOUT) + (size_t)l * 1024 * 1024, 1024, scr, r, lane); continue; } r -= I_OUT;
        if (r < I_UQ) { p0_transpose_item(kin(11) + (size_t)l * 384 * DQ, DQ, kin(10) + l * 384, (bf16_t*)(ws + WS_WUQ) + (size_t)l * 768 * 384, 384, scr, r, lane); continue; } r -= I_UQ;
        if (r < I_UKV) { p0_transpose_item(kin(13) + (size_t)l * 256 * DKV, DKV, kin(12) + l * 256, (bf16_t*)(ws + WS_WUKV) + (size_t)l * 768 * 256, 256, scr, r, lane); continue; } r -= I_UKV;
        if (r < I_G) { const int h = r >> 1; p0_transpose_item(kin(5) + (size_t)(l * 6 + h) * 4096, 64, nullptr, (bf16_t*)(ws + WS_SMALL) + (size_t)(l * 6 + h) * 4096, 64, scr, r & 1, lane); continue; } r -= I_G;
        if (r < I_G) { const int h = r >> 1; p0_transpose_item(kin(7) + (size_t)(l * 6 + h) * 4096, 64, nullptr, (bf16_t*)(ws + WS_SMALL + 196608) + (size_t)(l * 6 + h) * 4096, 64, scr, r & 1, lane); continue; } r -= I_G;
        { const int gq = r >> 1; p0_transpose_item(kin(14) + (size_t)(l * 4 + gq) * 4096, 64, nullptr, (bf16_t*)(ws + WS_SMALL + 393216) + (size_t)(l * 4 + gq) * 4096, 64, scr, r & 1, lane); }
    }
}
__device__ __forceinline__ void phase_prologue(Frame& F) {
    const int gw = F.bid * NWAVES + F.wave, NGW = F.G * NWAVES, lane = F.lane;
    unsigned char* ws = F.ws;
    convert_layer_weights(F, 0, gw, NGW);
    if (F.G != 256) { for (int l = 1; l < NL; ++l) convert_layer_weights(F, l, gw, NGW); }
    {
        const int gt = F.bid * NTHREADS + F.tid, NGT = F.G * NTHREADS;
        constexpr int ZIN = 224 * 1024 * 2 / 16, ZUQ = 192 * 384 * 2 / 16;
        for (int i = gt; i < NL * (ZIN + ZUQ); i += NGT) {
            const int l = i / (ZIN + ZUQ), r = i % (ZIN + ZUQ);
            u32x4* p = (r < ZIN) ? (u32x4*)(ws + WS_WIN + ((size_t)l * ZW + D_IN) * 1024 * 2) + r : (u32x4*)(ws + WS_WUQ + ((size_t)l * 768 + DQ) * 384 * 2) + (r - ZIN);
            *p = (u32x4){0u, 0u, 0u, 0u};
        }
        float* SP = (float*)(ws + WS_SMALL + 524288);
        for (int i = gt; i < NL * DLRU; i += NGT) SP[i] = log1pf(expf(-kin(9)[i]));
        float* cosT = (float*)(ws + WS_ROPE); float* sinT = cosT + SEQ * 16;
        for (int i = gt; i < SEQ * 16; i += NGT) {
            const int pos = i >> 4, fi = i & 15, j = fi & 3, k = fi >> 2;
            double inv = (j == 0) ? 1.0 : (j == 1) ? 0.56234132519034908 : (j == 2) ? 0.31622776601683794 : 0.17782794100389228;
            inv *= (k == 0) ? 1.0 : (k == 1) ? 0.1 : (k == 2) ? 0.01 : 0.001;
            const double ang = (double)pos * inv;
            const double n = __builtin_rint(ang * 0.15915494309189535);
            double rr = __builtin_fma(-n, 6.283185307179586, ang); rr = __builtin_fma(-n, 2.4492935982947064e-16, rr);
            const double r2 = rr * rr; double tc = 1.0, sc = 1.0, tsn = rr, ss = rr;
#pragma unroll 1
            for (int q = 1; q <= 15; ++q) { tc *= -r2 / (double)((2 * q - 1) * (2 * q)); sc += tc; tsn *= -r2 / (double)((2 * q) * (2 * q + 1)); ss += tsn; }
            cosT[i] = (float)sc; sinT[i] = (float)ss;
        }
    }
    {
        const float* x = kin(0); bf16_t* XB = (bf16_t*)(ws + WS_XB); ssum_t* ssx = (ssum_t*)(ws + WS_ACC + OFF_SSX);
#pragma unroll 4
        for (int m = gw; m < M; m += NGW) {
            const f32x4* xr = (const f32x4*)(x + (size_t)m * DM) + lane; u32x2* o = (u32x2*)(XB + (size_t)m * DM) + lane;
            float s = 0.f;
#pragma unroll
            for (int j = 0; j < 4; ++j) { const f32x4 v = __builtin_nontemporal_load(&xr[64 * j]);   s += (v.x * v.x + v.y * v.y) + (v.z * v.z + v.w * v.w); o[64 * j] = (u32x2){pk2(v.x, v.y), pk2(v.z, v.w)}; }
            s = wave_sum(s);
            if (lane == 0) ssx[m] = (ssum_t)(s * 16777216.0f);
        }
    }
}

__device__ __forceinline__ bf16x8 ld_x_frag(const LAS float* p) {
    const f32x4 a = *(const LAS f32x4*)p, b = *(const LAS f32x4*)(p + 4);
    u32x4 w; w.x = pg8::cvt_pk_bf16(a[0], a[1]); w.y = pg8::cvt_pk_bf16(a[2], a[3]); w.z = pg8::cvt_pk_bf16(b[0], b[1]); w.w = pg8::cvt_pk_bf16(b[2], b[3]);
    return __builtin_bit_cast(bf16x8, w);
}
constexpr int XAP16 = 392, PLP16 = 264;
constexpr int L2_LA = 64 * XAP16 * 2, L2_UU = L2_LA + 64 * DLRU * 2, L2_END = L2_UU + 64 * DLRU * 2;
static_assert(L2_END <= 150016, "phase-2 LDS map (below the barrier's LDS words)");
template <int W> __device__ __forceinline__ void pool_rows(const float (&c0)[31], const float (&c1)[31], const float (&v0)[31], const float (&v1)[31], int tpos0, LAS bf16_t* dst) {
#pragma unroll
    for (int j = 0; j < 16; ++j) {
        const int idx = 15 + j; const int tp = tpos0 + j;
        float s0 = c0[idx], s1 = c1[idx];
        if (idx - W >= 0) { s0 -= c0[idx - W >= 0 ? idx - W : 0]; s1 -= c1[idx - W >= 0 ? idx - W : 0]; }
        const float rc = __builtin_amdgcn_rcpf((float)((tp + 1 < W) ? tp + 1 : W));
        *(LAS unsigned*)(dst + j * PLP16) = pg8::cvt_pk_bf16(s0 * rc - v0[idx], s1 * rc - v1[idx]);
    }
}
__device__ __forceinline__ void phase2_tile(Frame& F, int l, int u) {
    const int tid = F.tid, lane = F.lane, wave = F.wave;
    unsigned char* ws = F.ws;
    const bf16_t* Z = (const bf16_t*)(ws + WS_Z);
    const int row0 = u * 64, t0 = (u & 127) * 64;
    LAS bf16_t* XA = (LAS bf16_t*)F.lds;
    LAS bf16_t* LA = (LAS bf16_t*)(F.lds + L2_LA); LAS bf16_t* UU = (LAS bf16_t*)(F.lds + L2_UU);
    bf16_t* A16 = (bf16_t*)(ws + WS_A32); bf16_t* U16 = (bf16_t*)(ws + WS_U32);
    if (tid < 384) {
        const int p = tid % 192, half = tid / 192, c = 2 * p;
        const float* cw = kin(3) + (size_t)l * 4 * DLRU; const float* cb = kin(4) + (size_t)l * DLRU;
        const f32x2 w0 = *(const f32x2*)(cw + c), w1 = *(const f32x2*)(cw + DLRU + c), w2 = *(const f32x2*)(cw + 2 * DLRU + c), w3 = *(const f32x2*)(cw + 3 * DLRU + c), bb = *(const f32x2*)(cb + c);
        const int ts = t0 + 32 * half;
        const bf16_t* zp = Z + (size_t)(row0 + 32 * half) * ZW + Z_ZA + c;
        unsigned zr[35];
#pragma unroll
        for (int j = 0; j < 35; ++j) { zr[j] = 0u; if (j >= 3 || ts >= 3) zr[j] = __builtin_nontemporal_load((const unsigned*)(zp + (ptrdiff_t)(j - 3) * ZW)); }
#pragma unroll
        for (int j = 0; j < 32; ++j) {
            const f32x2 x0 = {bflo(zr[j]), bfhi(zr[j])}, x1 = {bflo(zr[j + 1]), bfhi(zr[j + 1])}, x2 = {bflo(zr[j + 2]), bfhi(zr[j + 2])}, x3 = {bflo(zr[j + 3]), bfhi(zr[j + 3])};
            const f32x2 y = bb + w0 * x0 + w1 * x1 + w2 * x2 + w3 * x3;
            *(LAS unsigned*)(XA + (32 * half + j) * XAP16 + c) = pg8::cvt_pk_bf16(y.x, y.y);
        }
    } else {
        const float* cosT = (const float*)(ws + WS_ROPE); const float* sinT = cosT + SEQ * 16;
        bf16_t* KR = (bf16_t*)((unsigned char*)F.out + OUT_KR);
        float ka[8], kb2[8], kc[8], ks[8];
#pragma unroll
        for (int q = 0; q < 8; ++q) { const int it = tid - 384 + 128 * q, tk = it >> 4, i = it & 15, row = row0 + tk, pos = t0 + tk;
            ka[q] = bf2f(Z[(size_t)row * ZW + Z_KR + i]); kb2[q] = bf2f(Z[(size_t)row * ZW + Z_KR + 16 + i]); kc[q] = cosT[pos * 16 + i]; ks[q] = sinT[pos * 16 + i]; }
#pragma unroll
        for (int q = 0; q < 8; ++q) { const int it = tid - 384 + 128 * q, tk = it >> 4, i = it & 15, row = row0 + tk;
            KR[(size_t)row * 32 + i] = (bf16_t)f2bf(ka[q] * kc[q] - kb2[q] * ks[q]); KR[(size_t)row * 32 + 16 + i] = (bf16_t)f2bf(ka[q] * ks[q] + kb2[q] * kc[q]); }
    }
    __syncthreads();
    {
        const int mt = wave & 3, hg = wave >> 2, fr = lane & 15, fq = lane >> 4;
        const bf16_t* Wr = (const bf16_t*)(ws + WS_SMALL) + (size_t)l * 6 * 4096; const bf16_t* Wi = (const bf16_t*)(ws + WS_SMALL + 196608) + (size_t)l * 6 * 4096;
        const float* br = kin(6) + l * DLRU; const float* bi = kin(8) + l * DLRU; const float* SP = (const float*)(ws + WS_SMALL + 524288) + l * DLRU;
        const LAS bf16_t* xrow = XA + (16 * mt + fr) * XAP16; const int lrow = (16 * mt + fr) * DLRU;
        const size_t grow = (size_t)(row0 + 16 * mt + fr) * DLRU;
#pragma unroll 1
        for (int hh = 0; hh < 3; ++hh) {
            const int h = 3 * hg + hh;
            const bf16x8 xb0 = *(const LAS bf16x8*)(xrow + 64 * h + 8 * fq), xb1 = *(const LAS bf16x8*)(xrow + 64 * h + 32 + 8 * fq);
            bf16x8 wfr[4][4]; f32x4 brq[4], biq[4], spq[4];
#pragma unroll
            for (int nt = 0; nt < 4; ++nt) {
                const bf16_t* wr_ = Wr + (size_t)h * 4096 + (16 * nt + fr) * 64 + 8 * fq; const bf16_t* wi_ = Wi + (size_t)h * 4096 + (16 * nt + fr) * 64 + 8 * fq;
                wfr[nt][0] = *(const bf16x8*)wr_; wfr[nt][1] = *(const bf16x8*)(wr_ + 32); wfr[nt][2] = *(const bf16x8*)wi_; wfr[nt][3] = *(const bf16x8*)(wi_ + 32);
                const int c = 64 * h + 16 * nt + 4 * fq;
                brq[nt] = *(const f32x4*)(br + c); biq[nt] = *(const f32x4*)(bi + c); spq[nt] = *(const f32x4*)(SP + c);
            }
#pragma unroll
            for (int nt = 0; nt < 4; ++nt) {
                const bf16x8 ar0 = wfr[nt][0], ar1 = wfr[nt][1], ai0 = wfr[nt][2], ai1 = wfr[nt][3];
                f32x4 accR = {0.f, 0.f, 0.f, 0.f}, accI = {0.f, 0.f, 0.f, 0.f};
                accR = __builtin_amdgcn_mfma_f32_16x16x32_bf16(ar0, xb0, accR, 0, 0, 0); accR = __builtin_amdgcn_mfma_f32_16x16x32_bf16(ar1, xb1, accR, 0, 0, 0);
                accI = __builtin_amdgcn_mfma_f32_16x16x32_bf16(ai0, xb0, accI, 0, 0, 0); accI = __builtin_amdgcn_mfma_f32_16x16x32_bf16(ai1, xb1, accI, 0, 0, 0);
                const int c = 64 * h + 16 * nt + 4 * fq;
                const u32x2 xw_ = *(const LAS u32x2*)(xrow + c);
                const f32x4 brv = brq[nt], biv = biq[nt], spv = spq[nt], xav = {bflo(xw_.x), bfhi(xw_.x), bflo(xw_.y), bfhi(xw_.y)};
                f32x4 lv, uv;
#pragma unroll
                for (int v = 0; v < 4; ++v) {
                    const float r = fast_sigmoid(accR[v] + brv[v]), ig = fast_sigmoid(accI[v] + biv[v]);
                    const float la = -8.0f * r * spv[v];
                    lv[v] = la; uv[v] = __builtin_amdgcn_sqrtf(neg_expm1(2.0f * la)) * (ig * xav[v]);
                }
                *(LAS u32x2*)(LA + lrow + c) = (u32x2){pg8::cvt_pk_bf16(lv[0], lv[1]), pg8::cvt_pk_bf16(lv[2], lv[3])};
                *(LAS u32x2*)(UU + lrow + c) = (u32x2){pg8::cvt_pk_bf16(uv[0], uv[1]), pg8::cvt_pk_bf16(uv[2], uv[3])};
            }
        }
    }
    __syncthreads();
    unsigned zpool[31];
    {
        const int p_ = tid & 127, tq_ = tid >> 7, c_ = 2 * p_, tp0_ = t0 + 16 * tq_;
#pragma unroll
        for (int i = 0; i < 31; ++i) { zpool[i] = 0u; if (tp0_ - 15 + i >= 0) zpool[i] = __builtin_nontemporal_load((const unsigned*)(Z + (size_t)(row0 + 16 * tq_ - 15 + i) * ZW + Z_ZC + c_)); }
    }
    if (tid < DLRU) {
        float ap = 1.0f, hh = 0.0f;
#pragma unroll 1
        for (int jb = 0; jb < 64; jb += 16) {
            unsigned short lq[16], uq16[16], pq[16], hq[16];
#pragma unroll
            for (int j = 0; j < 16; ++j) { lq[j] = LA[(jb + j) * DLRU + tid]; uq16[j] = UU[(jb + j) * DLRU + tid]; }
#pragma unroll
            for (int j = 0; j < 16; ++j) { const float a = __expf(bf2f(lq[j])); hh = a * hh + bf2f(uq16[j]); ap *= a; const unsigned w_ = pg8::cvt_pk_bf16(ap, hh); pq[j] = (unsigned short)(w_ & 0xffffu); hq[j] = (unsigned short)(w_ >> 16); }
#pragma unroll
            for (int j = 0; j < 16; ++j) { LA[(jb + j) * DLRU + tid] = pq[j]; UU[(jb + j) * DLRU + tid] = hq[j]; }
        }
        float* CA = (float*)(ws + WS_CHS); float* CH = CA + 256 * DLRU;
        CA[u * DLRU + tid] = ap; CH[u * DLRU + tid] = hh;
    }
    LAS bf16_t* PL = (LAS bf16_t*)F.lds;
    {
        const int p = tid & 127, tq = tid >> 7, c = 2 * p, g = c >> 6;
        const int tp0 = t0 + 16 * tq;
        float v0[31], v1[31], c0[31], c1[31];
#pragma unroll
        for (int i = 0; i < 31; ++i) {
            const unsigned a = zpool[i];
            v0[i] = bflo(a); v1[i] = bfhi(a);
            c0[i] = (i ? c0[i - 1] : 0.f) + v0[i]; c1[i] = (i ? c1[i - 1] : 0.f) + v1[i];
        }
        LAS bf16_t* dst = PL + (16 * tq) * PLP16 + c;
        if (g == 0) pool_rows<2>(c0, c1, v0, v1, tp0, dst); else if (g == 1) pool_rows<4>(c0, c1, v0, v1, tp0, dst); else if (g == 2) pool_rows<8>(c0, c1, v0, v1, tp0, dst); else pool_rows<16>(c0, c1, v0, v1, tp0, dst);
    }
    __syncthreads();
#pragma unroll
    for (int k = 0; k < 6; ++k) { const int idx = tid + NTHREADS * k;
        const u32x4 va = *(const LAS u32x4*)(LA + idx * 8), vu = *(const LAS u32x4*)(UU + idx * 8);
        *(u32x4*)(A16 + (size_t)row0 * DLRU + idx * 8) = va; *(u32x4*)(U16 + (size_t)row0 * DLRU + idx * 8) = vu; }
    {
        const int mt = wave & 3, gg = wave >> 2, fr = lane & 15, fq = lane >> 4;
        const bf16_t* Wp = (const bf16_t*)(ws + WS_SMALL + 393216) + (size_t)l * 4 * 4096; const float* psc = kin(15) + l * DPOOL;
        bf16_t* Y = (bf16_t*)(ws + WS_Y);
        const LAS bf16_t* prow = PL + (16 * mt + fr) * PLP16; const size_t row = (size_t)(row0 + 16 * mt + fr);
        u32x2 gcq[2][4]; f32x4 psq[2][4]; bf16x8 wpq[2][4][2];
#pragma unroll
        for (int q = 0; q < 2; ++q)
#pragma unroll
            for (int nt = 0; nt < 4; ++nt) { const int g = 2 * gg + q, c = 64 * g + 16 * nt + 4 * fq;
                gcq[q][nt] = *(const u32x2*)(Z + row * ZW + Z_GC + c); psq[q][nt] = *(const f32x4*)(psc + c);
                const bf16_t* wp_ = Wp + (size_t)g * 4096 + (16 * nt + fr) * 64 + 8 * fq; wpq[q][nt][0] = *(const bf16x8*)wp_; wpq[q][nt][1] = *(const bf16x8*)(wp_ + 32); }
#pragma unroll
        for (int q = 0; q < 2; ++q) {
            const int g = 2 * gg + q;
            const bf16x8 xb0 = *(const LAS bf16x8*)(prow + 64 * g + 8 * fq), xb1 = *(const LAS bf16x8*)(prow + 64 * g + 32 + 8 * fq);
#pragma unroll
            for (int nt = 0; nt < 4; ++nt) {
                const bf16x8 a0 = wpq[q][nt][0], a1 = wpq[q][nt][1];
                f32x4 acc = {0.f, 0.f, 0.f, 0.f};
                acc = __builtin_amdgcn_mfma_f32_16x16x32_bf16(a0, xb0, acc, 0, 0, 0); acc = __builtin_amdgcn_mfma_f32_16x16x32_bf16(a1, xb1, acc, 0, 0, 0);
                const int c = 64 * g + 16 * nt + 4 * fq;
                const f32x4 ps = psq[q][nt]; const u32x2 gw_ = gcq[q][nt];
                const float y0 = acc[0] * ps[0] * siluf_(bflo(gw_.x)), y1 = acc[1] * ps[1] * siluf_(bfhi(gw_.x)), y2 = acc[2] * ps[2] * siluf_(bflo(gw_.y)), y3 = acc[3] * ps[3] * siluf_(bfhi(gw_.y));
                *(u32x2*)(Y + row * DM + 768 + c) = (u32x2){pg8::cvt_pk_bf16(y0, y1), pg8::cvt_pk_bf16(y2, y3)};
            }
        }
    }
    __syncthreads();
}

__device__ __forceinline__ void lru_final_unit(Frame& F, int u) {
    const int tid = F.tid; unsigned char* ws = F.ws;
    LAS float* carry = (LAS float*)F.lds;
    if (tid < DLRU) {
        const float* CA = (const float*)(ws + WS_CHS); const float* CH = CA + 256 * DLRU;
        const int b0 = u & ~127;
        float hh = 0.f;
#pragma unroll 16
        for (int j = b0; j < u; ++j) hh = CA[j * DLRU + tid] * hh + CH[j * DLRU + tid];
        carry[tid] = hh;
    }
    __syncthreads();
    const bf16_t* PA = (const bf16_t*)(ws + WS_A32) + (size_t)u * 64 * DLRU; const bf16_t* HL = (const bf16_t*)(ws + WS_U32) + (size_t)u * 64 * DLRU;
    const bf16_t* zg = (const bf16_t*)(ws + WS_Z) + (size_t)u * 64 * ZW + Z_GA; bf16_t* Y = (bf16_t*)(ws + WS_Y) + (size_t)u * 64 * DM;
    {
        u32x4 pq[6], hq[6], gq[6];
#pragma unroll
        for (int k = 0; k < 6; ++k) { const int idx = tid + NTHREADS * k, row = idx / 48, c = 8 * (idx % 48);
            pq[k] = *(const u32x4*)(PA + (size_t)row * DLRU + c); hq[k] = *(const u32x4*)(HL + (size_t)row * DLRU + c); gq[k] = __builtin_nontemporal_load((const u32x4*)(zg + (size_t)row * ZW + c)); }
#pragma unroll
        for (int k = 0; k < 6; ++k) { const int idx = tid + NTHREADS * k, row = idx / 48, c = 8 * (idx % 48);
            const f32x4 cr0 = *(const LAS f32x4*)(carry + c), cr1 = *(const LAS f32x4*)(carry + c + 4);
            const f32x4 p0 = {bflo(pq[k].x), bfhi(pq[k].x), bflo(pq[k].y), bfhi(pq[k].y)}, p1 = {bflo(pq[k].z), bfhi(pq[k].z), bflo(pq[k].w), bfhi(pq[k].w)};
            const f32x4 h0 = (f32x4){bflo(hq[k].x), bfhi(hq[k].x), bflo(hq[k].y), bfhi(hq[k].y)} + p0 * cr0, h1 = (f32x4){bflo(hq[k].z), bfhi(hq[k].z), bflo(hq[k].w), bfhi(hq[k].w)} + p1 * cr1;
            const u32x4 g = gq[k];
            u32x4 w;
            w.x = pg8::cvt_pk_bf16(h0[0] * siluf_(bflo(g.x)), h0[1] * siluf_(bfhi(g.x))); w.y = pg8::cvt_pk_bf16(h0[2] * siluf_(bflo(g.y)), h0[3] * siluf_(bfhi(g.y)));
            w.z = pg8::cvt_pk_bf16(h1[0] * siluf_(bflo(g.z)), h1[1] * siluf_(bfhi(g.z))); w.w = pg8::cvt_pk_bf16(h1[2] * siluf_(bflo(g.w)), h1[3] * siluf_(bfhi(g.w)));
            *(u32x4*)(Y + (size_t)row * DM + c) = w; }
    }
    __syncthreads();
}

namespace att {
constexpr int KSLOT = 12288, VSLOT = 8192;
constexpr int L_K = 0, L_V = 3 * KSLOT, L_WS = L_V + 3 * VSLOT, L_OST = L_WS + NWAVES * 256, L_END = L_OST + NWAVES * 8192;
static_assert(L_END <= 131072, "attention LDS");
__device__ __forceinline__ int crow(int r, int hi) { return (r & 3) + 8 * (r >> 2) + 4 * hi; }
__device__ __forceinline__ void glds16(const void* gsrc, unsigned lds_dst) {
    unsigned keep;
    asm volatile("s_mov_b32 %0, m0\n\ts_mov_b32 m0, %2\n\ts_nop 0\n\tglobal_load_lds_dwordx4 %1, off\n\ts_mov_b32 m0, %0" : "=&s"(keep) : "v"(gsrc), "s"(lds_dst) : "memory");
}
__device__ __forceinline__ void glds16s(const void* sbase, unsigned voff, unsigned lds_dst) {
    unsigned keep;
    asm volatile("s_mov_b32 %0, m0\n\ts_mov_b32 m0, %3\n\ts_nop 0\n\tglobal_load_lds_dwordx4 %1, %2\n\ts_mov_b32 m0, %0" : "=&s"(keep) : "v"(voff), "s"(sbase), "s"(lds_dst) : "memory");
}
typedef short v4i16_t __attribute__((ext_vector_type(4)));
__device__ __forceinline__ s16x4 vtr(const LAS char* p) { return __builtin_bit_cast(s16x4, __builtin_amdgcn_ds_read_tr16_b64_v4i16((LAS v4i16_t*)p)); }
typedef float f32x2_t __attribute__((ext_vector_type(2))); typedef __bf16 bf16x2_t __attribute__((ext_vector_type(2)));
__device__ __forceinline__ unsigned cvtpk_s(float lo, float hi) { f32x2_t v = {lo, hi}; bf16x2_t b = __builtin_convertvector(v, bf16x2_t); return __builtin_bit_cast(unsigned, b); }
__device__ __forceinline__ float swapmax(float m) { auto rr = __builtin_amdgcn_permlane32_swap(__float_as_uint(m), __float_as_uint(m), false, false); return fmaxf(__uint_as_float(rr[0]), __uint_as_float(rr[1])); }
__device__ __forceinline__ float swapsum(float m) { auto rr = __builtin_amdgcn_permlane32_swap(__float_as_uint(m), __float_as_uint(m), false, false); return __uint_as_float(rr[0]) + __uint_as_float(rr[1]); }
#define ATT_WAIT_BAR() asm volatile("s_waitcnt vmcnt(0) lgkmcnt(0)\n\ts_barrier" ::: "memory")

__device__ __forceinline__ void attn_unit(Frame& F, int b, int h, int qb) {
    const int lane = F.lane, r32 = lane & 31, hi = lane >> 5, wid = F.wave;
    unsigned char* ws = F.ws;
    const bf16_t* Q = (const bf16_t*)((const unsigned char*)F.out + OUT_Q); const bf16_t* KV = (const bf16_t*)(ws + WS_KV); const bf16_t* KR = (const bf16_t*)((const unsigned char*)F.out + OUT_KR);
    const LAS char* shm = (const LAS char*)F.lds;
    const unsigned lds0 = (unsigned)(uintptr_t)F.lds;
    const long rowbase = (long)b * SEQ; const int q0 = qb * 256;
    const bf16_t* kbase = KV + rowbase * DKV + h * 128 + wid * 8;
    const bf16_t* krbase = KR + rowbase * 32 + (wid & 3) * 8;
    const bf16_t* vbase = KV + (rowbase + 16 * (wid & 3)) * DKV + h * 128 + 64 + (wid >> 2) * 32;
    const unsigned kroffv = (unsigned)lane * 64u, voffv = (unsigned)(lane >> 2) * (DKV * 2) + (unsigned)(lane & 3) * 16u;
    const unsigned kdst = (unsigned)__builtin_amdgcn_readfirstlane(lds0 + L_K + wid * 1024), krdst = kdst + 8 * 1024  , vdst = kdst + (L_V - L_K);
#define ATT_ISSUE_K(t, sl) do { unsigned ko_ = kroffv; asm volatile("" : "+v"(ko_));   glds16s(kbase + (long)(t) * 64 * DKV, ko_ * 24u, kdst + (sl) * KSLOT); if (wid < 4) glds16s(krbase + (long)(t) * 64 * 32, kroffv, krdst + (sl) * KSLOT); } while (0)
#define ATT_ISSUE_V(t, sl) do { glds16s(vbase + (long)(t) * 64 * DKV, voffv, vdst + (sl) * VSLOT); } while (0)
#define ATT_QK(P0, P1, sl) do { const LAS char* kb_ = kfb + (sl) * KSLOT; P0 = f32x16{}; P1 = f32x16{}; \
        _Pragma("unroll") for (int d0 = 0; d0 < 6; ++d0) { \
            const bf16x8 k0_ = *(const LAS bf16x8*)(kb_ + d0 * 2048), k1_ = *(const LAS bf16x8*)(kb_ + d0 * 2048 + 512); \
            P0 = __builtin_amdgcn_mfma_f32_32x32x16_bf16(k0_, qr[d0], P0, 0, 0, 0); \
            P1 = __builtin_amdgcn_mfma_f32_32x32x16_bf16(k1_, qr[d0], P1, 0, 0, 0); } } while (0)
#define MX3(a, b, c) __builtin_fmaxf(__builtin_fmaxf((a), (b)), (c))
#define ATT_THR 8.0f
#define ATT_QKN(P0, P1, sl) do { const LAS char* kb_ = kfb + (sl) * KSLOT; \
        _Pragma("unroll") for (int d0 = 0; d0 < 6; ++d0) { \
            const bf16x8 k0_ = *(const LAS bf16x8*)(kb_ + d0 * 2048), k1_ = *(const LAS bf16x8*)(kb_ + d0 * 2048 + 512); \
            if (d0 == 0) { P0 = __builtin_amdgcn_mfma_f32_32x32x16_bf16(k0_, qr[0], negm, 0, 0, 0); P1 = __builtin_amdgcn_mfma_f32_32x32x16_bf16(k1_, qr[0], negm, 0, 0, 0); } \
            else { P0 = __builtin_amdgcn_mfma_f32_32x32x16_bf16(k0_, qr[d0], P0, 0, 0, 0); P1 = __builtin_amdgcn_mfma_f32_32x32x16_bf16(k1_, qr[d0], P1, 0, 0, 0); } } } while (0)
#define ATT_VF(d0, ks) ({ const s16x4 lo_ = vtr(vb + (d0) * 4096 + (ks) * 1024), hi_ = vtr(vb + (d0) * 4096 + (ks) * 1024 + 512); (bf16x8){lo_[0], lo_[1], lo_[2], lo_[3], hi_[0], hi_[1], hi_[2], hi_[3]}; })
#define ATT_STEP(C0, C1, N0, N1, tt) do { \
        ATT_WAIT_BAR(); \
        const int sl = (tt) & 1; \
        if ((tt) + 2 < NT) ATT_ISSUE_K((tt) + 2, sl); \
        if ((tt) + 1 < NT) ATT_ISSUE_V((tt) + 1, sl ^ 1); \
        if ((tt) <= tmax) { \
            if ((tt) == tmax) { const int kbase = 64 * (tt); \
                _Pragma("unroll") for (int r = 0; r < 16; ++r) { const int kv = kbase + crow(r, hi); if (kv > qabs) C0[r] = -INFINITY; if (kv + 32 > qabs) C1[r] = -INFINITY; } } \
            float ra = MX3(C0[0], C0[1], C1[0]), rb = MX3(C0[2], C0[3], C1[1]); ra = MX3(ra, C1[2], C1[3]); \
            _Pragma("unroll") for (int r = 4; r < 16; r += 4) { ra = MX3(ra, C0[r], C0[r + 1]); rb = MX3(rb, C0[r + 2], C0[r + 3]); ra = MX3(ra, C1[r], C1[r + 1]); rb = MX3(rb, C1[r + 2], C1[r + 3]); } \
            const float rm = swapmax(fmaxf(ra, rb)); \
            if ((tt) == 0 || __any(rm > ATT_THR)) {                                     \
                const float dl = ((tt) == 0) ? rm : fmaxf(rm, 0.f); \
                mref += dl; \
                _Pragma("unroll") for (int r = 0; r < 16; ++r) { C0[r] -= dl; C1[r] -= dl; } \
                _Pragma("unroll") for (int r = 0; r < 16; ++r) negm[r] = -mref; \
                asm volatile("" : "+v"(negm)); \
                if ((tt) != 0) { const float f = __builtin_amdgcn_exp2f(-dl); lrun *= f; \
                    if (hi == 0) wsf[r32] = f; \
                    LDS_WAIT(); \
                    _Pragma("unroll") for (int g4 = 0; g4 < 4; ++g4) { const f32x4 fv = *(const LAS f32x4*)(wsf + 8 * g4 + 4 * hi); \
                        _Pragma("unroll") for (int j = 0; j < 4; ++j) { o0[4 * g4 + j] *= fv[j]; o1[4 * g4 + j] *= fv[j]; } } \
                    LDS_WAIT(); } \
            } \
            ATT_QKN(N0, N1, sl ^ 1);                                                    \
            _Pragma("unroll") for (int r = 0; r < 16; ++r) { C0[r] = __builtin_amdgcn_exp2f(C0[r]); C1[r] = __builtin_amdgcn_exp2f(C1[r]); } \
            float sa = C0[0];                                                           \
            _Pragma("unroll") for (int r = 1; r < 16; ++r) sa += C0[r]; \
            _Pragma("unroll") for (int r = 0; r < 16; ++r) sa += C1[r]; \
            lrun += sa; \
            const u32x4 pw0 = (u32x4){cvtpk_s(C0[0], C0[1]), cvtpk_s(C0[2], C0[3]), cvtpk_s(C0[4], C0[5]), cvtpk_s(C0[6], C0[7])}; \
            const u32x4 pw1 = (u32x4){cvtpk_s(C0[8], C0[9]), cvtpk_s(C0[10], C0[11]), cvtpk_s(C0[12], C0[13]), cvtpk_s(C0[14], C0[15])}; \
            const u32x4 pw2 = (u32x4){cvtpk_s(C1[0], C1[1]), cvtpk_s(C1[2], C1[3]), cvtpk_s(C1[4], C1[5]), cvtpk_s(C1[6], C1[7])}; \
            const u32x4 pw3 = (u32x4){cvtpk_s(C1[8], C1[9]), cvtpk_s(C1[10], C1[11]), cvtpk_s(C1[12], C1[13]), cvtpk_s(C1[14], C1[15])}; \
            const LAS char* vb = vfb + sl * VSLOT; \
            o0 = __builtin_amdgcn_mfma_f32_32x32x16_bf16(__builtin_bit_cast(bf16x8, pw0), ATT_VF(0, 0), o0, 0, 0, 0); \
            o1 = __builtin_amdgcn_mfma_f32_32x32x16_bf16(__builtin_bit_cast(bf16x8, pw0), ATT_VF(1, 0), o1, 0, 0, 0); \
            o0 = __builtin_amdgcn_mfma_f32_32x32x16_bf16(__builtin_bit_cast(bf16x8, pw1), ATT_VF(0, 1), o0, 0, 0, 0); \
            o1 = __builtin_amdgcn_mfma_f32_32x32x16_bf16(__builtin_bit_cast(bf16x8, pw1), ATT_VF(1, 1), o1, 0, 0, 0); \
            o0 = __builtin_amdgcn_mfma_f32_32x32x16_bf16(__builtin_bit_cast(bf16x8, pw2), ATT_VF(0, 2), o0, 0, 0, 0); \
            o1 = __builtin_amdgcn_mfma_f32_32x32x16_bf16(__builtin_bit_cast(bf16x8, pw2), ATT_VF(1, 2), o1, 0, 0, 0); \
            o0 = __builtin_amdgcn_mfma_f32_32x32x16_bf16(__builtin_bit_cast(bf16x8, pw3), ATT_VF(0, 3), o0, 0, 0, 0); \
            o1 = __builtin_amdgcn_mfma_f32_32x32x16_bf16(__builtin_bit_cast(bf16x8, pw3), ATT_VF(1, 3), o1, 0, 0, 0); \
        } } while (0)
    const int NT = 4 * qb + 4, tmax = 4 * qb + (wid >> 1);
    ATT_ISSUE_K(0, 0); ATT_ISSUE_V(0, 0); ATT_ISSUE_K(1, 1);
    bf16x8 qr[6];
    { const bf16_t* qp = Q + (rowbase + q0 + wid * 32 + r32) * DQ + h * 96 + hi * 8;
#pragma unroll
      for (int d0 = 0; d0 < 6; ++d0) qr[d0] = *(const bf16x8*)(qp + d0 * 16); }
    float mref = 0.f, lrun = 0.f;
    f32x16 o0 = {}, o1 = {};
    f32x16 negm = {}; asm volatile("" : "+v"(negm));
    LAS float* wsf = (LAS float*)(F.lds + L_WS) + wid * 64;
    const int qabs = q0 + wid * 32 + r32;
    const LAS char* kfb = shm + L_K + hi * 1024 + r32 * 16;
    const LAS char* vfb = shm + L_V + ((lane >> 4) & 1) * 32 + (lane & 3) * 8 + (4 * hi + ((lane & 15) >> 2)) * 64;
    f32x16 pa0, pa1, pb0, pb1;
    if (wid >= 4) __builtin_amdgcn_s_setprio(1);
    ATT_WAIT_BAR();
    ATT_QKN(pa0, pa1, 0);
#pragma unroll 1
    for (int t = 0; t < NT; t += 2) {
        ATT_STEP(pa0, pa1, pb0, pb1, t);
        ATT_STEP(pb0, pb1, pa0, pa1, t + 1);
    }
    __builtin_amdgcn_s_setprio(0);
#undef ATT_STEP
#undef ATT_VF
#undef ATT_QKN
#undef ATT_THR
#undef MX3
    {
        const bf16_t* Z = (const bf16_t*)((const unsigned char*)kin(19) + WS_Z); bf16_t* Y = (bf16_t*)((unsigned char*)kin(19) + WS_Y);
        int lane_e = lane; asm volatile("" : "+v"(lane_e));
        const float lt = swapsum(lrun);
        if (hi == 0) wsf[r32] = 1.0f / lt;
        LDS_WAIT();
        LAS float* stg = (LAS float*)(F.lds + L_OST) + wid * 2048;
#pragma unroll
        for (int g4 = 0; g4 < 4; ++g4) { const f32x4 f = *(const LAS f32x4*)(wsf + 8 * g4 + 4 * hi);
#pragma unroll
            for (int j = 0; j < 4; ++j) { const int r = 4 * g4 + j, orow = crow(r, hi); stg[orow * 64 + r32] = o0[r] * f[j]; stg[orow * 64 + 32 + r32] = o1[r] * f[j]; } }
        LDS_WAIT();
        const size_t grow0 = (size_t)(rowbase + q0 + wid * 32);
        u32x4 gbq[4];
#pragma unroll
        for (int i = 0; i < 4; ++i) { const int row = i * 8 + (lane_e >> 3), ch = lane_e & 7; gbq[i] = __builtin_nontemporal_load((const u32x4*)(Z + (grow0 + row) * ZW + Z_GB + 64 * h + 8 * ch)); }
#pragma unroll
        for (int i = 0; i < 4; ++i) {
            const int row = i * 8 + (lane_e >> 3), ch = lane_e & 7;
            const f32x4 ov0 = *(const LAS f32x4*)(stg + row * 64 + ch * 8), ov1 = *(const LAS f32x4*)(stg + row * 64 + ch * 8 + 4);
            const u32x4 g = gbq[i];
            u32x4 w;
            w.x = pg8::cvt_pk_bf16(ov0[0] * siluf_(bflo(g.x)), ov0[1] * siluf_(bfhi(g.x))); w.y = pg8::cvt_pk_bf16(ov0[2] * siluf_(bflo(g.y)), ov0[3] * siluf_(bfhi(g.y)));
            w.z = pg8::cvt_pk_bf16(ov1[0] * siluf_(bflo(g.z)), ov1[1] * siluf_(bfhi(g.z))); w.w = pg8::cvt_pk_bf16(ov1[2] * siluf_(bflo(g.w)), ov1[3] * siluf_(bfhi(g.w)));
            *(u32x4*)(Y + (grow0 + row) * DM + 384 + 64 * h + 8 * ch) = w;
        }
        LDS_WAIT();
    }
#undef ATT_ISSUE_K
#undef ATT_ISSUE_V
}
}

__device__ __forceinline__ void phase_final(Frame& F) {
    const int gw = F.bid * NWAVES + F.wave, NGW = F.G * NWAVES, lane = F.lane;
    const ssum_t* ssx = (const ssum_t*)(F.ws + WS_ACC + OFF_SSX) + 4 * M; const float* g = kin(17);
    const bf16_t* XB = (const bf16_t*)(F.ws + WS_XB);
#pragma unroll 4
    for (int m = gw; m < M; m += NGW) {
        const u32x2* xr = (const u32x2*)(XB + (size_t)m * DM) + lane; f32x4* orow = (f32x4*)(F.out + (size_t)m * DM) + lane; const f32x4* gr = (const f32x4*)g + lane;
        const float rs = rsqrtf(ldfx(ssx + m) * (1.0f / 1024.0f) + EPS);
#pragma unroll
        for (int j = 0; j < 4; ++j) { const u32x2 w = __builtin_nontemporal_load(&xr[64 * j]); const f32x4 v = {bflo(w.x), bfhi(w.x), bflo(w.y), bfhi(w.y)}; __builtin_nontemporal_store(v * rs * gr[64 * j], &orow[64 * j]);   }
    }
}

#define XB_TMO      128
#define XB_XCNT(j)  (256  + 64 * (j))
#define XB_XSUB(j)  (1280 + 64 * (j))
#define XB_XGEN(j)  (2304 + 64 * (j))
#define XB_TOP      3328
#define XB_TOPGEN   3392
#define XCD_BAR_WORDS 3456
#define XB_SPIN_CAP (1u << 18)

__device__ __forceinline__ unsigned xb_ld(unsigned* p)              { return __hip_atomic_load(p, __ATOMIC_RELAXED, __HIP_MEMORY_SCOPE_AGENT); }
__device__ __forceinline__ unsigned xb_add(unsigned* p, unsigned v) { return __hip_atomic_fetch_add(p, v, __ATOMIC_RELAXED, __HIP_MEMORY_SCOPE_AGENT); }
__device__ __forceinline__ unsigned xb_xcc_id() { return (unsigned)__builtin_amdgcn_s_getreg((3 << 11) | 20) & 0xFu; }
#define XB_SPIN(cond, bar) do { unsigned _sp = 0; while (cond) { __builtin_amdgcn_s_sleep(1); \
    if ((++_sp & 255u) == 0u) { if (xb_ld(&(bar)[XB_TMO])) break; if (_sp > XB_SPIN_CAP) { atomicAdd(&(bar)[XB_TMO], 1u); break; } } } } while (0)

struct XcdBarrier {
    unsigned* bar; unsigned x;
    volatile LAS unsigned* st;
};

__device__ __forceinline__ XcdBarrier xcd_barrier_post(unsigned* bar, volatile LAS unsigned* st) {
    XcdBarrier b; b.bar = bar; b.x = xb_xcc_id(); b.st = st;
    if (threadIdx.x == 0) (void)xb_add(&bar[XB_XCNT(b.x)], 1u);
    return b;
}
__device__ __forceinline__ void xcd_barrier_complete(unsigned* bar, unsigned x, unsigned& nloc, unsigned& nx) {
    const unsigned G = gridDim.x * gridDim.y * gridDim.z;
    unsigned sum, cnt, mine, sp = 0u;
    for (;;) {
        sum = 0u; cnt = 0u; mine = 0u;
#pragma unroll
        for (unsigned j = 0; j < 16; ++j) { const unsigned c = xb_ld(&bar[XB_XCNT(j)]); sum += c; cnt += (c > 0u) ? 1u : 0u; mine = (j == x) ? c : mine; }
        if (sum == G) break;
        __builtin_amdgcn_s_sleep(1);
        if ((++sp & 255u) == 0u) { if (xb_ld(&bar[XB_TMO])) break; if (sp > XB_SPIN_CAP) { atomicAdd(&bar[XB_TMO], 1u); break; } }
    }
    nloc = mine > 0u ? mine : 1u; nx = cnt > 0u ? cnt : 1u;
}

__device__ __forceinline__ void xcd_barrier(const XcdBarrier& b) {
    asm volatile("s_waitcnt vmcnt(0)" ::: "memory");
    __syncthreads();
    if (threadIdx.x == 0) {
        unsigned* bar = b.bar;
        __builtin_amdgcn_s_waitcnt(0);
        unsigned nloc = b.st[0], nx = b.st[1];
        if (nloc == 0u) { xcd_barrier_complete(bar, b.x, nloc, nx); b.st[0] = nloc; b.st[1] = nx; }
        const unsigned old = xb_add(&bar[XB_XSUB(b.x)], 1u);
        const unsigned gen = old / nloc;
        if (old + 1u == (gen + 1u) * nloc) {
            __builtin_amdgcn_fence(__ATOMIC_RELEASE, "agent");
            asm volatile("s_waitcnt vmcnt(0)" ::: "memory");
            const unsigned og = xb_add(&bar[XB_TOP], 1u);
            const unsigned tg = og / nx;
            if (og + 1u == (tg + 1u) * nx) xb_add(&bar[XB_TOPGEN], 1u);
            else XB_SPIN(xb_ld(&bar[XB_TOPGEN]) == tg, bar);
            __builtin_amdgcn_fence(__ATOMIC_ACQUIRE, "agent");
            xb_add(&bar[XB_XGEN(b.x)], 1u);
            asm volatile("s_waitcnt vmcnt(0)" ::: "memory");
        } else {
            XB_SPIN(xb_ld(&bar[XB_XGEN(b.x)]) == gen, bar);
            __builtin_amdgcn_fence(__ATOMIC_ACQUIRE, "agent");
            asm volatile("s_waitcnt vmcnt(0)" ::: "memory");
        }
    }
    __syncthreads();
}

constexpr size_t OFF_BAR = 900 * 1024;
constexpr int LDS_BARST = 150016;
#define MK_FRAME() \
    Frame F; F.lds = (LAS unsigned char*)lds; \
    { int t_ = threadIdx.x; asm volatile("" : "+v"(t_)); F.tid = t_; } \
    F.lane = F.tid & 63; F.wave = __builtin_amdgcn_readfirstlane(F.tid >> 6); \
    F.bid = blockIdx.x; F.G = gridDim.x; F.out = (float*)kin(18); F.ws = (unsigned char*)kin(19); \
    unsigned char* ws = F.ws; (void)ws; \
    ssum_t* ssx = (ssum_t*)(ws + WS_ACC + OFF_SSX); ssum_t* ssq = (ssum_t*)(ws + WS_ACC + OFF_SSQ); ssum_t* sskv = (ssum_t*)(ws + WS_ACC + OFF_SSKV); (void)ssx; (void)ssq; (void)sskv; \
    const float* cosT = (const float*)(ws + WS_ROPE); const float* sinT = cosT + SEQ * 16; (void)cosT; (void)sinT;
#define MK_IN(k) (ph_lo <= (k) && (k) < ph_hi)
#define MK_SEAM(k) do { if ((k) + 1 < ph_hi) { if ((k) == 0 && ph_hi > 18) cg::this_grid().sync();   else { XcdBarrier xb_; xb_.bar = (unsigned*)(kin(19)) + OFF_BAR / 4; xb_.x = xb_xcc_id(); xb_.st = (volatile LAS unsigned*)((LAS unsigned char*)lds + LDS_BARST); xcd_barrier(xb_); } } } while (0)

template <int l> __device__ __forceinline__ void layer_phases(unsigned char* lds, int ph_lo, int ph_hi) {
    if (MK_IN(1 + 4 * l)) {
        MK_FRAME();
#if !defined(NO_GEMM) && !defined(NO_G1)
        pg8::Gemm g{(const pg8::bf16_t*)(ws + WS_XB), (const pg8::bf16_t*)(ws + WS_WIN) + (size_t)l * ZW * 1024, M, ZW, 1024, 1024, 1024};
        pg8::StaticOrder S; S.init(M, ZW, F.G, F.bid);
        EpiZ E{(bf16_t*)(ws + WS_Z), ssx + l * M, ssq + l * M, sskv + l * M};
        pg8::gemm_phase<EpiZ, pg8::StaticOrder, PG8_ALIGN, PG8_SP2>(F.lds, g, S, E);
#endif
        if (F.G == 256 && l + 1 < NL && F.bid >= 128) convert_layer_weights(F, l + 1, (F.bid - 128) * NWAVES + F.wave, 128 * NWAVES);
        MK_SEAM(1 + 4 * l);
    }
    if (MK_IN(2 + 4 * l)) for (int rep2_ = 0; rep2_ < P2_REPEAT; ++rep2_) {
        {
            MK_FRAME();
#if !defined(NO_GEMM) && !defined(NO_G2)
            pg8::Gemm g{(const pg8::bf16_t*)(ws + WS_Z) + Z_CQ, (const pg8::bf16_t*)(ws + WS_WUQ) + (size_t)l * 768 * 384, M, 768, 384, ZW, 384};
            pg8::StaticOrder S; S.init(M, 768, F.G, F.bid);
            EpiQ E{(bf16_t*)((unsigned char*)F.out + OUT_Q), ssq + l * M, cosT, sinT};
            pg8::gemm_phase<EpiQ, pg8::StaticOrder, PG8_ALIGN, PG8_SP2>(F.lds, g, S, E);
#endif
        }
        {
            MK_FRAME();
#if !defined(NO_GEMM) && !defined(NO_G3)
            pg8::Gemm g{(const pg8::bf16_t*)(ws + WS_Z) + Z_CKV, (const pg8::bf16_t*)(ws + WS_WUKV) + (size_t)l * 768 * 256, M, 768, 256, ZW, 256};
            pg8::StaticOrder S; S.init(M, 768, F.G, (F.bid + F.G / 2) % F.G);
            EpiKV E{(bf16_t*)(ws + WS_KV), sskv + l * M};
            pg8::gemm_phase<EpiKV, pg8::StaticOrder, PG8_ALIGN, PG8_SP2>(F.lds, g, S, E);
#endif
        }
        __syncthreads();
        {
            MK_FRAME();
#if !defined(NO_P2)
            for (int u = F.bid; u < 256; u += F.G) phase2_tile(F, l, u);
#endif
        }
        MK_SEAM(2 + 4 * l);
    }
    if (MK_IN(3 + 4 * l)) {
        MK_FRAME();
#ifndef ATT_REPEAT
#define ATT_REPEAT 1
#endif
        int i1 = F.bid;
        if (F.G == 256) { const int v = (F.bid & 7) * 32 + (F.bid >> 3); i1 = (v < 252) ? (v % 21) * 12 + v / 21 : v; }
        for (int rep = 0; rep < ATT_REPEAT; ++rep)
        for (int r = 0;; ++r) {
            int i;
            if (F.G == 256) { if (r >= 2 || (r == 1 && i1 < 128)) break; i = r ? 511 - i1 : i1; }
            else { if (r * F.G >= 384) break; i = (r & 1) ? r * F.G + (F.G - 1 - F.bid) : r * F.G + F.bid; }
#if !defined(NO_ATT)
            if (i < 384) att::attn_unit(F, (i % 12) / 6, (i % 12) % 6, 31 - i / 12);
#endif
        }
        __syncthreads();
        { const int hg = F.G / 2;
          if (i1 >= F.G - hg) for (int u = F.G - 1 - i1; u < 256; u += hg) lru_final_unit(F, u); }
        MK_SEAM(3 + 4 * l);
    }
    if (MK_IN(4 + 4 * l)) {
        MK_FRAME();
#if !defined(NO_GEMM) && !defined(NO_G4)
        pg8::Gemm g{(const pg8::bf16_t*)(ws + WS_Y), (const pg8::bf16_t*)(ws + WS_WOUT) + (size_t)l * 1024 * 1024, M, 1024, 1024, 1024, 1024};
        pg8::StaticOrder S; S.init(M, 1024, F.G, F.bid);
        EpiOut E{(bf16_t*)(ws + WS_XB), ssx + (l + 1) * M};
        pg8::gemm_phase<EpiOut, pg8::StaticOrder, PG8_ALIGN, PG8_SP2>(F.lds, g, S, E);
#endif
        MK_SEAM(4 + 4 * l);
    }
}

__global__ void __launch_bounds__(NTHREADS, 2) mk_fwd(Args args) {
    extern __shared__ __attribute__((aligned(16))) unsigned char lds[];
    const int ph_lo = *(__attribute__((address_space(4))) const int*)((__attribute__((address_space(4))) const char*)__builtin_amdgcn_kernarg_segment_ptr() + 160);
    const int ph_hi = *(__attribute__((address_space(4))) const int*)((__attribute__((address_space(4))) const char*)__builtin_amdgcn_kernarg_segment_ptr() + 164);
    if (threadIdx.x < 2) ((LAS unsigned*)((LAS unsigned char*)lds + LDS_BARST))[threadIdx.x] = 0u;
    __syncthreads();
    (void)xcd_barrier_post((unsigned*)(kin(19)) + OFF_BAR / 4, (volatile LAS unsigned*)((LAS unsigned char*)lds + LDS_BARST));
    if (MK_IN(0)) {
        MK_FRAME();
#if !defined(NO_PRO)
        phase_prologue(F);
#endif
        MK_SEAM(0);
    }
    layer_phases<0>(lds, ph_lo, ph_hi);
    layer_phases<1>(lds, ph_lo, ph_hi);
    layer_phases<2>(lds, ph_lo, ph_hi);
    layer_phases<3>(lds, ph_lo, ph_hi);
    if (MK_IN(17)) {
        MK_FRAME();
        phase_final(F);
    }
}

extern "C" void kernel_launch(void* const* d_in, const int* in_sizes, int n_in, void* d_out, int out_size, void* d_ws, size_t ws_size, hipStream_t stream) {
    static int grid = 0;
    if (grid == 0) {
        if (n_in != 18 || in_sizes[0] != M * DM || out_size != M * DM || ws_size < WS_END) { fprintf(stderr, "kernel_launch: unexpected shapes (n_in %d, in0 %d, out %d, ws %zu)\n", n_in, n_in > 0 ? in_sizes[0] : -1, out_size, ws_size); grid = -1; return; }
        int dev = 0, cus = 0, per_cu = 0;
        hipGetDevice(&dev); hipDeviceGetAttribute(&cus, hipDeviceAttributeMultiprocessorCount, dev);
        if (hipFuncSetAttribute((const void*)mk_fwd, hipFuncAttributeMaxDynamicSharedMemorySize, LDS_BYTES) != hipSuccess) { fprintf(stderr, "kernel_launch: hipFuncSetAttribute failed\n"); grid = -1; return; }
        if (hipOccupancyMaxActiveBlocksPerMultiprocessor(&per_cu, (const void*)mk_fwd, NTHREADS, LDS_BYTES) != hipSuccess || per_cu < 1) { fprintf(stderr, "kernel_launch: occupancy query says %d\n", per_cu); per_cu = 1; }
        (void)hipGetLastError();
        grid = cus;
        if (grid > 256) grid = 256;
    }
    if (grid < 0) return;
    hipMemsetAsync((char*)d_ws + WS_CTL, 0, CTL_ZERO_BYTES, stream);
    hipMemsetAsync((char*)d_ws + WS_ACC, 0, ACC_BYTES, stream);
    Args a{};
    for (int i = 0; i < 18; ++i) a.in[i] = (const float*)d_in[i];
    a.out = (float*)d_out; a.ws = (unsigned char*)d_ws;
#if MK_ONE_LAUNCH
    a.ph_lo = 0; a.ph_hi = 18;
    void* kargs[] = {&a};
    hipError_t e = hipLaunchCooperativeKernel((const void*)mk_fwd, dim3(grid), dim3(NTHREADS), kargs, LDS_BYTES, stream);
    if (e != hipSuccess) fprintf(stderr, "cooperative launch failed: %s (grid %d)\n", hipGetErrorString(e), grid);
#else
    for (int ph = 0; ph < 18; ++ph) {
        a.ph_lo = ph; a.ph_hi = ph + 1;
        hipLaunchKernelGGL(mk_fwd, dim3(grid), dim3(NTHREADS), LDS_BYTES, stream, a);
    }
#endif
}
```
